# Optimizing an MI355X kernel written in HIP

```python
import math
import jax
import jax.numpy as jnp
from jax import lax
import numpy as np

D_MODEL = 2048
BATCH = 4
SEQ = 4096
DEPTH = 4

GRID_W = 64
CTX_LEN = 256
N_MOD = 6
EPS = 1e-6

NA_HEAD_DIM = 128
NA_W = D_MODEL // 2
NA_HEADS = NA_W // NA_HEAD_DIM
NA_ROWS = 8
NA_COLS = 16

SGU_W = D_MODEL // 4
SGU_HEADS = 4
SGU_HEAD_DIM = SGU_W // SGU_HEADS
SGU_CHUNK = 128

S5_W = D_MODEL // 4
S5_GROUP = 16
S5_GROUPS = S5_W // S5_GROUP
S5_STATE = 64
DT_MIN = 1e-3
DT_MAX = 1e-1

MIX_W = NA_W + SGU_W + S5_W
IN_W = 3 * NA_W + 2 * SGU_W + S5_W
COL_SPLITS = (NA_W, 2 * NA_W, 3 * NA_W, 3 * NA_W + SGU_W, 3 * NA_W + 2 * SGU_W)

PEER_HEADS = 8
PEER_QDIM = 256
PEER_NKEYS = 128
PEER_TOPK = 16
PEER_EXPERTS = PEER_NKEYS * PEER_NKEYS
PEER_CHUNK = 128

kernel_name = "hybrid_na_sgu_s5_peer_dit"

F32 = jnp.float32


def rms_norm(x, g):
    xf = x.astype(F32)
    y = xf * lax.rsqrt(jnp.mean(xf * xf, axis=-1, keepdims=True) + EPS)
    return (y * g.astype(F32)).astype(x.dtype)


def modulate(h, shift, scale):
    return h * (1 + scale) + shift


def gelu(x):
    return jax.nn.gelu(x, approximate=False)


def neighbourhood_attention(q, k, v, kc, vc, rpb):
    B, L, H, Dh = q.shape
    rows = L // GRID_W
    kr = min(NA_ROWS, rows)
    scale = Dh ** -0.5
    qg = q.reshape(B, rows, GRID_W, H, Dh)
    kg = k.reshape(B, rows, GRID_W, H, Dh)
    vg = v.reshape(B, rows, GRID_W, H, Dh)
    col = jnp.arange(GRID_W)
    col_start = jnp.clip(col - NA_COLS // 2, 0, GRID_W - NA_COLS)
    col_idx = col_start[:, None] + jnp.arange(NA_COLS)
    col_off = col_idx - col[:, None] + (NA_COLS - 1)

    def one_row(r):
        r_start = jnp.clip(r - kr // 2, 0, rows - kr)
        q_r = lax.dynamic_index_in_dim(qg, r, axis=1, keepdims=False)
        k_band = lax.dynamic_slice_in_dim(kg, r_start, kr, axis=1)
        v_band = lax.dynamic_slice_in_dim(vg, r_start, kr, axis=1)
        k_win = k_band[:, :, col_idx]
        v_win = v_band[:, :, col_idx]
        row_off = r_start + jnp.arange(kr) - r + (NA_ROWS - 1)
        bias = rpb[:, row_off[:, None, None], col_off[None, :, :]]
        bias = jnp.transpose(bias, (0, 2, 1, 3)).astype(F32)
        s_loc = jnp.einsum("bchd,brcwhd->bhcrw", q_r, k_win).astype(F32) * scale + bias[None]
        s_ctx = jnp.einsum("bchd,bnhd->bhcn", q_r, kc).astype(F32) * scale
        s = jnp.concatenate([s_loc.reshape(B, H, GRID_W, kr * NA_COLS), s_ctx], axis=-1)
        p = jax.nn.softmax(s, axis=-1)
        p_loc = p[..., : kr * NA_COLS].reshape(B, H, GRID_W, kr, NA_COLS).astype(v.dtype)
        p_ctx = p[..., kr * NA_COLS:].astype(v.dtype)
        return (jnp.einsum("bhcrw,brcwhd->bchd", p_loc, v_win)
                + jnp.einsum("bhcn,bnhd->bchd", p_ctx, vc))

    out = lax.map(one_row, jnp.arange(rows))
    return jnp.transpose(out, (1, 0, 2, 3, 4)).reshape(B, L, H * Dh)


def context_attention(qc, kc, vc):
    s = jnp.einsum("bqhd,bkhd->bhqk", qc, kc).astype(F32) * NA_HEAD_DIM ** -0.5
    p = jax.nn.softmax(s, axis=-1).astype(vc.dtype)
    o = jnp.einsum("bhqk,bkhd->bqhd", p, vc)
    return o.reshape(o.shape[0], o.shape[1], NA_W)


def spatial_gating(su, sv, w_s, b_s, g):
    B, L, _ = su.shape
    u = gelu(su)
    v = rms_norm(gelu(sv), g).reshape(B, L // SGU_CHUNK, SGU_CHUNK, SGU_HEADS, SGU_HEAD_DIM)
    mixed = jnp.einsum("hts,bnshc->bnthc", w_s, v) + b_s.T[:, :, None]
    return u * mixed.reshape(B, L, SGU_W)


def zoh_discretize(a_re, a_im, log_dt, b_re, b_im):
    lam = lax.complex(jnp.minimum(a_re.astype(F32), -1e-4), a_im.astype(F32))
    dt = jnp.exp(log_dt.astype(F32))[:, None]
    lam_bar = jnp.exp(lam * dt)
    b = lax.complex(b_re.astype(F32), b_im.astype(F32))
    b_bar = ((lam_bar - 1) / lam)[..., None] * b
    return lam_bar, b_bar


def _linear_recurrence(e1, e2):
    a1, b1 = e1
    a2, b2 = e2
    return a1 * a2, a2 * b1 + b2


def diag_scan(lam_bar, drive, h0, reverse):
    if h0 is not None:
        edge = drive.shape[1] - 1 if reverse else 0
        drive = drive.at[:, edge].add(lam_bar * h0)
    decay = jnp.broadcast_to(lam_bar, drive.shape)
    _, h = lax.associative_scan(_linear_recurrence, (decay, drive), reverse=reverse, axis=1)
    return h


def s5_mixer(s_in, s_ctx, a_re, a_im, log_dt, b_re, b_im, c_re, c_im, d, glu_w, glu_b, ctx_out):
    def to_groups(t):
        return t.astype(F32).reshape(t.shape[0], t.shape[1], S5_GROUPS, S5_GROUP)

    def drive(b_bar, u):
        return jnp.einsum("gph,blgh->blgp", b_bar, u.astype(jnp.complex64))

    def readout(c_mat, h):
        return jnp.real(jnp.einsum("ghp,blgp->blgh", c_mat, h))

    def glu(y):
        y = gelu(y.reshape(y.shape[0], y.shape[1], S5_W))
        return y * jax.nn.sigmoid(y @ glu_w.astype(F32) + glu_b.astype(F32))

    u, uc = to_groups(s_in), to_groups(s_ctx)
    d_g = d.astype(F32).reshape(S5_GROUPS, S5_GROUP)
    y = u * d_g
    yc = uc * d_g if ctx_out else None
    for direction in range(2):
        reverse = direction == 1
        lam_bar, b_bar = zoh_discretize(a_re[direction], a_im[direction], log_dt[direction],
                                        b_re[direction], b_im[direction])
        c_mat = lax.complex(c_re[direction].astype(F32), c_im[direction].astype(F32))
        h_ctx = diag_scan(lam_bar, drive(b_bar, uc), None, reverse)
        h_carry = h_ctx[:, 0] if reverse else h_ctx[:, -1]
        h_lat = diag_scan(lam_bar, drive(b_bar, u), h_carry, reverse)
        y = y + readout(c_mat, h_lat)
        if ctx_out:
            yc = yc + readout(c_mat, h_ctx)
    out = glu(y).astype(s_in.dtype)
    out_c = glu(yc).astype(s_in.dtype) if ctx_out else None
    return out, out_c


def merge_groups(attn, sgu, s5, out_norm, w_out):
    y = jnp.concatenate([
        rms_norm(attn, out_norm[:NA_W]),
        rms_norm(sgu, out_norm[NA_W:NA_W + SGU_W]),
        rms_norm(s5, out_norm[NA_W + SGU_W:]),
    ], axis=-1)
    return y @ w_out


def token_mixers(h, hc, w_in, w_out, out_norm, na_rpb, sgu_w, sgu_b, sgu_norm,
                 s5_a_re, s5_a_im, s5_log_dt, s5_b_re, s5_b_im, s5_c_re, s5_c_im,
                 s5_d, s5_glu_w, s5_glu_b, ctx_out):
    B, L, _ = h.shape

    def heads(t):
        return t.reshape(t.shape[0], t.shape[1], NA_HEADS, NA_HEAD_DIM)

    q, k, v, su, sv, s_in = jnp.split(h @ w_in, COL_SPLITS, axis=-1)
    if ctx_out:
        qc, kc, vc, suc, svc, s_inc = jnp.split(hc @ w_in, COL_SPLITS, axis=-1)
    else:
        kc, vc = jnp.split(hc @ w_in[:, NA_W:3 * NA_W], 2, axis=-1)
        s_inc = hc @ w_in[:, IN_W - S5_W:]
    kc_h, vc_h = heads(kc), heads(vc)

    attn = neighbourhood_attention(heads(q), heads(k), heads(v), kc_h, vc_h, na_rpb)
    sgu = spatial_gating(su, sv, sgu_w, sgu_b, sgu_norm)
    s5, s5c = s5_mixer(s_in, s_inc, s5_a_re, s5_a_im, s5_log_dt, s5_b_re, s5_b_im,
                       s5_c_re, s5_c_im, s5_d, s5_glu_w, s5_glu_b, ctx_out)
    y = merge_groups(attn, sgu, s5, out_norm, w_out)
    if not ctx_out:
        return y, None
    attn_c = context_attention(heads(qc), kc_h, vc_h)
    sgu_c = spatial_gating(suc, svc, sgu_w, sgu_b, sgu_norm)
    yc = merge_groups(attn_c, sgu_c, s5c, out_norm, w_out)
    return y, yc


def peer_ffn(h, w_q, k1, k2, u_tab, v_tab):
    B, L, D = h.shape
    tokens = h.reshape(B * L // PEER_CHUNK, PEER_CHUNK, D)
    half = PEER_QDIM // 2

    def block(xb):
        q = (xb @ w_q).reshape(PEER_CHUNK, PEER_HEADS, PEER_QDIM)
        s1 = jnp.einsum("thd,hkd->thk", q[..., :half], k1).astype(F32)
        s2 = jnp.einsum("thd,hkd->thk", q[..., half:], k2).astype(F32)
        v1, i1 = lax.top_k(s1, PEER_TOPK)
        v2, i2 = lax.top_k(s2, PEER_TOPK)
        cand_s = (v1[..., :, None] + v2[..., None, :]).reshape(PEER_CHUNK, PEER_HEADS, PEER_TOPK * PEER_TOPK)
        cand_e = (i1[..., :, None] * PEER_NKEYS + i2[..., None, :]).reshape(PEER_CHUNK, PEER_HEADS, PEER_TOPK * PEER_TOPK)
        best_s, pos = lax.top_k(cand_s, PEER_TOPK)
        expert = jnp.take_along_axis(cand_e, pos, axis=-1)
        gate = jax.nn.softmax(best_s, axis=-1)
        u = jnp.take(u_tab, expert, axis=0)
        act = gelu(jnp.einsum("thkd,td->thk", u, xb).astype(F32))
        w = (gate * act).astype(xb.dtype)
        return jnp.einsum("thk,thkd->td", w, jnp.take(v_tab, expert, axis=0))

    return lax.map(block, tokens).reshape(B, L, D)


def setup_inputs(seed: int = 0) -> dict:
    key = jax.random.key(seed)
    ks = jax.random.split(key, 32)
    D = D_MODEL
    G, P, H = S5_GROUPS, S5_STATE, S5_GROUP

    def nrm(k, shape, s):
        return jax.random.normal(k, shape, F32) * s

    return {
        "x": nrm(ks[0], (BATCH, SEQ, D), 1.0),
        "c": nrm(ks[1], (BATCH, D), 1.0),
        "ctx": nrm(ks[2], (BATCH, CTX_LEN, D), 1.0),
        "c_ctx": nrm(ks[3], (D,), 1.0),
        "ada_w": nrm(ks[4], (DEPTH, D, N_MOD * D), 0.5 * D ** -0.5),
        "ada_b": nrm(ks[5], (DEPTH, N_MOD * D), 0.01),
        "norm_mix": 1.0 + nrm(ks[6], (DEPTH, D), 0.01),
        "norm_ffn": 1.0 + nrm(ks[7], (DEPTH, D), 0.01),
        "w_in": nrm(ks[8], (DEPTH, D, IN_W), D ** -0.5),
        "w_out": nrm(ks[9], (DEPTH, MIX_W, D), MIX_W ** -0.5),
        "out_norm": 1.0 + nrm(ks[10], (DEPTH, MIX_W), 0.01),
        "na_rpb": nrm(ks[11], (DEPTH, NA_HEADS, 2 * NA_ROWS - 1, 2 * NA_COLS - 1), 0.02),
        "sgu_w": nrm(ks[12], (DEPTH, SGU_HEADS, SGU_CHUNK, SGU_CHUNK), 0.1 * SGU_CHUNK ** -0.5),
        "sgu_b": 1.0 + nrm(ks[13], (DEPTH, SGU_HEADS, SGU_CHUNK), 0.1),
        "sgu_norm": 1.0 + nrm(ks[14], (DEPTH, SGU_W), 0.01),
        "s5_a_re": -0.5 + nrm(ks[15], (DEPTH, 2, G, P), 0.01),
        "s5_a_im": math.pi * jnp.arange(P, dtype=F32) + nrm(ks[16], (DEPTH, 2, G, P), 0.01),
        "s5_log_dt": jax.random.uniform(ks[17], (DEPTH, 2, G), F32, math.log(DT_MIN), math.log(DT_MAX)),
        "s5_b_re": nrm(ks[18], (DEPTH, 2, G, P, H), (2 * H) ** -0.5),
        "s5_b_im": nrm(ks[19], (DEPTH, 2, G, P, H), (2 * H) ** -0.5),
        "s5_c_re": nrm(ks[20], (DEPTH, 2, G, H, P), (2 * P) ** -0.5),
        "s5_c_im": nrm(ks[21], (DEPTH, 2, G, H, P), (2 * P) ** -0.5),
        "s5_d": nrm(ks[22], (DEPTH, S5_W), 1.0),
        "s5_glu_w": nrm(ks[23], (DEPTH, S5_W, S5_W), S5_W ** -0.5),
        "s5_glu_b": nrm(ks[24], (DEPTH, S5_W), 0.01),
        "peer_wq": nrm(ks[25], (DEPTH, D, PEER_HEADS * PEER_QDIM), D ** -0.5),
        "peer_k1": nrm(ks[26], (DEPTH, PEER_HEADS, PEER_NKEYS, PEER_QDIM // 2), (PEER_QDIM // 2) ** -0.5),
        "peer_k2": nrm(ks[27], (DEPTH, PEER_HEADS, PEER_NKEYS, PEER_QDIM // 2), (PEER_QDIM // 2) ** -0.5),
        "peer_u": nrm(ks[28], (DEPTH, PEER_EXPERTS, D), D ** -0.5),
        "peer_v": nrm(ks[29], (DEPTH, PEER_EXPERTS, D), PEER_HEADS ** -0.5),
        "final_norm": 1.0 + nrm(ks[30], (D,), 0.01),
    }


def reference(x, c, ctx, c_ctx, ada_w, ada_b, norm_mix, norm_ffn, w_in, w_out, out_norm,
              na_rpb, sgu_w, sgu_b, sgu_norm, s5_a_re, s5_a_im, s5_log_dt, s5_b_re, s5_b_im,
              s5_c_re, s5_c_im, s5_d, s5_glu_w, s5_glu_b, peer_wq, peer_k1, peer_k2,
              peer_u, peer_v, final_norm):
    B = x.shape[0]
    D = x.shape[-1]
    sc = jax.nn.silu(c)
    scc = jax.nn.silu(c_ctx)
    xc = ctx
    for i in range(DEPTH):
        ctx_out = i < DEPTH - 1
        mod = (sc @ ada_w[i] + ada_b[i]).reshape(B, N_MOD, D)[:, :, None, :]
        modc = (scc @ ada_w[i] + ada_b[i]).reshape(N_MOD, D)

        h = modulate(rms_norm(x, norm_mix[i]), mod[:, 0], mod[:, 1])
        hc = modulate(rms_norm(xc, norm_mix[i]), modc[0], modc[1])
        y, yc = token_mixers(h, hc, w_in[i], w_out[i], out_norm[i], na_rpb[i],
                             sgu_w[i], sgu_b[i], sgu_norm[i],
                             s5_a_re[i], s5_a_im[i], s5_log_dt[i], s5_b_re[i], s5_b_im[i],
                             s5_c_re[i], s5_c_im[i], s5_d[i], s5_glu_w[i], s5_glu_b[i], ctx_out)
        x = x + mod[:, 2] * y

        h = modulate(rms_norm(x, norm_ffn[i]), mod[:, 3], mod[:, 4])
        x = x + mod[:, 5] * peer_ffn(h, peer_wq[i], peer_k1[i], peer_k2[i], peer_u[i], peer_v[i])

        if ctx_out:
            xc = xc + modc[2] * yc
            hc = modulate(rms_norm(xc, norm_ffn[i]), modc[3], modc[4])
            xc = xc + modc[5] * peer_ffn(hc, peer_wq[i], peer_k1[i], peer_k2[i], peer_u[i], peer_v[i])
    return rms_norm(x, final_norm)
```

```cpp
#include <hip/hip_runtime.h>
#include <cstdio>
namespace pg8 {
#define PG8_LAS __attribute__((address_space(3)))
typedef unsigned short bf16_t;
typedef short bf16x8 __attribute__((ext_vector_type(8)));
typedef float f32x4 __attribute__((ext_vector_type(4)));
typedef unsigned u32x4 __attribute__((ext_vector_type(4)));
constexpr int BM = 256, BK = 64, HALF = 128, HTB = HALF * BK * 2  , STAGE_BYTES = 8 * HTB, NXCD = 8, WGM = 8;

__host__ __device__ __forceinline__ int lds_byte(int r, int c) { const int st = (r >> 4) * 2 + (c >> 5), rr = r & 15, cc = c & 31, ob = rr * 64 + cc * 2; return st * 1024 + (ob ^ (((ob >> 9) & 1) << 5)); }
__host__ __device__ __forceinline__ void stage_rc(int b, int& R, int& C) { const int st = b / 1024, sb = b % 1024, swz = sb ^ (((sb >> 9) & 1) << 5); R = (st >> 1) * 16 + swz / 64; C = (st & 1) * 32 + (swz % 64) / 2; }
__host__ __device__ __forceinline__ int perm32(int rho) { const int n = rho >> 4, i = rho & 15; return 8 * (i >> 2) + 4 * n + (i & 3); }

struct Unit { int pm, pn; };
struct Gemm { const bf16_t* A; const bf16_t* Bt; int M, N, K; };

struct StaticOrder {
    int nM, nN, nwg, G, c;
    __host__ __device__ void init(int M, int N, int G_, int c_) { nM = M / BM; nN = N / BM; nwg = nM * nN; G = G_; c = c_; }
    __host__ __device__ bool next(int i, Unit& u) const {
        const long L = (long)i * G + c; if (L >= nwg) return false;
        int wgid = (int)L; { const int q = nwg / NXCD, r = nwg % NXCD, xcd = wgid % NXCD, off = wgid / NXCD; wgid = (xcd < r ? xcd * (q + 1) : r * (q + 1) + (xcd - r) * q) + off; }
        const int nig = WGM * nN, gid = wgid / nig, fm = gid * WGM, gsz = (nM - fm) < WGM ? (nM - fm) : WGM;
        u.pm = fm + ((wgid % nig) % gsz); u.pn = (wgid % nig) / gsz; return true;
    }
    __device__ __forceinline__ void a_ready(const Unit&) const {}
    __device__ __forceinline__ void done(const Unit&) const {}
};
__device__ __forceinline__ unsigned cvt_pk_bf16(float lo, float hi) { unsigned r; asm volatile("v_cvt_pk_bf16_f32 %0, %1, %2" : "=v"(r) : "v"(lo), "v"(hi)); return r; }
typedef float f32x2 __attribute__((ext_vector_type(2)));
__device__ __forceinline__ f32x2 gelu_pk(f32x2 v) {
    const f32x2 av = __builtin_elementwise_abs(v), d = av * 0.2316418882f + 1.0f;
    f32x2 t; t.x = __builtin_amdgcn_rcpf(d.x); t.y = __builtin_amdgcn_rcpf(d.y);
    f32x2 q = t * 0.5307027145f + (-0.7265760135f); q = q * t + 0.7107068705f; q = q * t + (-0.142248368f); q = q * t + 0.127414796f; q = q * t;
    const f32x2 s = (v * v) * (-0.72134752044f);
    f32x2 e; e.x = __builtin_amdgcn_exp2f(s.x); e.y = __builtin_amdgcn_exp2f(s.y);
    const f32x2 m = v * (q * e), r = v - m;
    f32x2 o; o.x = v.x < 0.f ? m.x : r.x; o.y = v.y < 0.f ? m.y : r.y; return o;
}
template <int ACT  > struct EpiBf16 {
    static constexpr bool PERM = true, AFTER_DRAIN = false;
    bf16_t* O; int ldc; const float* bias; int split_cols; size_t split_stride;
    __device__ __forceinline__ void operator()(const f32x4 (&acc)[2][2][4][2], const Unit& u, int wr, int wc, int fr, int fq) const {
        const int row0 = u.pm * BM + wr * 64 + fr; int colt = u.pn * BM; bf16_t* base = O;
        if (split_cols) { const int t = colt / split_cols; base += (size_t)t * split_stride; colt -= t * split_cols; }
        const int col0 = colt + wc * 32 + 8 * fq, bcol0 = u.pn * BM + wc * 32 + 8 * fq;
        f32x4 bv[2][2];
#pragma unroll
        for (int bj = 0; bj < 2; ++bj)
#pragma unroll
            for (int n = 0; n < 2; ++n) bv[bj][n] = bias ? *(const f32x4*)(bias + bcol0 + bj * HALF + 4 * n) : (f32x4){0.f, 0.f, 0.f, 0.f};
#pragma unroll
        for (int ai = 0; ai < 2; ++ai)
#pragma unroll
            for (int m = 0; m < 4; ++m) { bf16_t* rowp = base + (size_t)(row0 + ai * HALF + m * 16) * ldc + col0;
#pragma unroll
                for (int bj = 0; bj < 2; ++bj) { f32x4 v0 = acc[ai][bj][m][0] + bv[bj][0], v1 = acc[ai][bj][m][1] + bv[bj][1];
                    if (ACT == 1) { f32x2 a = gelu_pk((f32x2){v0[0], v0[1]}), b = gelu_pk((f32x2){v0[2], v0[3]}), c = gelu_pk((f32x2){v1[0], v1[1]}), d = gelu_pk((f32x2){v1[2], v1[3]});
                        v0 = (f32x4){a.x, a.y, b.x, b.y}; v1 = (f32x4){c.x, c.y, d.x, d.y}; }
                    if (ACT == 2) {
#pragma unroll
                        for (int j = 0; j < 4; ++j) { v0[j] = 0.5f * v0[j] * (1.0f + erff(v0[j] * 0.70710678f)); v1[j] = 0.5f * v1[j] * (1.0f + erff(v1[j] * 0.70710678f)); } }
                    u32x4 w; w.x = cvt_pk_bf16(v0[0], v0[1]); w.y = cvt_pk_bf16(v0[2], v0[3]); w.z = cvt_pk_bf16(v1[0], v1[1]); w.w = cvt_pk_bf16(v1[2], v1[3]);
                    *(u32x4*)(rowp + bj * HALF) = w; } }
    }
};
template <class Epi, class Sched, bool STAMP = false>
__device__ __forceinline__ void gemm_phase(PG8_LAS unsigned char* lds, const Gemm g, const Sched& S, const Epi& E, unsigned long long* stamps) {
    int tid = threadIdx.x; asm volatile("" : "+v"(tid)); const int wid = __builtin_amdgcn_readfirstlane(tid >> 6), lane = tid & 63, wr = wid >> 2, wc = wid & 3, fr = lane & 15, fq = lane >> 4;
    const int K = g.K, nt = K / BK;
    int ts_lo = 0, ts_hi = 0, nts = 0; const unsigned long long rt_entry = STAMP ? (unsigned long long)wall_clock64() : 0ull;
#define PG8_STAMP() do { if (STAMP && wid == 0 && nts < 64) { const unsigned long long _c = (unsigned long long)clock64(); \
        ts_lo = (lane == nts) ? (int)(unsigned)_c : ts_lo; ts_hi = (lane == nts) ? (int)(unsigned)(_c >> 32) : ts_hi; ++nts; } } while (0)
    PG8_STAMP();
    unsigned voffA[2], voffB[2];
#pragma unroll
    for (int i = 0; i < 2; ++i) { int R, C; stage_rc(tid * 16 + i * 8192, R, C); const int Rb = Epi::PERM ? ((R & ~31) + perm32(R & 31)) : R;
        voffA[i] = (unsigned)(R * K + C) * 2u; voffB[i] = (unsigned)(Rb * K + C) * 2u; }
    const size_t kstep = (size_t)(BK * 2);
    const size_t hstep = (size_t)HALF * K * 2;
    const size_t tstep = 2 * hstep;
    const unsigned ldsw = (unsigned)wid * 1024u;
    const int aoff = lds_byte(wr * 64 + fr, fq * 8), boff = lds_byte(wc * 32 + fr, fq * 8);
#define PG8_SA(b, h) (((b) * 2 + (h)) * HTB)
#define PG8_SB(b, h) ((4 + (b) * 2 + (h)) * HTB)
#define PG8_STAGE(bufoff, gbase, voff) do { _Pragma("unroll") for (int _i = 0; _i < 2; ++_i) \
        __builtin_amdgcn_global_load_lds((const unsigned*)((const char*)(gbase) + (voff)[_i]), (PG8_LAS unsigned*)(lds + (bufoff) + ldsw + _i * 8192), 16, 0, 0); } while (0)
#define PG8_LDA(dst, b, h) do { _Pragma("unroll") for (int m = 0; m < 4; ++m) _Pragma("unroll") for (int k = 0; k < 2; ++k) dst[m][k] = *(const PG8_LAS bf16x8*)(lds + PG8_SA(b, h) + aoff + m * 2048 + k * 1024); } while (0)
#define PG8_LDB(dst, b, h) do { _Pragma("unroll") for (int n = 0; n < 2; ++n) _Pragma("unroll") for (int k = 0; k < 2; ++k) dst[n][k] = *(const PG8_LAS bf16x8*)(lds + PG8_SB(b, h) + boff + n * 2048 + k * 1024); } while (0)
#define PG8_MMA(ai, bj, At, Bt) do { __builtin_amdgcn_s_setprio(1); _Pragma("unroll") for (int m = 0; m < 4; ++m) _Pragma("unroll") for (int n = 0; n < 2; ++n) _Pragma("unroll") for (int k = 0; k < 2; ++k) \
        acc[ai][bj][m][n] = __builtin_amdgcn_mfma_f32_16x16x32_bf16(Bt[n][k], At[m][k], acc[ai][bj][m][n], 0, 0, 0); __builtin_amdgcn_s_setprio(0); } while (0)
#define PG8_WAIT_V(n) asm volatile("s_waitcnt vmcnt(" #n ")" ::: "memory")
#define PG8_WAIT_L(n) asm volatile("s_waitcnt lgkmcnt(" #n ")" ::: "memory")
#define PG8_BAR __builtin_amdgcn_s_barrier()
#define PG8_SCHED __builtin_amdgcn_sched_barrier(0)
    Unit cur, nxt; int ui = 0;
    if (!S.next(0, cur)) return;
    f32x4 acc[2][2][4][2];
#pragma unroll
    for (int a = 0; a < 2; ++a)
#pragma unroll
        for (int b = 0; b < 2; ++b)
#pragma unroll
            for (int m = 0; m < 4; ++m)
#pragma unroll
                for (int n = 0; n < 2; ++n) acc[a][b][m][n] = (f32x4){0.f, 0.f, 0.f, 0.f};
    bf16x8 At[4][2], B0[2][2], B1[2][2];
    const char* cA = (const char*)g.A + (size_t)cur.pm * tstep; const char* cB = (const char*)g.Bt + (size_t)cur.pn * tstep;
    S.a_ready(cur);
    PG8_STAGE(PG8_SB(0, 0), cB, voffB); PG8_STAGE(PG8_SA(0, 0), cA, voffA); PG8_STAGE(PG8_SB(0, 1), cB + hstep, voffB); PG8_STAGE(PG8_SA(0, 1), cA + hstep, voffA);
    if (wr == 1) PG8_BAR;
    PG8_WAIT_V(4); PG8_BAR;
    PG8_STAGE(PG8_SB(1, 0), cB + kstep, voffB); PG8_STAGE(PG8_SA(1, 0), cA + kstep, voffA); PG8_STAGE(PG8_SB(1, 1), cB + hstep + kstep, voffB);
    PG8_WAIT_V(6); PG8_BAR;
    PG8_STAMP();
    for (;;) {
        const bool has_next = S.next(ui + 1, nxt);
        const char* nA = has_next ? (const char*)g.A + (size_t)nxt.pm * tstep : cA; const char* nB = has_next ? (const char*)g.Bt + (size_t)nxt.pn * tstep : cB;
        for (int t = 0; t < nt; t += 2) {
            const bool last = (t == nt - 2);
            const char* a1 = cA + (size_t)(t + 1) * kstep;
            const char* a2 = last ? nA : cA + (size_t)(t + 2) * kstep; const char* b2 = last ? nB : cB + (size_t)(t + 2) * kstep;
            const char* a3 = a2 + kstep; const char* b3 = b2 + kstep;
            if (last && has_next) S.a_ready(nxt);
            PG8_LDB(B0, 0, 0); PG8_SCHED; PG8_LDA(At, 0, 0); PG8_STAGE(PG8_SA(1, 1), a1 + hstep, voffA);
            PG8_WAIT_L(8); PG8_BAR; PG8_WAIT_L(0); PG8_MMA(0, 0, At, B0); PG8_BAR; PG8_SCHED;
            PG8_LDB(B1, 0, 1); PG8_STAGE(PG8_SB(0, 0), b2, voffB);
            PG8_BAR; PG8_WAIT_L(0); PG8_MMA(0, 1, At, B1); PG8_BAR;
            PG8_LDA(At, 0, 1); PG8_STAGE(PG8_SA(0, 0), a2, voffA);
            PG8_BAR; PG8_WAIT_L(0); PG8_MMA(1, 0, At, B0); PG8_BAR; PG8_SCHED;
            PG8_STAGE(PG8_SB(0, 1), b2 + hstep, voffB);
            PG8_WAIT_V(6); PG8_BAR; PG8_MMA(1, 1, At, B1); PG8_BAR;
            PG8_LDB(B0, 1, 0); PG8_SCHED; PG8_LDA(At, 1, 0); PG8_STAGE(PG8_SA(0, 1), a2 + hstep, voffA);
            PG8_WAIT_L(8); PG8_BAR; PG8_WAIT_L(0); PG8_MMA(0, 0, At, B0); PG8_BAR; PG8_SCHED;
            PG8_LDB(B1, 1, 1); PG8_STAGE(PG8_SB(1, 0), b3, voffB);
            PG8_BAR; PG8_WAIT_L(0); PG8_MMA(0, 1, At, B1); PG8_BAR;
            PG8_LDA(At, 1, 1); PG8_STAGE(PG8_SA(1, 0), a3, voffA);
            PG8_BAR; PG8_WAIT_L(0); PG8_MMA(1, 0, At, B0); PG8_BAR; PG8_SCHED;
            PG8_STAGE(PG8_SB(1, 1), b3 + hstep, voffB);
            PG8_WAIT_V(6); PG8_BAR; PG8_MMA(1, 1, At, B1); PG8_BAR;
        }
        PG8_STAMP();
        if constexpr (!Epi::AFTER_DRAIN) { E(acc, cur, wr, wc, fr, fq); S.done(cur); }
        PG8_STAMP();
        if (!has_next) break;
#pragma unroll
        for (int a = 0; a < 2; ++a)
#pragma unroll
            for (int b = 0; b < 2; ++b)
#pragma unroll
                for (int m = 0; m < 4; ++m)
#pragma unroll
                    for (int n = 0; n < 2; ++n) acc[a][b][m][n] = (f32x4){0.f, 0.f, 0.f, 0.f};
        cur = nxt; cA = nA; cB = nB; ++ui;
    }
    PG8_WAIT_V(0);
    if (wr == 0) PG8_BAR;
    PG8_BAR;
    if constexpr (Epi::AFTER_DRAIN) { E.fused(acc, cur, wr, wc, fr, fq, lds, wid, lane); S.done(cur); }
    PG8_STAMP();
    if (STAMP && wid == 0) { stamps[lane] = lane < nts ? (((unsigned long long)(unsigned)ts_hi << 32) | (unsigned)ts_lo) : 0ull;
        if (lane == 62) stamps[62] = rt_entry; if (lane == 63) stamps[63] = (unsigned long long)wall_clock64(); }
#undef PG8_STAMP
#undef PG8_SA
#undef PG8_SB
#undef PG8_STAGE
#undef PG8_LDA
#undef PG8_LDB
#undef PG8_MMA
#undef PG8_WAIT_V
#undef PG8_WAIT_L
#undef PG8_BAR
#undef PG8_SCHED
}
}

#define XB_TMO      128
#define XB_XCNT(j)  (256  + 64 * (j))
#define XB_XSUB(j)  (1280 + 64 * (j))
#define XB_XGEN(j)  (2304 + 64 * (j))
#define XB_TOP      3328
#define XB_TOPGEN   3392
#define XCD_BAR_WORDS 3456
#define XB_SPIN_CAP (1u << 22)
#define LAS __attribute__((address_space(3)))

__device__ __forceinline__ unsigned xb_ld(unsigned* p)              { return __hip_atomic_load(p, __ATOMIC_RELAXED, __HIP_MEMORY_SCOPE_AGENT); }
__device__ __forceinline__ unsigned xb_add(unsigned* p, unsigned v) { return __hip_atomic_fetch_add(p, v, __ATOMIC_RELAXED, __HIP_MEMORY_SCOPE_AGENT); }
__device__ __forceinline__ unsigned xb_xcc_id() { return (unsigned)__builtin_amdgcn_s_getreg((3 << 11) | 20) & 0xFu; }
#define XB_SPIN(cond, bar) do { unsigned _sp = 0; while (cond) { __builtin_amdgcn_s_sleep(1); \
    if ((++_sp & 255u) == 0u) { if (xb_ld(&(bar)[XB_TMO])) break; if (_sp > XB_SPIN_CAP) { atomicAdd(&(bar)[XB_TMO], 1u); break; } } } } while (0)

struct XcdBarrier { unsigned* bar; unsigned x; volatile LAS unsigned* st; };

__device__ __forceinline__ XcdBarrier xcd_barrier_post(unsigned* bar, volatile LAS unsigned* st) {
    XcdBarrier b; b.bar = bar; b.x = xb_xcc_id(); b.st = st;
    if (threadIdx.x == 0) (void)xb_add(&bar[XB_XCNT(b.x)], 1u);
    return b;
}
__device__ __forceinline__ void xcd_barrier_complete(unsigned* bar, unsigned x, unsigned& nloc, unsigned& nx) {
    const unsigned G = gridDim.x * gridDim.y * gridDim.z;
    unsigned sum, cnt, mine, sp = 0u;
    for (;;) {
        sum = 0u; cnt = 0u; mine = 0u;
#pragma unroll
        for (unsigned j = 0; j < 16; ++j) { const unsigned c = xb_ld(&bar[XB_XCNT(j)]); sum += c; cnt += (c > 0u) ? 1u : 0u; mine = (j == x) ? c : mine; }
        if (sum == G) break;
        __builtin_amdgcn_s_sleep(1);
        if ((++sp & 255u) == 0u) { if (xb_ld(&bar[XB_TMO])) break; if (sp > XB_SPIN_CAP) { atomicAdd(&bar[XB_TMO], 1u); break; } }
    }
    nloc = mine > 0u ? mine : 1u; nx = cnt > 0u ? cnt : 1u;
}
__device__ __forceinline__ void xcd_barrier(const XcdBarrier& b) {
    asm volatile("s_waitcnt vmcnt(0)" ::: "memory");
    __syncthreads();
    if (threadIdx.x == 0) {
        unsigned* bar = b.bar;
        __builtin_amdgcn_s_waitcnt(0);
        unsigned nloc = b.st[0], nx = b.st[1];
        if (nloc == 0u) { xcd_barrier_complete(bar, b.x, nloc, nx); b.st[0] = nloc; b.st[1] = nx; }
        const unsigned old = xb_add(&bar[XB_XSUB(b.x)], 1u);
        const unsigned gen = old / nloc;
        if (old + 1u == (gen + 1u) * nloc) {
            __builtin_amdgcn_fence(__ATOMIC_RELEASE, "agent");
            asm volatile("s_waitcnt vmcnt(0)" ::: "memory");
            const unsigned og = xb_add(&bar[XB_TOP], 1u);
            const unsigned tg = og / nx;
            if (og + 1u == (tg + 1u) * nx) xb_add(&bar[XB_TOPGEN], 1u);
            else XB_SPIN(xb_ld(&bar[XB_TOPGEN]) == tg, bar);
            __builtin_amdgcn_fence(__ATOMIC_ACQUIRE, "agent");
            xb_add(&bar[XB_XGEN(b.x)], 1u);
            asm volatile("s_waitcnt vmcnt(0)" ::: "memory");
        } else {
            XB_SPIN(xb_ld(&bar[XB_XGEN(b.x)]) == gen, bar);
            __builtin_amdgcn_fence(__ATOMIC_ACQUIRE, "agent");
            asm volatile("s_waitcnt vmcnt(0)" ::: "memory");
        }
    }
    __syncthreads();
}

typedef unsigned short u16;
using pg8::bf16x8; using pg8::f32x4; using pg8::u32x4;
typedef float f32x2v __attribute__((ext_vector_type(2)));

constexpr int DM = 2048, NB = 4, SEQL = 4096, CTXL = 256, NLAT = NB * SEQL, NCTX = NB * CTXL, MROWS = NLAT + NCTX;
constexpr int DEPTH = 4, NMAIN = 3072, NTR = 1536;
constexpr int PJ_Q = 0, PJ_K = 1024, PJ_SU = 2048, PJ_SIN = 2560;
constexpr int TR_V = 0, TR_SV = 1024;
constexpr int NCHK = 68;
constexpr float EPSN = 1e-6f;

constexpr size_t al256(size_t x) { return (x + 255) & ~(size_t)255; }
constexpr size_t WS_BAR   = 0;
constexpr size_t WS_MOD   = 16384;
constexpr size_t WS_MODP  = al256(WS_MOD + (size_t)DEPTH * 5 * 6 * DM * 4);
constexpr size_t WS_X     = al256(WS_MODP + (size_t)16 * DEPTH * 5 * 6 * DM * 4);
constexpr size_t WS_H     = al256(WS_X + (size_t)MROWS * DM * 4);
constexpr size_t WS_PROJ  = al256(WS_H + (size_t)MROWS * DM * 2);
constexpr size_t WS_TR    = al256(WS_PROJ + (size_t)MROWS * NMAIN * 2);
constexpr size_t WS_ATT   = al256(WS_TR + (size_t)NTR * MROWS * 2);
constexpr size_t WS_SGU   = al256(WS_ATT + (size_t)MROWS * 1024 * 2);
constexpr size_t WS_S5Y   = al256(WS_SGU + (size_t)MROWS * 512 * 2);
constexpr size_t WS_S5O   = al256(WS_S5Y + (size_t)MROWS * 512 * 2);
constexpr size_t WS_YIN   = al256(WS_S5O + (size_t)MROWS * 512 * 2);
constexpr size_t WS_PQ    = al256(WS_YIN + (size_t)MROWS * DM * 2);
constexpr size_t WS_EID   = al256(WS_PQ + (size_t)MROWS * DM * 2);
constexpr size_t WS_GATE  = al256(WS_EID + (size_t)MROWS * 128 * 2);
constexpr size_t WS_SLOC  = al256(WS_GATE + (size_t)MROWS * 128 * 4);
constexpr size_t WS_WTS   = al256(WS_SLOC + (size_t)NB * 32 * 2 * NCHK * 64 * 8);
constexpr size_t WL_MAIN = 0;
constexpr size_t WL_TR   = WL_MAIN + (size_t)NMAIN * DM * 2;
constexpr size_t WL_OUT  = WL_TR + (size_t)NTR * DM * 2;
constexpr size_t WL_Q    = WL_OUT + (size_t)DM * DM * 2;
constexpr size_t WL_GLU  = WL_Q + (size_t)DM * DM * 2;
constexpr size_t WL_K12  = WL_GLU + (size_t)512 * 512 * 2;
constexpr size_t WL_U    = WL_K12 + (size_t)2 * 8 * 128 * 128 * 2;
constexpr size_t WL_V    = WL_U + (size_t)16384 * DM * 2;
constexpr size_t WL_SIZE = al256(WL_V + (size_t)16384 * DM * 2);
constexpr size_t WS_END  = WS_WTS + DEPTH * WL_SIZE;

constexpr int LDS_BYTES = 147456;
constexpr int LDS_BARW  = LDS_BYTES - 16;

enum { I_X = 0, I_C, I_CTX, I_CCTX, I_ADAW, I_ADAB, I_NMIX, I_NFFN, I_WIN, I_WOUT, I_ONORM, I_RPB, I_SGUW, I_SGUB, I_SGUN, I_ARE, I_AIM, I_LOGDT, I_BRE, I_BIM, I_CRE, I_CIM, I_S5D, I_GLUW, I_GLUB,
       I_WQ, I_K1, I_K2, I_PU, I_PV, I_FNORM, N_IN };

struct Args { const float* in[N_IN]; float* out; unsigned char* ws; int ph_lo, ph_hi; };

struct Ctx {
    const float* in[N_IN]; float* out; unsigned char* ws; LAS unsigned char* lds;
    int tid, lane, wave, G, bid;
    float* MOD; float* MODP; float* X; u16* H; u16* PROJ; u16* TR; u16* ATT; u16* SGU; u16* S5Y; u16* S5O; u16* YIN; u16* PQ; u16* EID; float* GATE; f32x2v* SLOC;
    __device__ __forceinline__ unsigned char* wl(int l) const { return ws + WS_WTS + (size_t)l * WL_SIZE; }
    __device__ __forceinline__ void fresh() { int t = threadIdx.x; asm volatile("" : "+v"(t)); tid = t; lane = t & 63; wave = __builtin_amdgcn_readfirstlane(t >> 6); }
};

__device__ __forceinline__ float bf2f(u16 v) { return __uint_as_float(((unsigned)v) << 16); }
__device__ __forceinline__ float bflo(unsigned v) { return __uint_as_float(v << 16); }
__device__ __forceinline__ float bfhi(unsigned v) { return __uint_as_float(v & 0xffff0000u); }
__device__ __forceinline__ u16 f2bf(float f) { unsigned u = __float_as_uint(f); u += 0x7FFFu + ((u >> 16) & 1u); return (u16)(u >> 16); }
__device__ __forceinline__ unsigned pk2(float lo, float hi) { return pg8::cvt_pk_bf16(lo, hi); }
__device__ __forceinline__ float gelu_f(float x) { return 0.5f * x * (1.0f + erff(x * 0.70710678118654752f)); }
__device__ __forceinline__ float wave_sum(float v) {
    v += __shfl_xor(v, 32); v += __shfl_xor(v, 16); v += __shfl_xor(v, 8); v += __shfl_xor(v, 4); v += __shfl_xor(v, 2); v += __shfl_xor(v, 1); return v;
}
__device__ __forceinline__ int row_bidx(int row) { return row < NLAT ? (row >> 12) : 4; }
__device__ __forceinline__ void lds_fence() { asm volatile("s_waitcnt lgkmcnt(0)" ::: "memory"); }

__device__ __forceinline__ void tr_tile(const Ctx& c, const float* src, int ld, int k0, int n0, u16* dst, int drow0) {
    LAS float* T = (LAS float*)c.lds;
    const int t = c.tid;
#pragma unroll
    for (int i = 0; i < 8; ++i) { const int r = (t >> 6) + 8 * i; T[r * 65 + (t & 63)] = src[(size_t)(k0 + r) * ld + n0 + (t & 63)]; }
    __syncthreads();
#pragma unroll
    for (int i = 0; i < 4; ++i) { const int n = (t >> 5) + 16 * i, kp = t & 31;
        const unsigned v = pk2(T[(2 * kp) * 65 + n], T[(2 * kp + 1) * 65 + n]);
        *(unsigned*)(dst + (size_t)(drow0 + n) * DM + k0 + 2 * kp) = v; }
    __syncthreads();
}

__device__ __forceinline__ void phase_prologue(const Ctx& c) {
    const int G = c.G, bid = c.bid, tid = c.tid;
    {
        const size_t n4 = (size_t)MROWS * DM / 4, nl4 = (size_t)NLAT * DM / 4;
        const float4* sx = (const float4*)c.in[I_X]; const float4* sc = (const float4*)c.in[I_CTX]; float4* dx = (float4*)c.X;
        for (size_t i = (size_t)bid * 512 + tid; i < n4; i += (size_t)G * 512) dx[i] = i < nl4 ? sx[i] : sc[i - nl4];
    }
    for (int l = 0; l < DEPTH; ++l) {
        unsigned char* W = c.wl(l);
        const float* win = c.in[I_WIN] + (size_t)l * DM * 4608;
        for (int it = bid; it < 32 * 72; it += G) {
            const int kt = it & 31, nt = it >> 5, n0 = nt * 64;
            u16* dst; int drow;
            if (n0 < 2048) { dst = (u16*)(W + WL_MAIN); drow = n0; }
            else if (n0 < 3072) { dst = (u16*)(W + WL_TR); drow = n0 - 2048; }
            else if (n0 < 3584) { dst = (u16*)(W + WL_MAIN); drow = 2048 + (n0 - 3072); }
            else if (n0 < 4096) { dst = (u16*)(W + WL_TR); drow = 1024 + (n0 - 3584); }
            else { dst = (u16*)(W + WL_MAIN); drow = 2560 + (n0 - 4096); }
            tr_tile(c, win, 4608, kt * 64, n0, dst, drow);
        }
        const float* wout = c.in[I_WOUT] + (size_t)l * DM * DM;
        for (int it = bid; it < 32 * 32; it += G) tr_tile(c, wout, DM, (it & 31) * 64, (it >> 5) * 64, (u16*)(W + WL_OUT), (it >> 5) * 64);
        const float* wq = c.in[I_WQ] + (size_t)l * DM * DM;
        for (int it = bid; it < 32 * 32; it += G) tr_tile(c, wq, DM, (it & 31) * 64, (it >> 5) * 64, (u16*)(W + WL_Q), (it >> 5) * 64);
        {
            const float* gw = c.in[I_GLUW] + (size_t)l * 512 * 512; u16* dst = (u16*)(W + WL_GLU);
            LAS float* T = (LAS float*)c.lds;
            for (int it = bid; it < 8 * 8; it += G) {
                const int k0 = (it & 7) * 64, n0 = (it >> 3) * 64, t = tid;
#pragma unroll
                for (int i = 0; i < 8; ++i) { const int r = (t >> 6) + 8 * i; T[r * 65 + (t & 63)] = gw[(size_t)(k0 + r) * 512 + n0 + (t & 63)]; }
                __syncthreads();
#pragma unroll
                for (int i = 0; i < 4; ++i) { const int n = (t >> 5) + 16 * i, kp = t & 31;
                    *(unsigned*)(dst + (size_t)(n0 + n) * 512 + k0 + 2 * kp) = pk2(T[(2 * kp) * 65 + n], T[(2 * kp + 1) * 65 + n]); }
                __syncthreads();
            }
        }
        {
            u16* dst = (u16*)(W + WL_K12);
            const float* k1 = c.in[I_K1] + (size_t)l * 8 * 128 * 128; const float* k2 = c.in[I_K2] + (size_t)l * 8 * 128 * 128;
            for (int i = bid * 512 + tid; i < 2 * 131072 / 2; i += G * 512) {
                const int e = 2 * i; const float* s = e < 131072 ? k1 + e : k2 + (e - 131072);
                *(unsigned*)(dst + e) = pk2(s[0], s[1]);
            }
        }
        {
            const size_t n8 = (size_t)16384 * DM / 8;
            const float4* su = (const float4*)(c.in[I_PU] + (size_t)l * 16384 * DM); const float4* sv = (const float4*)(c.in[I_PV] + (size_t)l * 16384 * DM);
            u32x4* du = (u32x4*)(W + WL_U); u32x4* dv = (u32x4*)(W + WL_V);
            for (size_t i = (size_t)bid * 512 + tid; i < n8; i += (size_t)G * 512) {
                const float4 a = su[2 * i], b = su[2 * i + 1]; u32x4 o; o.x = pk2(a.x, a.y); o.y = pk2(a.z, a.w); o.z = pk2(b.x, b.y); o.w = pk2(b.z, b.w); du[i] = o;
                const float4 a2 = sv[2 * i], b2 = sv[2 * i + 1]; u32x4 o2; o2.x = pk2(a2.x, a2.y); o2.y = pk2(a2.z, a2.w); o2.z = pk2(b2.x, b2.y); o2.w = pk2(b2.z, b2.w); dv[i] = o2;
            }
        }
    }
    {
        LAS float* S = (LAS float*)c.lds;
        for (int it = bid; it < DEPTH * 24 * 16; it += G) {
            const int kc = it & 15, nb = (it >> 4) % 24, l = it / (16 * 24);
            __syncthreads();
            for (int i = tid; i < 640; i += 512) { const int r = i >> 7, kk = i & 127; const float v = r < 4 ? c.in[I_C][r * DM + kc * 128 + kk] : c.in[I_CCTX][kc * 128 + kk]; S[i] = v / (1.0f + __expf(-v)); }
            __syncthreads();
            const int n = nb * 512 + tid; const float* w = c.in[I_ADAW] + ((size_t)l * DM + kc * 128) * 12288 + n;
            float a0 = 0.f, a1 = 0.f, a2 = 0.f, a3 = 0.f, a4 = 0.f;
#pragma unroll 8
            for (int kk = 0; kk < 128; ++kk) { const float wv = w[(size_t)kk * 12288]; a0 += S[kk] * wv; a1 += S[128 + kk] * wv; a2 += S[256 + kk] * wv; a3 += S[384 + kk] * wv; a4 += S[512 + kk] * wv; }
            float* o = c.MODP + ((size_t)(kc * DEPTH + l) * 5) * 12288 + n;
            o[0] = a0; o[12288] = a1; o[2 * 12288] = a2; o[3 * 12288] = a3; o[4 * 12288] = a4;
        }
        __syncthreads();
    }
}

__device__ __forceinline__ void phase_modfin(const Ctx& c) {
    const int total = DEPTH * 5 * 12288;
    for (int i = c.bid * 512 + c.tid; i < total; i += c.G * 512) {
        const int n = i % 12288, l = i / (5 * 12288);
        float s = c.in[I_ADAB][l * 12288 + n];
#pragma unroll
        for (int kc = 0; kc < 16; ++kc) s += c.MODP[(size_t)kc * total + i];
        c.MOD[i] = s;
    }
}

__device__ __forceinline__ void phase_normmod(const Ctx& c, int l, int which, int nrows) {
    const float* gain = (which ? c.in[I_NFFN] : c.in[I_NMIX]) + (size_t)l * DM;
    for (int row = c.bid * 8 + c.wave; row < nrows; row += c.G * 8) {
        const float4* xp = (const float4*)(c.X + (size_t)row * DM);
        const int bi = row_bidx(row);
        const float* sh = c.MOD + ((size_t)(l * 5 + bi) * 6 + (which ? 3 : 0)) * DM; const float* sc = sh + DM;
        float4 v[8]; float ss = 0.f;
#pragma unroll
        for (int i = 0; i < 8; ++i) { v[i] = xp[c.lane + 64 * i]; ss += v[i].x * v[i].x + v[i].y * v[i].y + v[i].z * v[i].z + v[i].w * v[i].w; }
        ss = wave_sum(ss);
        const float rstd = rsqrtf(ss * (1.0f / DM) + EPSN);
        uint2* hp = (uint2*)(c.H + (size_t)row * DM);
#pragma unroll
        for (int i = 0; i < 8; ++i) {
            const int e = 4 * (c.lane + 64 * i);
            const float4 g = *(const float4*)(gain + e), s1 = *(const float4*)(sc + e), s0 = *(const float4*)(sh + e);
            const float y0 = v[i].x * rstd * g.x * (1.f + s1.x) + s0.x, y1 = v[i].y * rstd * g.y * (1.f + s1.y) + s0.y;
            const float y2 = v[i].z * rstd * g.z * (1.f + s1.z) + s0.z, y3 = v[i].w * rstd * g.w * (1.f + s1.w) + s0.w;
            uint2 o; o.x = pk2(y0, y1); o.y = pk2(y2, y3); hp[c.lane + 64 * i] = o;
        }
    }
}

struct EpiResid {
    static constexpr bool PERM = false, AFTER_DRAIN = false;
    float* X; const float* modl;
    __device__ __forceinline__ void operator()(const f32x4 (&acc)[2][2][4][2], const pg8::Unit& u, int wr, int wc, int fr, int fq) const {
        const int row0 = u.pm * 256 + wr * 64 + fr, col0 = u.pn * 256 + wc * 32 + 4 * fq;
        const int bi = row_bidx(u.pm * 256);
        const float* gp = modl + ((size_t)bi * 6 + 2) * DM + col0;
        f32x4 gv[2][2];
#pragma unroll
        for (int bj = 0; bj < 2; ++bj)
#pragma unroll
            for (int n = 0; n < 2; ++n) gv[bj][n] = *(const f32x4*)(gp + bj * 128 + n * 16);
#pragma unroll
        for (int ai = 0; ai < 2; ++ai)
#pragma unroll
            for (int m = 0; m < 4; ++m) { float* rowp = X + (size_t)(row0 + ai * 128 + m * 16) * DM + col0;
#pragma unroll
                for (int bj = 0; bj < 2; ++bj)
#pragma unroll
                    for (int n = 0; n < 2; ++n) { f32x4* p = (f32x4*)(rowp + bj * 128 + n * 16); *p = *p + gv[bj][n] * acc[ai][bj][m][n]; } }
    }
};
struct EpiGlu {
    static constexpr bool PERM = true, AFTER_DRAIN = false;
    const u16* Y; u16* O; const float* bias;
    __device__ __forceinline__ void operator()(const f32x4 (&acc)[2][2][4][2], const pg8::Unit& u, int wr, int wc, int fr, int fq) const {
        const int row0 = u.pm * 256 + wr * 64 + fr, col0 = u.pn * 256 + wc * 32 + 8 * fq;
        f32x4 bv[2][2];
#pragma unroll
        for (int bj = 0; bj < 2; ++bj)
#pragma unroll
            for (int n = 0; n < 2; ++n) bv[bj][n] = *(const f32x4*)(bias + col0 + bj * 128 + 4 * n);
#pragma unroll
        for (int ai = 0; ai < 2; ++ai)
#pragma unroll
            for (int m = 0; m < 4; ++m) { const size_t off = (size_t)(row0 + ai * 128 + m * 16) * 512 + col0;
#pragma unroll
                for (int bj = 0; bj < 2; ++bj) {
                    const u32x4 yv = *(const u32x4*)(Y + off + bj * 128);
                    const f32x4 v0 = acc[ai][bj][m][0] + bv[bj][0], v1 = acc[ai][bj][m][1] + bv[bj][1];
                    float y[8] = {bflo(yv.x), bfhi(yv.x), bflo(yv.y), bfhi(yv.y), bflo(yv.z), bfhi(yv.z), bflo(yv.w), bfhi(yv.w)};
                    float z[8] = {v0[0], v0[1], v0[2], v0[3], v1[0], v1[1], v1[2], v1[3]};
#pragma unroll
                    for (int j = 0; j < 8; ++j) y[j] = y[j] / (1.0f + __expf(-z[j]));
                    u32x4 w; w.x = pk2(y[0], y[1]); w.y = pk2(y[2], y[3]); w.z = pk2(y[4], y[5]); w.w = pk2(y[6], y[7]);
                    *(u32x4*)(O + off + bj * 128) = w; } }
    }
};

template <bool LOCAL>
__device__ __forceinline__ void attn_item(const Ctx& c, int l, int b, int r, int head, int qt) {
    constexpr int NG = LOCAL ? 16 : 8;
    const int lane = c.lane, n = lane & 15, lg = lane >> 4;
    const int qrow0 = LOCAL ? (b * SEQL + r * 64 + 16 * qt) : (NLAT + b * CTXL + 16 * qt);
    const int r_start = LOCAL ? min(max(r - 4, 0), 56) : 0;
    const int cbase = LOCAL ? (qt == 0 ? 0 : (qt == 1 ? 8 : (qt == 2 ? 24 : 32))) : 0;
    bf16x8 qf[4];
    { const u16* qp = c.PROJ + (size_t)(qrow0 + n) * NMAIN + PJ_Q + head * 128 + 8 * lg;
#pragma unroll
      for (int kk = 0; kk < 4; ++kk) qf[kk] = *(const bf16x8*)(qp + 32 * kk); }
    f32x4 S[NG][2];
#pragma unroll
    for (int gi = 0; gi < NG; ++gi) {
        const int base = (LOCAL && gi < 8) ? (b * SEQL + (r_start + gi) * 64 + cbase) : (NLAT + b * CTXL + 32 * (gi - (LOCAL ? 8 : 0)));
#pragma unroll
        for (int t = 0; t < 2; ++t) {
            const int tok = base + 8 * (n >> 2) + 4 * t + (n & 3);
            const u16* kp = c.PROJ + (size_t)tok * NMAIN + PJ_K + head * 128 + 8 * lg;
            f32x4 acc = {0.f, 0.f, 0.f, 0.f};
#pragma unroll
            for (int kk = 0; kk < 4; ++kk) { const bf16x8 a = *(const bf16x8*)(kp + 32 * kk); acc = __builtin_amdgcn_mfma_f32_16x16x32_bf16(a, qf[kk], acc, 0, 0, 0); }
            S[gi][t] = acc;
        }
    }
    const float scale = 0.08838834764831845f;
    float mx = -3.0e38f;
    const int qc = 16 * qt + n, cs = min(max(qc - 8, 0), 48);
#pragma unroll
    for (int gi = 0; gi < NG; ++gi)
#pragma unroll
        for (int t = 0; t < 2; ++t)
#pragma unroll
            for (int rr = 0; rr < 4; ++rr) {
                float s = S[gi][t][rr] * scale;
                if (LOCAL && gi < 8) {
                    const int kc = cbase + 8 * lg + 4 * t + rr;
                    const bool valid = (kc >= cs) && (kc < cs + 16);
                    const int roff = (r_start + gi) - r + 7, coff = kc - qc + 15;
                    const int bidx = min(max(roff * 31 + coff, 0), 15 * 31 - 1);
                    const float bias = c.in[I_RPB][(size_t)(l * 8 + head) * 465 + bidx];
                    s = valid ? s + bias : -INFINITY;
                }
                S[gi][t][rr] = s; mx = fmaxf(mx, s);
            }
    mx = fmaxf(mx, __shfl_xor(mx, 16)); mx = fmaxf(mx, __shfl_xor(mx, 32));
    float sum = 0.f;
#pragma unroll
    for (int gi = 0; gi < NG; ++gi)
#pragma unroll
        for (int t = 0; t < 2; ++t)
#pragma unroll
            for (int rr = 0; rr < 4; ++rr) { const float p = exp2f((S[gi][t][rr] - mx) * 1.4426950408889634f); S[gi][t][rr] = p; sum += p; }
    sum += __shfl_xor(sum, 16); sum += __shfl_xor(sum, 32);
    const float inv = 1.0f / sum;
    f32x4 O[8];
#pragma unroll
    for (int dt = 0; dt < 8; ++dt) O[dt] = (f32x4){0.f, 0.f, 0.f, 0.f};
#pragma unroll
    for (int gi = 0; gi < NG; ++gi) {
        const int base = (LOCAL && gi < 8) ? (b * SEQL + (r_start + gi) * 64 + cbase) : (NLAT + b * CTXL + 32 * (gi - (LOCAL ? 8 : 0)));
        u32x4 pw; pw.x = pk2(S[gi][0][0], S[gi][0][1]); pw.y = pk2(S[gi][0][2], S[gi][0][3]); pw.z = pk2(S[gi][1][0], S[gi][1][1]); pw.w = pk2(S[gi][1][2], S[gi][1][3]);
        const bf16x8 pb = __builtin_bit_cast(bf16x8, pw);
        const u16* vp = c.TR + (size_t)(TR_V + head * 128 + n) * MROWS + base + 8 * lg;
#pragma unroll
        for (int dt = 0; dt < 8; ++dt) { const bf16x8 va = *(const bf16x8*)(vp + (size_t)(16 * dt) * MROWS); O[dt] = __builtin_amdgcn_mfma_f32_16x16x32_bf16(va, pb, O[dt], 0, 0, 0); }
    }
    u16* op = c.ATT + (size_t)(qrow0 + n) * 1024 + head * 128 + 4 * lg;
#pragma unroll
    for (int dt = 0; dt < 8; ++dt) { uint2 o; o.x = pk2(O[dt][0] * inv, O[dt][1] * inv); o.y = pk2(O[dt][2] * inv, O[dt][3] * inv); *(uint2*)(op + 16 * dt) = o; }
}

__device__ __forceinline__ void sgu_item(const Ctx& c, int l, int chunk) {
    const int tid = c.tid, lane = c.lane, n = lane & 15, lg = lane >> 4;
    const int tok0 = chunk < 128 ? chunk * 128 : NLAT + (chunk - 128) * 128;
    LAS float* part = (LAS float*)c.lds;
    LAS float* rstd = part + 32 * 128;
    __syncthreads();
    {
        const int sg = tid & 15, cg = tid >> 4;
        float a[8];
#pragma unroll
        for (int j = 0; j < 8; ++j) a[j] = 0.f;
        for (int cc = 0; cc < 16; ++cc) {
            const u32x4 v = *(const u32x4*)(c.TR + (size_t)(TR_SV + cg * 16 + cc) * MROWS + tok0 + 8 * sg);
            const float x[8] = {bflo(v.x), bfhi(v.x), bflo(v.y), bfhi(v.y), bflo(v.z), bfhi(v.z), bflo(v.w), bfhi(v.w)};
#pragma unroll
            for (int j = 0; j < 8; ++j) { const float g = gelu_f(x[j]); a[j] += g * g; }
        }
#pragma unroll
        for (int j = 0; j < 8; ++j) part[cg * 128 + 8 * sg + j] = a[j];
    }
    __syncthreads();
    if (tid < 128) { float s = 0.f; for (int cg = 0; cg < 32; ++cg) s += part[cg * 128 + tid]; rstd[tid] = rsqrtf(s * (1.0f / 512.0f) + EPSN); }
    __syncthreads();
    const int hs = c.wave >> 1, th = c.wave & 1;
    const float* wsp = c.in[I_SGUW] + ((size_t)(l * 4 + hs) * 128) * 128;
    const float* gn = c.in[I_SGUN] + (size_t)l * 512 + hs * 128;
    const float* bsp = c.in[I_SGUB] + (size_t)(l * 4 + hs) * 128;
#pragma unroll 1
    for (int ch = 0; ch < 2; ++ch) {
        f32x4 acc[4][4];
#pragma unroll
        for (int mt = 0; mt < 4; ++mt)
#pragma unroll
            for (int ct = 0; ct < 4; ++ct) acc[mt][ct] = (f32x4){0.f, 0.f, 0.f, 0.f};
#pragma unroll 1
        for (int kk = 0; kk < 4; ++kk) {
            bf16x8 af[4];
#pragma unroll
            for (int mt = 0; mt < 4; ++mt) {
                const float* wp = wsp + (size_t)(64 * th + 16 * mt + n) * 128 + 32 * kk + 8 * lg;
                const float4 w0 = *(const float4*)wp, w1 = *(const float4*)(wp + 4);
                u32x4 pw; pw.x = pk2(w0.x, w0.y); pw.y = pk2(w0.z, w0.w); pw.z = pk2(w1.x, w1.y); pw.w = pk2(w1.z, w1.w);
                af[mt] = __builtin_bit_cast(bf16x8, pw);
            }
            const f32x4 r0 = *(const LAS f32x4*)(rstd + 32 * kk + 8 * lg), r1 = *(const LAS f32x4*)(rstd + 32 * kk + 8 * lg + 4);
#pragma unroll
            for (int ct = 0; ct < 4; ++ct) {
                const int cl = 64 * ch + 16 * ct + n;
                const u32x4 v = *(const u32x4*)(c.TR + (size_t)(TR_SV + hs * 128 + cl) * MROWS + tok0 + 32 * kk + 8 * lg);
                const float gc = gn[cl];
                const float x0 = gelu_f(bflo(v.x)) * r0[0] * gc, x1 = gelu_f(bfhi(v.x)) * r0[1] * gc, x2 = gelu_f(bflo(v.y)) * r0[2] * gc, x3 = gelu_f(bfhi(v.y)) * r0[3] * gc;
                const float x4 = gelu_f(bflo(v.z)) * r1[0] * gc, x5 = gelu_f(bfhi(v.z)) * r1[1] * gc, x6 = gelu_f(bflo(v.w)) * r1[2] * gc, x7 = gelu_f(bfhi(v.w)) * r1[3] * gc;
                u32x4 pw; pw.x = pk2(x0, x1); pw.y = pk2(x2, x3); pw.z = pk2(x4, x5); pw.w = pk2(x6, x7);
                const bf16x8 bfr = __builtin_bit_cast(bf16x8, pw);
#pragma unroll
                for (int mt = 0; mt < 4; ++mt) acc[mt][ct] = __builtin_amdgcn_mfma_f32_16x16x32_bf16(af[mt], bfr, acc[mt][ct], 0, 0, 0);
            }
        }
#pragma unroll
        for (int mt = 0; mt < 4; ++mt)
#pragma unroll
            for (int rr = 0; rr < 4; ++rr) {
                const int t = 64 * th + 16 * mt + 4 * lg + rr; const float bs = bsp[t];
                const size_t row = (size_t)(tok0 + t);
#pragma unroll
                for (int ct = 0; ct < 4; ++ct) {
                    const int col = hs * 128 + 64 * ch + 16 * ct + n;
                    const float su = bf2f(c.PROJ[row * NMAIN + PJ_SU + col]);
                    c.SGU[row * 512 + col] = f2bf(gelu_f(su) * (acc[mt][ct][rr] + bs));
                }
            }
    }
}

__device__ __forceinline__ int s5_row(int dir, int b, int q) {
    if (dir == 0) return q < CTXL ? NLAT + b * CTXL + q : b * SEQL + (q - CTXL);
    return q < CTXL ? NLAT + b * CTXL + (CTXL - 1 - q) : b * SEQL + (SEQL - 1 - (q - CTXL));
}
__device__ __forceinline__ void s5_disc(const Ctx& c, int l, int dir, int grp, int p, float& lr, float& li, float (&bbr)[16], float (&bbi)[16]) {
    const size_t gp = ((size_t)(l * 2 + dir) * 32 + grp) * 64 + p;
    const float are = fminf(c.in[I_ARE][gp], -1e-4f), aim = c.in[I_AIM][gp];
    const float dt = expf(c.in[I_LOGDT][(size_t)(l * 2 + dir) * 32 + grp]);
    const float mag = expf(are * dt); float sn, cs; sincosf(aim * dt, &sn, &cs);
    lr = mag * cs; li = mag * sn;
    const float den = 1.0f / (are * are + aim * aim), nr = lr - 1.0f;
    const float cr = (nr * are + li * aim) * den, ci = (li * are - nr * aim) * den;
    const float* br = c.in[I_BRE] + gp * 16; const float* bi = c.in[I_BIM] + gp * 16;
#pragma unroll
    for (int q4 = 0; q4 < 4; ++q4) {
        const float4 a = *(const float4*)(br + 4 * q4), b = *(const float4*)(bi + 4 * q4);
        bbr[4 * q4 + 0] = cr * a.x - ci * b.x; bbi[4 * q4 + 0] = cr * b.x + ci * a.x;
        bbr[4 * q4 + 1] = cr * a.y - ci * b.y; bbi[4 * q4 + 1] = cr * b.y + ci * a.y;
        bbr[4 * q4 + 2] = cr * a.z - ci * b.z; bbi[4 * q4 + 2] = cr * b.z + ci * a.z;
        bbr[4 * q4 + 3] = cr * a.w - ci * b.w; bbi[4 * q4 + 3] = cr * b.w + ci * a.w;
    }
}
__device__ __forceinline__ void s5_load_u(const Ctx& c, LAS float* U, int row, int grp) {
    const u32x4* sp = (const u32x4*)(c.PROJ + (size_t)row * NMAIN + PJ_SIN + 16 * grp);
    const u32x4 a = sp[0], b = sp[1];
    LAS f32x4* up = (LAS f32x4*)(U + c.lane * 16);
    up[0] = (f32x4){bflo(a.x), bfhi(a.x), bflo(a.y), bfhi(a.y)}; up[1] = (f32x4){bflo(a.z), bfhi(a.z), bflo(a.w), bfhi(a.w)};
    up[2] = (f32x4){bflo(b.x), bfhi(b.x), bflo(b.y), bfhi(b.y)}; up[3] = (f32x4){bflo(b.z), bfhi(b.z), bflo(b.w), bfhi(b.w)};
    lds_fence();
}
__device__ __forceinline__ void s5_step(LAS const float* U, int tok, float lr, float li, const float (&bbr)[16], const float (&bbi)[16], float& hr, float& hi) {
    const LAS f32x4* up = (const LAS f32x4*)(U + tok * 16);
    float dr = 0.f, di = 0.f;
#pragma unroll
    for (int q4 = 0; q4 < 4; ++q4) { const f32x4 u = up[q4];
#pragma unroll
        for (int j = 0; j < 4; ++j) { dr += bbr[4 * q4 + j] * u[j]; di += bbi[4 * q4 + j] * u[j]; } }
    const float nr = lr * hr - li * hi + dr, ni = lr * hi + li * hr + di; hr = nr; hi = ni;
}
__device__ __forceinline__ void s5_pass1_item(const Ctx& c, int l, int item, LAS float* U) {
    const int nchunk = item % NCHK, dir = (item / NCHK) & 1, grp = (item / (2 * NCHK)) & 31, b = item / (2 * NCHK * 32);
    float lr, li, bbr[16], bbi[16];
    s5_disc(c, l, dir, grp, c.lane, lr, li, bbr, bbi);
    lds_fence();
    s5_load_u(c, U, s5_row(dir, b, 64 * nchunk + c.lane), grp);
    float hr = 0.f, hi = 0.f;
#pragma unroll 4
    for (int j = 0; j < 64; ++j) s5_step(U, j, lr, li, bbr, bbi, hr, hi);
    c.SLOC[((size_t)((b * 32 + grp) * 2 + dir) * NCHK + nchunk) * 64 + c.lane] = (f32x2v){hr, hi};
}
constexpr int S5_HS = 272;
template <int DIR, int HALF>
__device__ __forceinline__ void s5_half(LAS const float* U, LAS unsigned char* Hb, float lr, float li, const float (&bbr)[16], const float (&bbi)[16], float& hr, float& hi,
                                        const bf16x8 (&cf)[4], f32x4 (&acc)[4], int lane, int n, int lg) {
#pragma unroll 4
    for (int jj = 0; jj < 32; ++jj) {
        const int j = 32 * HALF + jj, tok = DIR ? 63 - j : j;
        s5_step(U, tok, lr, li, bbr, bbi, hr, hi);
        *(LAS unsigned*)(Hb + (tok & 31) * S5_HS + 4 * lane) = pk2(hr, hi);
    }
    lds_fence();
    constexpr int MTB = DIR ? (2 - 2 * HALF) : (2 * HALF);
#pragma unroll
    for (int mi = 0; mi < 2; ++mi)
#pragma unroll
        for (int kk = 0; kk < 4; ++kk) {
            const bf16x8 a = *(const LAS bf16x8*)(Hb + (16 * mi + n) * S5_HS + (32 * kk + 8 * lg) * 2);
            acc[MTB + mi] = __builtin_amdgcn_mfma_f32_16x16x32_bf16(a, cf[kk], acc[MTB + mi], 0, 0, 0);
        }
    lds_fence();
}
template <int DIR>
__device__ __forceinline__ void s5_dir(const Ctx& c, int l, int b, int grp, int tc, LAS float* U, LAS unsigned char* Hb, f32x4 (&acc)[4]) {
    const int lane = c.lane, n = lane & 15, lg = lane >> 4;
    float lr, li, bbr[16], bbi[16];
    s5_disc(c, l, DIR, grp, lane, lr, li, bbr, bbi);
    bf16x8 cf[4];
    {
        const size_t cb = (((size_t)(l * 2 + DIR) * 32 + grp) * 16 + n) * 64;
#pragma unroll
        for (int kk = 0; kk < 4; ++kk) {
            const float4 re = *(const float4*)(c.in[I_CRE] + cb + 16 * kk + 4 * lg), im = *(const float4*)(c.in[I_CIM] + cb + 16 * kk + 4 * lg);
            u32x4 pw; pw.x = pk2(re.x, -im.x); pw.y = pk2(re.y, -im.y); pw.z = pk2(re.z, -im.z); pw.w = pk2(re.w, -im.w);
            cf[kk] = __builtin_bit_cast(bf16x8, pw);
        }
    }
    float tr = lr, ti = li;
#pragma unroll
    for (int s = 0; s < 6; ++s) { const float a = tr * tr - ti * ti, bq = 2.0f * tr * ti; tr = a; ti = bq; }
    const int nchunk = tc < 64 ? (DIR == 0 ? 4 + tc : 4 + 63 - tc) : (DIR == 0 ? tc - 64 : 3 - (tc - 64));
    float hr = 0.f, hi = 0.f;
    {
        const f32x2v* sp = c.SLOC + ((size_t)((b * 32 + grp) * 2 + DIR) * NCHK) * 64 + lane;
        for (int m = 0; m < nchunk; ++m) { const f32x2v s = sp[(size_t)m * 64]; const float nr = hr * tr - hi * ti + s.x, ni = hr * ti + hi * tr + s.y; hr = nr; hi = ni; }
    }
    s5_half<DIR, 0>(U, Hb, lr, li, bbr, bbi, hr, hi, cf, acc, lane, n, lg);
    s5_half<DIR, 1>(U, Hb, lr, li, bbr, bbi, hr, hi, cf, acc, lane, n, lg);
}
__device__ __forceinline__ void s5_pass3_item(const Ctx& c, int l, int item, LAS float* U, LAS unsigned char* Hb) {
    const int tc = item % NCHK, grp = (item / NCHK) & 31, b = item / (NCHK * 32);
    const int lane = c.lane, n = lane & 15, lg = lane >> 4;
    const int rowbase = tc < 64 ? b * SEQL + 64 * tc : NLAT + b * CTXL + 64 * (tc - 64);
    lds_fence();
    s5_load_u(c, U, rowbase + lane, grp);
    f32x4 acc[4];
#pragma unroll
    for (int i = 0; i < 4; ++i) acc[i] = (f32x4){0.f, 0.f, 0.f, 0.f};
    s5_dir<0>(c, l, b, grp, tc, U, Hb, acc);
    s5_dir<1>(c, l, b, grp, tc, U, Hb, acc);
    const float dv = c.in[I_S5D][(size_t)l * 512 + 16 * grp + n];
#pragma unroll
    for (int mt = 0; mt < 4; ++mt)
#pragma unroll
        for (int rr = 0; rr < 4; ++rr) {
            const int tok = 16 * mt + 4 * lg + rr;
            const float y = acc[mt][rr] + dv * U[tok * 16 + n];
            c.S5Y[(size_t)(rowbase + tok) * 512 + 16 * grp + n] = f2bf(gelu_f(y));
        }
}

__device__ __forceinline__ void phase_merge(const Ctx& c, int l, int nrows) {
    const float* gn = c.in[I_ONORM] + (size_t)l * DM;
    const int lane = c.lane;
    for (int row = c.bid * 8 + c.wave; row < nrows; row += c.G * 8) {
        const u32x4 a0 = *(const u32x4*)(c.ATT + (size_t)row * 1024 + 8 * lane), a1 = *(const u32x4*)(c.ATT + (size_t)row * 1024 + 512 + 8 * lane);
        const u32x4 s0 = *(const u32x4*)(c.SGU + (size_t)row * 512 + 8 * lane), z0 = *(const u32x4*)(c.S5O + (size_t)row * 512 + 8 * lane);
        float va[16] = {bflo(a0.x), bfhi(a0.x), bflo(a0.y), bfhi(a0.y), bflo(a0.z), bfhi(a0.z), bflo(a0.w), bfhi(a0.w), bflo(a1.x), bfhi(a1.x), bflo(a1.y), bfhi(a1.y), bflo(a1.z), bfhi(a1.z), bflo(a1.w), bfhi(a1.w)};
        float vs[8] = {bflo(s0.x), bfhi(s0.x), bflo(s0.y), bfhi(s0.y), bflo(s0.z), bfhi(s0.z), bflo(s0.w), bfhi(s0.w)};
        float vz[8] = {bflo(z0.x), bfhi(z0.x), bflo(z0.y), bfhi(z0.y), bflo(z0.z), bfhi(z0.z), bflo(z0.w), bfhi(z0.w)};
        float sa = 0.f, ss = 0.f, sz = 0.f;
#pragma unroll
        for (int j = 0; j < 16; ++j) sa += va[j] * va[j];
#pragma unroll
        for (int j = 0; j < 8; ++j) { ss += vs[j] * vs[j]; sz += vz[j] * vz[j]; }
        sa = wave_sum(sa); ss = wave_sum(ss); sz = wave_sum(sz);
        const float ra = rsqrtf(sa * (1.0f / 1024.0f) + EPSN), rs = rsqrtf(ss * (1.0f / 512.0f) + EPSN), rz = rsqrtf(sz * (1.0f / 512.0f) + EPSN);
        u16* yp = c.YIN + (size_t)row * DM;
        {   const float* g = gn + 8 * lane; u32x4 o;
            o.x = pk2(va[0] * ra * g[0], va[1] * ra * g[1]); o.y = pk2(va[2] * ra * g[2], va[3] * ra * g[3]); o.z = pk2(va[4] * ra * g[4], va[5] * ra * g[5]); o.w = pk2(va[6] * ra * g[6], va[7] * ra * g[7]);
            *(u32x4*)(yp + 8 * lane) = o; }
        {   const float* g = gn + 512 + 8 * lane; u32x4 o;
            o.x = pk2(va[8] * ra * g[0], va[9] * ra * g[1]); o.y = pk2(va[10] * ra * g[2], va[11] * ra * g[3]); o.z = pk2(va[12] * ra * g[4], va[13] * ra * g[5]); o.w = pk2(va[14] * ra * g[6], va[15] * ra * g[7]);
            *(u32x4*)(yp + 512 + 8 * lane) = o; }
        {   const float* g = gn + 1024 + 8 * lane; u32x4 o;
            o.x = pk2(vs[0] * rs * g[0], vs[1] * rs * g[1]); o.y = pk2(vs[2] * rs * g[2], vs[3] * rs * g[3]); o.z = pk2(vs[4] * rs * g[4], vs[5] * rs * g[5]); o.w = pk2(vs[6] * rs * g[6], vs[7] * rs * g[7]);
            *(u32x4*)(yp + 1024 + 8 * lane) = o; }
        {   const float* g = gn + 1536 + 8 * lane; u32x4 o;
            o.x = pk2(vz[0] * rz * g[0], vz[1] * rz * g[1]); o.y = pk2(vz[2] * rz * g[2], vz[3] * rz * g[3]); o.z = pk2(vz[4] * rz * g[4], vz[5] * rz * g[5]); o.w = pk2(vz[6] * rz * g[6], vz[7] * rz * g[7]);
            *(u32x4*)(yp + 1536 + 8 * lane) = o; }
    }
}

__device__ __forceinline__ unsigned ord_f(float f) { const unsigned u = __float_as_uint(f); return (u & 0x80000000u) ? ~u : (u | 0x80000000u); }
__device__ __forceinline__ float unord_f(unsigned k) { return __uint_as_float((k & 0x80000000u) ? (k ^ 0x80000000u) : ~k); }
#define INS16(r, x_) do { unsigned _x = (x_); _Pragma("unroll") for (int _j = 0; _j < 16; ++_j) { const unsigned _t = max(r[_j], _x); _x = min(r[_j], _x); r[_j] = _t; } } while (0)

constexpr int TK_SC = 0;
constexpr int TK_QL = TK_SC + 64 * 260 * 4;
constexpr int TK_HL = TK_QL + 64 * 2 * 4 * 16 * 4;
constexpr int TK_TOP = TK_HL + 64 * 2 * 2 * 16 * 4;
constexpr int TK_END = TK_TOP + 64 * 2 * 16 * 4;
static_assert(TK_END <= LDS_BARW, "topk LDS");

__device__ __forceinline__ void topk_item(const Ctx& c, int l, int tile, int head) {
    const int tid = c.tid, lane = c.lane, n = lane & 15, lg = lane >> 4, w = c.wave;
    const int tok0 = tile * 64;
    LAS unsigned* SC = (LAS unsigned*)(c.lds + TK_SC); LAS unsigned* QL = (LAS unsigned*)(c.lds + TK_QL);
    LAS unsigned* HL = (LAS unsigned*)(c.lds + TK_HL); LAS unsigned* TOP = (LAS unsigned*)(c.lds + TK_TOP);
    __syncthreads();
    {
        const int list = w >> 2, kt0 = 2 * (w & 3);
        const u16* kb = (const u16*)(c.wl(l) + WL_K12) + ((size_t)(list * 8 + head) * 128) * 128;
        bf16x8 bk[2][4];
#pragma unroll
        for (int i = 0; i < 2; ++i)
#pragma unroll
            for (int kk = 0; kk < 4; ++kk) bk[i][kk] = *(const bf16x8*)(kb + (size_t)(16 * (kt0 + i) + n) * 128 + 32 * kk + 8 * lg);
#pragma unroll
        for (int mt = 0; mt < 4; ++mt) {
            const u16* qp = c.PQ + (size_t)(tok0 + 16 * mt + n) * DM + head * 256 + list * 128 + 8 * lg;
            f32x4 a0 = {0.f, 0.f, 0.f, 0.f}, a1 = {0.f, 0.f, 0.f, 0.f};
#pragma unroll
            for (int kk = 0; kk < 4; ++kk) { const bf16x8 a = *(const bf16x8*)(qp + 32 * kk);
                a0 = __builtin_amdgcn_mfma_f32_16x16x32_bf16(a, bk[0][kk], a0, 0, 0, 0); a1 = __builtin_amdgcn_mfma_f32_16x16x32_bf16(a, bk[1][kk], a1, 0, 0, 0); }
#pragma unroll
            for (int rr = 0; rr < 4; ++rr) {
                const int tk = 16 * mt + 4 * lg + rr, k0i = 16 * kt0 + n, k1i = 16 * (kt0 + 1) + n;
                SC[tk * 260 + list * 128 + k0i] = (ord_f(a0[rr]) & ~0x7Fu) | (unsigned)(127 - k0i);
                SC[tk * 260 + list * 128 + k1i] = (ord_f(a1[rr]) & ~0x7Fu) | (unsigned)(127 - k1i);
            }
        }
    }
    __syncthreads();
    {
        const int tk = tid & 63, list = w >> 2, qu = w & 3;
        unsigned r[16];
#pragma unroll
        for (int j = 0; j < 16; ++j) r[j] = 0u;
        const LAS u32x4* sp = (const LAS u32x4*)(SC + tk * 260 + list * 128 + 32 * qu);
#pragma unroll
        for (int i = 0; i < 8; ++i) { const u32x4 v = sp[i]; INS16(r, v.x); INS16(r, v.y); INS16(r, v.z); INS16(r, v.w); }
        LAS u32x4* op = (LAS u32x4*)(QL + ((tk * 2 + list) * 4 + qu) * 16);
        op[0] = (u32x4){r[0], r[1], r[2], r[3]}; op[1] = (u32x4){r[4], r[5], r[6], r[7]}; op[2] = (u32x4){r[8], r[9], r[10], r[11]}; op[3] = (u32x4){r[12], r[13], r[14], r[15]};
    }
    __syncthreads();
    if (w < 4) {
        const int tk = tid & 63, list = w >> 1, hf = w & 1;
        const LAS u32x4* ap = (const LAS u32x4*)(QL + ((tk * 2 + list) * 4 + 2 * hf) * 16);
        unsigned r[16];
#pragma unroll
        for (int i = 0; i < 4; ++i) { const u32x4 v = ap[i]; r[4 * i] = v.x; r[4 * i + 1] = v.y; r[4 * i + 2] = v.z; r[4 * i + 3] = v.w; }
#pragma unroll
        for (int i = 0; i < 4; ++i) { const u32x4 v = ap[4 + i]; INS16(r, v.x); INS16(r, v.y); INS16(r, v.z); INS16(r, v.w); }
        LAS u32x4* op = (LAS u32x4*)(HL + ((tk * 2 + list) * 2 + hf) * 16);
        op[0] = (u32x4){r[0], r[1], r[2], r[3]}; op[1] = (u32x4){r[4], r[5], r[6], r[7]}; op[2] = (u32x4){r[8], r[9], r[10], r[11]}; op[3] = (u32x4){r[12], r[13], r[14], r[15]};
    }
    __syncthreads();
    if (w < 2) {
        const int tk = tid & 63, list = w;
        const LAS u32x4* ap = (const LAS u32x4*)(HL + ((tk * 2 + list) * 2) * 16);
        unsigned r[16];
#pragma unroll
        for (int i = 0; i < 4; ++i) { const u32x4 v = ap[i]; r[4 * i] = v.x; r[4 * i + 1] = v.y; r[4 * i + 2] = v.z; r[4 * i + 3] = v.w; }
#pragma unroll
        for (int i = 0; i < 4; ++i) { const u32x4 v = ap[4 + i]; INS16(r, v.x); INS16(r, v.y); INS16(r, v.z); INS16(r, v.w); }
        LAS u32x4* op = (LAS u32x4*)(TOP + (tk * 2 + list) * 16);
        op[0] = (u32x4){r[0], r[1], r[2], r[3]}; op[1] = (u32x4){r[4], r[5], r[6], r[7]}; op[2] = (u32x4){r[8], r[9], r[10], r[11]}; op[3] = (u32x4){r[12], r[13], r[14], r[15]};
    }
    __syncthreads();
    if (w == 0) {
        const int tk = lane;
        float v1[16], v2[16];
        {
            const LAS u32x4* p1 = (const LAS u32x4*)(TOP + (tk * 2) * 16); const LAS u32x4* p2 = (const LAS u32x4*)(TOP + (tk * 2 + 1) * 16);
#pragma unroll
            for (int i = 0; i < 4; ++i) { const u32x4 a = p1[i], b = p2[i];
                v1[4 * i] = unord_f(a.x & ~0x7Fu); v1[4 * i + 1] = unord_f(a.y & ~0x7Fu); v1[4 * i + 2] = unord_f(a.z & ~0x7Fu); v1[4 * i + 3] = unord_f(a.w & ~0x7Fu);
                v2[4 * i] = unord_f(b.x & ~0x7Fu); v2[4 * i + 1] = unord_f(b.y & ~0x7Fu); v2[4 * i + 2] = unord_f(b.z & ~0x7Fu); v2[4 * i + 3] = unord_f(b.w & ~0x7Fu); }
        }
        unsigned r[16];
#pragma unroll
        for (int j = 0; j < 16; ++j) r[j] = 0u;
#pragma unroll
        for (int a = 0; a < 16; ++a)
#pragma unroll
            for (int b = 0; b < 16; ++b)
                if ((a + 1) * (b + 1) <= 16) { const unsigned key = (ord_f(v1[a] + v2[b]) & ~0xFFu) | (unsigned)(255 - (a * 16 + b)); INS16(r, key); }
        float s[16], mx, sum = 0.f;
        mx = unord_f(r[0] & ~0xFFu);
#pragma unroll
        for (int k = 0; k < 16; ++k) { s[k] = __expf(unord_f(r[k] & ~0xFFu) - mx); sum += s[k]; }
        const float inv = 1.0f / sum;
        const size_t ob = (size_t)(tok0 + tk) * 128 + head * 16;
#pragma unroll
        for (int k = 0; k < 16; ++k) {
            const int flat = 255 - (int)(r[k] & 0xFFu), a = flat >> 4, b = flat & 15;
            const int i1 = 127 - (int)(TOP[(tk * 2) * 16 + a] & 0x7Fu), i2 = 127 - (int)(TOP[(tk * 2 + 1) * 16 + b] & 0x7Fu);
            c.EID[ob + k] = (u16)(i1 * 128 + i2); c.GATE[ob + k] = s[k] * inv;
        }
    }
}

__device__ __forceinline__ float dot8(const u32x4& a, const u32x4& b, float acc) {
    acc += bflo(a.x) * bflo(b.x); acc += bfhi(a.x) * bfhi(b.x); acc += bflo(a.y) * bflo(b.y); acc += bfhi(a.y) * bfhi(b.y);
    acc += bflo(a.z) * bflo(b.z); acc += bfhi(a.z) * bfhi(b.z); acc += bflo(a.w) * bflo(b.w); acc += bfhi(a.w) * bfhi(b.w); return acc;
}
__device__ __forceinline__ void axpy8(float (&o)[32], int i, float w, const u32x4& v) {
    o[8 * i + 0] += w * bflo(v.x); o[8 * i + 1] += w * bfhi(v.x); o[8 * i + 2] += w * bflo(v.y); o[8 * i + 3] += w * bfhi(v.y);
    o[8 * i + 4] += w * bflo(v.z); o[8 * i + 5] += w * bfhi(v.z); o[8 * i + 6] += w * bflo(v.w); o[8 * i + 7] += w * bfhi(v.w);
}
__device__ __forceinline__ void peer_item(const Ctx& c, int l, int t) {
    const int lane = c.lane;
    const u32x4* hp = (const u32x4*)(c.H + (size_t)t * DM);
    u32x4 hq[4];
#pragma unroll
    for (int i = 0; i < 4; ++i) hq[i] = hp[lane + 64 * i];
    float out[32];
#pragma unroll
    for (int j = 0; j < 32; ++j) out[j] = 0.f;
    const u16* UT = (const u16*)(c.wl(l) + WL_U); const u16* VT = (const u16*)(c.wl(l) + WL_V);
    const u16* eid = c.EID + (size_t)t * 128; const float* gt = c.GATE + (size_t)t * 128;
#pragma unroll 1
    for (int k0 = 0; k0 < 128; k0 += 4) {
        int e[4]; float g[4], d[4];
#pragma unroll
        for (int j = 0; j < 4; ++j) { e[j] = __builtin_amdgcn_readfirstlane((int)eid[k0 + j]); g[j] = gt[k0 + j]; }
#pragma unroll
        for (int j = 0; j < 4; ++j) {
            const u32x4* up = (const u32x4*)(UT + (size_t)e[j] * DM);
            float a = 0.f;
#pragma unroll
            for (int i = 0; i < 4; ++i) a = dot8(up[lane + 64 * i], hq[i], a);
            d[j] = a;
        }
#pragma unroll
        for (int j = 0; j < 4; ++j) d[j] = g[j] * gelu_f(wave_sum(d[j]));
#pragma unroll
        for (int j = 0; j < 4; ++j) {
            const u32x4* vp = (const u32x4*)(VT + (size_t)e[j] * DM);
#pragma unroll
            for (int i = 0; i < 4; ++i) axpy8(out, i, d[j], vp[lane + 64 * i]);
        }
    }
    const int bi = row_bidx(t);
    const float* g5 = c.MOD + ((size_t)(l * 5 + bi) * 6 + 5) * DM;
    float* xp = c.X + (size_t)t * DM;
    float xn[32]; float ss = 0.f;
#pragma unroll
    for (int i = 0; i < 4; ++i) {
        const int e0 = 8 * (lane + 64 * i);
        const float4 x0 = *(const float4*)(xp + e0), x1 = *(const float4*)(xp + e0 + 4), q0 = *(const float4*)(g5 + e0), q1 = *(const float4*)(g5 + e0 + 4);
        xn[8 * i + 0] = x0.x + q0.x * out[8 * i + 0]; xn[8 * i + 1] = x0.y + q0.y * out[8 * i + 1]; xn[8 * i + 2] = x0.z + q0.z * out[8 * i + 2]; xn[8 * i + 3] = x0.w + q0.w * out[8 * i + 3];
        xn[8 * i + 4] = x1.x + q1.x * out[8 * i + 4]; xn[8 * i + 5] = x1.y + q1.y * out[8 * i + 5]; xn[8 * i + 6] = x1.z + q1.z * out[8 * i + 6]; xn[8 * i + 7] = x1.w + q1.w * out[8 * i + 7];
#pragma unroll
        for (int j = 0; j < 8; ++j) ss += xn[8 * i + j] * xn[8 * i + j];
    }
    ss = wave_sum(ss);
    const float rstd = rsqrtf(ss * (1.0f / DM) + EPSN);
    if (l < DEPTH - 1) {
        const float* gain = c.in[I_NMIX] + (size_t)(l + 1) * DM;
        const float* sh = c.MOD + ((size_t)((l + 1) * 5 + bi) * 6 + 0) * DM; const float* sc = sh + DM;
#pragma unroll
        for (int i = 0; i < 4; ++i) {
            const int e0 = 8 * (lane + 64 * i);
            *(float4*)(xp + e0) = make_float4(xn[8 * i], xn[8 * i + 1], xn[8 * i + 2], xn[8 * i + 3]); *(float4*)(xp + e0 + 4) = make_float4(xn[8 * i + 4], xn[8 * i + 5], xn[8 * i + 6], xn[8 * i + 7]);
            float y[8];
#pragma unroll
            for (int j = 0; j < 8; ++j) y[j] = xn[8 * i + j] * rstd * gain[e0 + j] * (1.0f + sc[e0 + j]) + sh[e0 + j];
            u32x4 o; o.x = pk2(y[0], y[1]); o.y = pk2(y[2], y[3]); o.z = pk2(y[4], y[5]); o.w = pk2(y[6], y[7]);
            *(u32x4*)(c.H + (size_t)t * DM + e0) = o;
        }
    } else {
        const float* gain = c.in[I_FNORM];
        float* op = c.out + (size_t)t * DM;
#pragma unroll
        for (int i = 0; i < 4; ++i) {
            const int e0 = 8 * (lane + 64 * i);
            *(float4*)(op + e0) = make_float4(xn[8 * i] * rstd * gain[e0], xn[8 * i + 1] * rstd * gain[e0 + 1], xn[8 * i + 2] * rstd * gain[e0 + 2], xn[8 * i + 3] * rstd * gain[e0 + 3]);
            *(float4*)(op + e0 + 4) = make_float4(xn[8 * i + 4] * rstd * gain[e0 + 4], xn[8 * i + 5] * rstd * gain[e0 + 5], xn[8 * i + 6] * rstd * gain[e0 + 6], xn[8 * i + 7] * rstd * gain[e0 + 7]);
        }
    }
}

constexpr int PH_PRO = 0, PH_MODFIN = 1, PH_NORM0 = 2, PH_L0 = 3, PH_PER_LAYER = 10, N_PHASES = PH_L0 + DEPTH * PH_PER_LAYER;

__global__ void __launch_bounds__(512, 2) fwd_kernel(Args args) {
    extern __shared__ __attribute__((aligned(16))) unsigned char lds_raw[];
    Ctx c;
#pragma unroll
    for (int i = 0; i < N_IN; ++i) c.in[i] = args.in[i];
    c.out = args.out; c.ws = args.ws; c.lds = (LAS unsigned char*)lds_raw;
    c.tid = threadIdx.x; c.lane = c.tid & 63; c.wave = __builtin_amdgcn_readfirstlane(c.tid >> 6); c.G = gridDim.x; c.bid = blockIdx.x;
    unsigned char* ws = args.ws;
    c.MOD = (float*)(ws + WS_MOD); c.MODP = (float*)(ws + WS_MODP); c.X = (float*)(ws + WS_X); c.H = (u16*)(ws + WS_H); c.PROJ = (u16*)(ws + WS_PROJ); c.TR = (u16*)(ws + WS_TR);
    c.ATT = (u16*)(ws + WS_ATT); c.SGU = (u16*)(ws + WS_SGU); c.S5Y = (u16*)(ws + WS_S5Y); c.S5O = (u16*)(ws + WS_S5O); c.YIN = (u16*)(ws + WS_YIN); c.PQ = (u16*)(ws + WS_PQ);
    c.EID = (u16*)(ws + WS_EID); c.GATE = (float*)(ws + WS_GATE); c.SLOC = (f32x2v*)(ws + WS_SLOC);

    const int lo = args.ph_lo, hi = args.ph_hi;
    XcdBarrier bar; bar.bar = (unsigned*)(ws + WS_BAR); bar.x = 0; bar.st = (volatile LAS unsigned*)(c.lds + LDS_BARW);
    if (hi - lo > 1) {
        if (c.tid == 0) { bar.st[0] = 0u; bar.st[1] = 0u; }
        __syncthreads();
        bar = xcd_barrier_post((unsigned*)(ws + WS_BAR), (volatile LAS unsigned*)(c.lds + LDS_BARW));
    }
#ifndef PHASE_MASK
#define PHASE_MASK 0xFFFFFF
#endif
#define EN(i) ((PHASE_MASK >> (i)) & 1)
#define IN_PH(k) (lo <= (k) && (k) < hi)
#define SEAM(k) do { if (IN_PH((k) + 1)) xcd_barrier(bar); } while (0)

    if (EN(0) && IN_PH(PH_PRO)) { phase_prologue(c); SEAM(PH_PRO); }
    if (EN(1) && IN_PH(PH_MODFIN)) { phase_modfin(c); SEAM(PH_MODFIN); }
    if (EN(2) && IN_PH(PH_NORM0)) { phase_normmod(c, 0, 0, MROWS); SEAM(PH_NORM0); }

#pragma unroll 1
    for (int l = 0; l < DEPTH; ++l) {
        const int base = PH_L0 + l * PH_PER_LAYER;
        const bool last = (l == DEPTH - 1);
        const int mrows = last ? NLAT : MROWS;
        unsigned char* W = c.wl(l);
        if (EN(3) && IN_PH(base + 0)) { c.fresh();
            { pg8::Gemm g{c.H, (const u16*)(W + WL_MAIN), MROWS, NMAIN, DM}; pg8::StaticOrder S; S.init(MROWS, NMAIN, c.G, c.bid);
              pg8::EpiBf16<0> E{c.PROJ, NMAIN, nullptr, 0, 0};
              pg8::gemm_phase<pg8::EpiBf16<0>, pg8::StaticOrder>(c.lds, g, S, E, nullptr); }
            { pg8::Gemm g{(const u16*)(W + WL_TR), c.H, NTR, MROWS, DM}; pg8::StaticOrder S; S.init(NTR, MROWS, c.G, c.bid);
              pg8::EpiBf16<0> E{c.TR, MROWS, nullptr, 0, 0};
              pg8::gemm_phase<pg8::EpiBf16<0>, pg8::StaticOrder>(c.lds, g, S, E, nullptr); }
            SEAM(base + 0);
        }
        if (EN(4) && IN_PH(base + 1)) { c.fresh();
            const int gw = c.bid * 8 + c.wave, nw = c.G * 8;
            if (EN(13)) for (int it = gw; it < NB * 64 * 8 * 4; it += nw) { const int qt = it & 3, head = (it >> 2) & 7, r = (it >> 5) & 63, b = it >> 11; attn_item<true>(c, l, b, r, head, qt); }
            if (EN(14) && !last) for (int it = gw; it < NB * 8 * 16; it += nw) { const int qt = it & 15, head = (it >> 4) & 7, b = it >> 7; attn_item<false>(c, l, b, 0, head, qt); }
            if (EN(15)) for (int it = c.bid; it < (last ? 128 : 136); it += c.G) sgu_item(c, l, it);
            __syncthreads();
            if (EN(16)) { LAS float* U = (LAS float*)(c.lds + c.wave * 4096);
              for (int it = gw; it < NB * 32 * 2 * NCHK; it += nw) s5_pass1_item(c, l, it, U); }
            SEAM(base + 1);
        }
        if (EN(5) && IN_PH(base + 2)) { c.fresh();
            const int gw = c.bid * 8 + c.wave, nw = c.G * 8;
            LAS float* U = (LAS float*)(c.lds + c.wave * 4096); LAS unsigned char* Hb = c.lds + 32768 + c.wave * (32 * S5_HS);
            for (int it = gw; it < NB * 32 * NCHK; it += nw) { if (last && (it % NCHK) >= 64) continue; s5_pass3_item(c, l, it, U, Hb); }
            SEAM(base + 2);
        }
        if (EN(6) && IN_PH(base + 3)) { c.fresh();
            pg8::Gemm g{c.S5Y, (const u16*)(W + WL_GLU), mrows, 512, 512}; pg8::StaticOrder S; S.init(mrows, 512, c.G, c.bid);
            EpiGlu E{c.S5Y, c.S5O, c.in[I_GLUB] + (size_t)l * 512};
            pg8::gemm_phase<EpiGlu, pg8::StaticOrder>(c.lds, g, S, E, nullptr);
            SEAM(base + 3);
        }
        if (EN(7) && IN_PH(base + 4)) { c.fresh(); phase_merge(c, l, mrows); SEAM(base + 4); }
        if (EN(8) && IN_PH(base + 5)) { c.fresh();
            pg8::Gemm g{c.YIN, (const u16*)(W + WL_OUT), mrows, DM, DM}; pg8::StaticOrder S; S.init(mrows, DM, c.G, c.bid);
            EpiResid E{c.X, c.MOD + (size_t)l * 5 * 6 * DM};
            pg8::gemm_phase<EpiResid, pg8::StaticOrder>(c.lds, g, S, E, nullptr);
            SEAM(base + 5);
        }
        if (EN(9) && IN_PH(base + 6)) { c.fresh(); phase_normmod(c, l, 1, mrows); SEAM(base + 6); }
        if (EN(10) && IN_PH(base + 7)) { c.fresh();
            pg8::Gemm g{c.H, (const u16*)(W + WL_Q), mrows, DM, DM}; pg8::StaticOrder S; S.init(mrows, DM, c.G, c.bid);
            pg8::EpiBf16<0> E{c.PQ, DM, nullptr, 0, 0};
            pg8::gemm_phase<pg8::EpiBf16<0>, pg8::StaticOrder>(c.lds, g, S, E, nullptr);
            SEAM(base + 7);
        }
        if (EN(11) && IN_PH(base + 8)) { c.fresh();
            for (int it = c.bid; it < (mrows / 64) * 8; it += c.G) topk_item(c, l, it >> 3, it & 7);
            SEAM(base + 8);
        }
        if (EN(12) && IN_PH(base + 9)) { c.fresh();
            for (int t = c.bid * 8 + c.wave; t < mrows; t += c.G * 8) peer_item(c, l, t);
            SEAM(base + 9);
        }
    }
}

#ifndef N_LAUNCH_MODE
#define N_LAUNCH_MODE 0
#endif
extern "C" void kernel_launch(void* const* d_in, const int* in_sizes, int n_in, void* d_out, int out_size, void* d_ws, size_t ws_size, hipStream_t stream) {
    static int grid = 0;
    if (grid == 0) {
        if (n_in != N_IN || ws_size < WS_END) { fprintf(stderr, "kernel_launch: unexpected n_in %d or ws %zu < %zu\n", n_in, ws_size, (size_t)WS_END); grid = -1; return; }
        int dev = 0, cus = 0, per_cu = 0;
        hipGetDevice(&dev); hipDeviceGetAttribute(&cus, hipDeviceAttributeMultiprocessorCount, dev);
        if (hipFuncSetAttribute((const void*)fwd_kernel, hipFuncAttributeMaxDynamicSharedMemorySize, LDS_BYTES) != hipSuccess) { fprintf(stderr, "kernel_launch: hipFuncSetAttribute failed\n"); grid = -1; return; }
        if (hipOccupancyMaxActiveBlocksPerMultiprocessor(&per_cu, (const void*)fwd_kernel, 512, LDS_BYTES) != hipSuccess || per_cu < 1) fprintf(stderr, "kernel_launch: occupancy query says %d\n", per_cu);
        (void)hipGetLastError();
        grid = cus > 0 ? cus : 256;
    }
    if (grid < 0) return;
    hipMemsetAsync((char*)d_ws + WS_BAR, 0, 16384, stream);
    Args a{};
    for (int i = 0; i < N_IN; ++i) a.in[i] = (const float*)d_in[i];
    a.out = (float*)d_out; a.ws = (unsigned char*)d_ws;
#if N_LAUNCH_MODE == 1
    a.ph_lo = 0; a.ph_hi = N_PHASES;
    hipLaunchKernelGGL(fwd_kernel, dim3(grid), dim3(512), LDS_BYTES, stream, a);
#else
    for (int p = 0; p < N_PHASES; ++p) { a.ph_lo = p; a.ph_hi = p + 1; hipLaunchKernelGGL(fwd_kernel, dim3(grid), dim3(512), LDS_BYTES, stream, a); }
#endif
}
```

```cpp
#include <hip/hip_runtime.h>
#include <cstdio>
namespace pg8 {
#define PG8_LAS __attribute__((address_space(3)))
typedef unsigned short bf16_t;
typedef short bf16x8 __attribute__((ext_vector_type(8)));
typedef float f32x4 __attribute__((ext_vector_type(4)));
typedef unsigned u32x4 __attribute__((ext_vector_type(4)));
constexpr int BM = 256, BK = 64, HALF = 128, HTB = HALF * BK * 2  , STAGE_BYTES = 8 * HTB, NXCD = 8, WGM = 8;

__host__ __device__ __forceinline__ int lds_byte(int r, int c) { const int st = (r >> 4) * 2 + (c >> 5), rr = r & 15, cc = c & 31, ob = rr * 64 + cc * 2; return st * 1024 + (ob ^ (((ob >> 9) & 1) << 5)); }
__host__ __device__ __forceinline__ void stage_rc(int b, int& R, int& C) { const int st = b / 1024, sb = b % 1024, swz = sb ^ (((sb >> 9) & 1) << 5); R = (st >> 1) * 16 + swz / 64; C = (st & 1) * 32 + (swz % 64) / 2; }
__host__ __device__ __forceinline__ int perm32(int rho) { const int n = rho >> 4, i = rho & 15; return 8 * (i >> 2) + 4 * n + (i & 3); }

struct Unit { int pm, pn, w; };
struct Gemm { const bf16_t* A; const bf16_t* Bt; int M, N, K; const bf16_t* A2; const bf16_t* Bt2; };

struct StaticOrder {
    int nM, nN, nwg, G, c;
    __host__ __device__ void init(int M, int N, int G_, int c_) { nM = M / BM; nN = N / BM; nwg = nM * nN; G = G_; c = c_; }
    __host__ __device__ bool next(int i, Unit& u) const {
        const long L = (long)i * G + c; if (L >= nwg) return false;
        int wgid = (int)L; { const int q = nwg / NXCD, r = nwg % NXCD, xcd = wgid % NXCD, off = wgid / NXCD; wgid = (xcd < r ? xcd * (q + 1) : r * (q + 1) + (xcd - r) * q) + off; }
        const int nig = WGM * nN, gid = wgid / nig, fm = gid * WGM, gsz = (nM - fm) < WGM ? (nM - fm) : WGM;
        u.pm = fm + ((wgid % nig) % gsz); u.pn = (wgid % nig) / gsz; u.w = 0; return true;
    }
    __device__ __forceinline__ void a_ready(const Unit&) const {}
    __device__ __forceinline__ void done(const Unit&) const {}
};
struct DualOrder {
    StaticOrder s0, s1; int G, c;
    __host__ __device__ void init(int M0, int N0, int M1, int N1, int G_, int c_) { s0.init(M0, N0, 1, 0); s1.init(M1, N1, 1, 0); G = G_; c = c_; }
    __host__ __device__ bool next(int i, Unit& u) const {
        const long L = (long)i * G + c;
        if (L < s0.nwg) { s0.next((int)L, u); u.w = 0; return true; }
        if (L < s0.nwg + s1.nwg) { s1.next((int)(L - s0.nwg), u); u.w = 1; return true; }
        return false;
    }
    __device__ __forceinline__ void a_ready(const Unit&) const {}
    __device__ __forceinline__ void done(const Unit&) const {}
};
__device__ __forceinline__ unsigned cvt_pk_bf16(float lo, float hi) { unsigned r; asm volatile("v_cvt_pk_bf16_f32 %0, %1, %2" : "=v"(r) : "v"(lo), "v"(hi)); return r; }
typedef float f32x2 __attribute__((ext_vector_type(2)));
__device__ __forceinline__ f32x2 gelu_pk(f32x2 v) {
    const f32x2 av = __builtin_elementwise_abs(v), d = av * 0.2316418882f + 1.0f;
    f32x2 t; t.x = __builtin_amdgcn_rcpf(d.x); t.y = __builtin_amdgcn_rcpf(d.y);
    f32x2 q = t * 0.5307027145f + (-0.7265760135f); q = q * t + 0.7107068705f; q = q * t + (-0.142248368f); q = q * t + 0.127414796f; q = q * t;
    const f32x2 s = (v * v) * (-0.72134752044f);
    f32x2 e; e.x = __builtin_amdgcn_exp2f(s.x); e.y = __builtin_amdgcn_exp2f(s.y);
    const f32x2 m = v * (q * e), r = v - m;
    f32x2 o; o.x = v.x < 0.f ? m.x : r.x; o.y = v.y < 0.f ? m.y : r.y; return o;
}
template <int ACT  > struct EpiBf16 {
    static constexpr bool PERM = true, AFTER_DRAIN = false;
    bf16_t* O; int ldc; const float* bias; int split_cols; size_t split_stride;
    __device__ __forceinline__ void operator()(const f32x4 (&acc)[2][2][4][2], const Unit& u, int wr, int wc, int fr, int fq) const {
        const int row0 = u.pm * BM + wr * 64 + fr; int colt = u.pn * BM; bf16_t* base = O;
        if (split_cols) { const int t = colt / split_cols; base += (size_t)t * split_stride; colt -= t * split_cols; }
        const int col0 = colt + wc * 32 + 8 * fq, bcol0 = u.pn * BM + wc * 32 + 8 * fq;
        f32x4 bv[2][2];
#pragma unroll
        for (int bj = 0; bj < 2; ++bj)
#pragma unroll
            for (int n = 0; n < 2; ++n) bv[bj][n] = bias ? *(const f32x4*)(bias + bcol0 + bj * HALF + 4 * n) : (f32x4){0.f, 0.f, 0.f, 0.f};
#pragma unroll
        for (int ai = 0; ai < 2; ++ai)
#pragma unroll
            for (int m = 0; m < 4; ++m) { bf16_t* rowp = base + (size_t)(row0 + ai * HALF + m * 16) * ldc + col0;
#pragma unroll
                for (int bj = 0; bj < 2; ++bj) { f32x4 v0 = acc[ai][bj][m][0] + bv[bj][0], v1 = acc[ai][bj][m][1] + bv[bj][1];
                    if (ACT == 1) { f32x2 a = gelu_pk((f32x2){v0[0], v0[1]}), b = gelu_pk((f32x2){v0[2], v0[3]}), c = gelu_pk((f32x2){v1[0], v1[1]}), d = gelu_pk((f32x2){v1[2], v1[3]});
                        v0 = (f32x4){a.x, a.y, b.x, b.y}; v1 = (f32x4){c.x, c.y, d.x, d.y}; }
                    if (ACT == 2) {
#pragma unroll
                        for (int j = 0; j < 4; ++j) { v0[j] = 0.5f * v0[j] * (1.0f + erff(v0[j] * 0.70710678f)); v1[j] = 0.5f * v1[j] * (1.0f + erff(v1[j] * 0.70710678f)); } }
                    u32x4 w; w.x = cvt_pk_bf16(v0[0], v0[1]); w.y = cvt_pk_bf16(v0[2], v0[3]); w.z = cvt_pk_bf16(v1[0], v1[1]); w.w = cvt_pk_bf16(v1[2], v1[3]);
                    *(u32x4*)(rowp + bj * HALF) = w; } }
    }
};
template <class Epi, class Sched, bool STAMP = false>
__device__ __forceinline__ void gemm_phase(PG8_LAS unsigned char* lds, const Gemm g, const Sched& S, const Epi& E, unsigned long long* stamps) {
    int tid = threadIdx.x; asm volatile("" : "+v"(tid)); const int wid = __builtin_amdgcn_readfirstlane(tid >> 6), lane = tid & 63, wr = wid >> 2, wc = wid & 3, fr = lane & 15, fq = lane >> 4;
    const int K = g.K, nt = K / BK;
    int ts_lo = 0, ts_hi = 0, nts = 0; const unsigned long long rt_entry = STAMP ? (unsigned long long)wall_clock64() : 0ull;
#define PG8_STAMP() do { if (STAMP && wid == 0 && nts < 64) { const unsigned long long _c = (unsigned long long)clock64(); \
        ts_lo = (lane == nts) ? (int)(unsigned)_c : ts_lo; ts_hi = (lane == nts) ? (int)(unsigned)(_c >> 32) : ts_hi; ++nts; } } while (0)
    PG8_STAMP();
    unsigned voffA[2], voffB[2];
#pragma unroll
    for (int i = 0; i < 2; ++i) { int R, C; stage_rc(tid * 16 + i * 8192, R, C); const int Rb = Epi::PERM ? ((R & ~31) + perm32(R & 31)) : R;
        voffA[i] = (unsigned)(R * K + C) * 2u; voffB[i] = (unsigned)(Rb * K + C) * 2u; }
    const size_t kstep = (size_t)(BK * 2);
    const size_t hstep = (size_t)HALF * K * 2;
    const size_t tstep = 2 * hstep;
    const unsigned ldsw = (unsigned)wid * 1024u;
    const int aoff = lds_byte(wr * 64 + fr, fq * 8), boff = lds_byte(wc * 32 + fr, fq * 8);
#define PG8_SA(b, h) (((b) * 2 + (h)) * HTB)
#define PG8_SB(b, h) ((4 + (b) * 2 + (h)) * HTB)
#define PG8_STAGE(bufoff, gbase, voff) do { _Pragma("unroll") for (int _i = 0; _i < 2; ++_i) \
        __builtin_amdgcn_global_load_lds((const unsigned*)((const char*)(gbase) + (voff)[_i]), (PG8_LAS unsigned*)(lds + (bufoff) + ldsw + _i * 8192), 16, 0, 0); } while (0)
#define PG8_LDA(dst, b, h) do { _Pragma("unroll") for (int m = 0; m < 4; ++m) _Pragma("unroll") for (int k = 0; k < 2; ++k) dst[m][k] = *(const PG8_LAS bf16x8*)(lds + PG8_SA(b, h) + aoff + m * 2048 + k * 1024); } while (0)
#define PG8_LDB(dst, b, h) do { _Pragma("unroll") for (int n = 0; n < 2; ++n) _Pragma("unroll") for (int k = 0; k < 2; ++k) dst[n][k] = *(const PG8_LAS bf16x8*)(lds + PG8_SB(b, h) + boff + n * 2048 + k * 1024); } while (0)
#define PG8_MMA(ai, bj, At, Bt) do { __builtin_amdgcn_s_setprio(1); _Pragma("unroll") for (int m = 0; m < 4; ++m) _Pragma("unroll") for (int n = 0; n < 2; ++n) _Pragma("unroll") for (int k = 0; k < 2; ++k) \
        acc[ai][bj][m][n] = __builtin_amdgcn_mfma_f32_16x16x32_bf16(Bt[n][k], At[m][k], acc[ai][bj][m][n], 0, 0, 0); __builtin_amdgcn_s_setprio(0); } while (0)
#define PG8_WAIT_V(n) asm volatile("s_waitcnt vmcnt(" #n ")" ::: "memory")
#define PG8_WAIT_L(n) asm volatile("s_waitcnt lgkmcnt(" #n ")" ::: "memory")
#define PG8_BAR __builtin_amdgcn_s_barrier()
#define PG8_SCHED __builtin_amdgcn_sched_barrier(0)
    Unit cur, nxt; int ui = 0;
    if (!S.next(0, cur)) return;
    f32x4 acc[2][2][4][2];
#pragma unroll
    for (int a = 0; a < 2; ++a)
#pragma unroll
        for (int b = 0; b < 2; ++b)
#pragma unroll
            for (int m = 0; m < 4; ++m)
#pragma unroll
                for (int n = 0; n < 2; ++n) acc[a][b][m][n] = (f32x4){0.f, 0.f, 0.f, 0.f};
    bf16x8 At[4][2], B0[2][2], B1[2][2];
    const char* cA = (const char*)(cur.w ? g.A2 : g.A) + (size_t)cur.pm * tstep; const char* cB = (const char*)(cur.w ? g.Bt2 : g.Bt) + (size_t)cur.pn * tstep;
    S.a_ready(cur);
    PG8_STAGE(PG8_SB(0, 0), cB, voffB); PG8_STAGE(PG8_SA(0, 0), cA, voffA); PG8_STAGE(PG8_SB(0, 1), cB + hstep, voffB); PG8_STAGE(PG8_SA(0, 1), cA + hstep, voffA);
    if (wr == 1) PG8_BAR;
    PG8_WAIT_V(4); PG8_BAR;
    PG8_STAGE(PG8_SB(1, 0), cB + kstep, voffB); PG8_STAGE(PG8_SA(1, 0), cA + kstep, voffA); PG8_STAGE(PG8_SB(1, 1), cB + hstep + kstep, voffB);
    PG8_WAIT_V(6); PG8_BAR;
    PG8_STAMP();
    for (;;) {
        const bool has_next = S.next(ui + 1, nxt);
        const char* nA = has_next ? (const char*)(nxt.w ? g.A2 : g.A) + (size_t)nxt.pm * tstep : cA; const char* nB = has_next ? (const char*)(nxt.w ? g.Bt2 : g.Bt) + (size_t)nxt.pn * tstep : cB;
        for (int t = 0; t < nt; t += 2) {
            const bool last = (t == nt - 2);
            const char* a1 = cA + (size_t)(t + 1) * kstep;
            const char* a2 = last ? nA : cA + (size_t)(t + 2) * kstep; const char* b2 = last ? nB : cB + (size_t)(t + 2) * kstep;
            const char* a3 = a2 + kstep; const char* b3 = b2 + kstep;
            if (last && has_next) S.a_ready(nxt);
            PG8_LDB(B0, 0, 0); PG8_SCHED; PG8_LDA(At, 0, 0); PG8_STAGE(PG8_SA(1, 1), a1 + hstep, voffA);
            PG8_WAIT_L(8); PG8_BAR; PG8_WAIT_L(0); PG8_MMA(0, 0, At, B0); PG8_BAR; PG8_SCHED;
            PG8_LDB(B1, 0, 1); PG8_STAGE(PG8_SB(0, 0), b2, voffB);
            PG8_BAR; PG8_WAIT_L(0); PG8_MMA(0, 1, At, B1); PG8_BAR;
            PG8_LDA(At, 0, 1); PG8_STAGE(PG8_SA(0, 0), a2, voffA);
            PG8_BAR; PG8_WAIT_L(0); PG8_MMA(1, 0, At, B0); PG8_BAR; PG8_SCHED;
            PG8_STAGE(PG8_SB(0, 1), b2 + hstep, voffB);
            PG8_WAIT_V(6); PG8_BAR; PG8_MMA(1, 1, At, B1); PG8_BAR;
            PG8_LDB(B0, 1, 0); PG8_SCHED; PG8_LDA(At, 1, 0); PG8_STAGE(PG8_SA(0, 1), a2 + hstep, voffA);
            PG8_WAIT_L(8); PG8_BAR; PG8_WAIT_L(0); PG8_MMA(0, 0, At, B0); PG8_BAR; PG8_SCHED;
            PG8_LDB(B1, 1, 1); PG8_STAGE(PG8_SB(1, 0), b3, voffB);
            PG8_BAR; PG8_WAIT_L(0); PG8_MMA(0, 1, At, B1); PG8_BAR;
            PG8_LDA(At, 1, 1); PG8_STAGE(PG8_SA(1, 0), a3, voffA);
            PG8_BAR; PG8_WAIT_L(0); PG8_MMA(1, 0, At, B0); PG8_BAR; PG8_SCHED;
            PG8_STAGE(PG8_SB(1, 1), b3 + hstep, voffB);
            PG8_WAIT_V(6); PG8_BAR; PG8_MMA(1, 1, At, B1); PG8_BAR;
        }
        PG8_STAMP();
        if constexpr (!Epi::AFTER_DRAIN) { E(acc, cur, wr, wc, fr, fq); S.done(cur); }
        PG8_STAMP();
        if (!has_next) break;
#pragma unroll
        for (int a = 0; a < 2; ++a)
#pragma unroll
            for (int b = 0; b < 2; ++b)
#pragma unroll
                for (int m = 0; m < 4; ++m)
#pragma unroll
                    for (int n = 0; n < 2; ++n) acc[a][b][m][n] = (f32x4){0.f, 0.f, 0.f, 0.f};
        cur = nxt; cA = nA; cB = nB; ++ui;
    }
    PG8_WAIT_V(0);
    if (wr == 0) PG8_BAR;
    PG8_BAR;
    if constexpr (Epi::AFTER_DRAIN) { E.fused(acc, cur, wr, wc, fr, fq, lds, wid, lane); S.done(cur); }
    PG8_STAMP();
    if (STAMP && wid == 0) { stamps[lane] = lane < nts ? (((unsigned long long)(unsigned)ts_hi << 32) | (unsigned)ts_lo) : 0ull;
        if (lane == 62) stamps[62] = rt_entry; if (lane == 63) stamps[63] = (unsigned long long)wall_clock64(); }
#undef PG8_STAMP
#undef PG8_SA
#undef PG8_SB
#undef PG8_STAGE
#undef PG8_LDA
#undef PG8_LDB
#undef PG8_MMA
#undef PG8_WAIT_V
#undef PG8_WAIT_L
#undef PG8_BAR
#undef PG8_SCHED
}
}

#define XB_TMO      128
#define XB_XCNT(j)  (256  + 64 * (j))
#define XB_XSUB(j)  (1280 + 64 * (j))
#define XB_XGEN(j)  (2304 + 64 * (j))
#define XB_TOP      3328
#define XB_TOPGEN   3392
#define XCD_BAR_WORDS 3456
#define XB_SPIN_CAP (1u << 22)
#define LAS __attribute__((address_space(3)))

__device__ __forceinline__ unsigned xb_ld(unsigned* p)              { return __hip_atomic_load(p, __ATOMIC_RELAXED, __HIP_MEMORY_SCOPE_AGENT); }
__device__ __forceinline__ unsigned xb_add(unsigned* p, unsigned v) { return __hip_atomic_fetch_add(p, v, __ATOMIC_RELAXED, __HIP_MEMORY_SCOPE_AGENT); }
__device__ __forceinline__ unsigned xb_xcc_id() { return (unsigned)__builtin_amdgcn_s_getreg((3 << 11) | 20) & 0xFu; }
#define XB_SPIN(cond, bar) do { unsigned _sp = 0; while (cond) { __builtin_amdgcn_s_sleep(1); \
    if ((++_sp & 255u) == 0u) { if (xb_ld(&(bar)[XB_TMO])) break; if (_sp > XB_SPIN_CAP) { atomicAdd(&(bar)[XB_TMO], 1u); break; } } } } while (0)

struct XcdBarrier { unsigned* bar; unsigned x; volatile LAS unsigned* st; };

__device__ __forceinline__ XcdBarrier xcd_barrier_post(unsigned* bar, volatile LAS unsigned* st) {
    XcdBarrier b; b.bar = bar; b.x = xb_xcc_id(); b.st = st;
    if (threadIdx.x == 0) st[2] = xb_add(&bar[XB_XCNT(b.x)], 1u);
    return b;
}
__device__ __forceinline__ void xcd_barrier_complete(unsigned* bar, unsigned x, unsigned& nloc, unsigned& nx) {
    const unsigned G = gridDim.x * gridDim.y * gridDim.z;
    unsigned sum, cnt, mine, sp = 0u;
    for (;;) {
        sum = 0u; cnt = 0u; mine = 0u;
#pragma unroll
        for (unsigned j = 0; j < 16; ++j) { const unsigned c = xb_ld(&bar[XB_XCNT(j)]); sum += c; cnt += (c > 0u) ? 1u : 0u; mine = (j == x) ? c : mine; }
        if (sum == G) break;
        __builtin_amdgcn_s_sleep(1);
        if ((++sp & 255u) == 0u) { if (xb_ld(&bar[XB_TMO])) break; if (sp > XB_SPIN_CAP) { atomicAdd(&bar[XB_TMO], 1u); break; } }
    }
    nloc = mine > 0u ? mine : 1u; nx = cnt > 0u ? cnt : 1u;
}
__device__ __forceinline__ void xcd_barrier(const XcdBarrier& b) {
    asm volatile("s_waitcnt vmcnt(0)" ::: "memory");
    __syncthreads();
    if (threadIdx.x == 0) {
        unsigned* bar = b.bar;
        __builtin_amdgcn_s_waitcnt(0);
        unsigned nloc = b.st[0], nx = b.st[1];
        if (nloc == 0u) { xcd_barrier_complete(bar, b.x, nloc, nx); b.st[0] = nloc; b.st[1] = nx; }
        const unsigned old = xb_add(&bar[XB_XSUB(b.x)], 1u);
        const unsigned gen = old / nloc;
        if (old + 1u == (gen + 1u) * nloc) {
            __builtin_amdgcn_fence(__ATOMIC_RELEASE, "agent");
            asm volatile("s_waitcnt vmcnt(0)" ::: "memory");
            const unsigned og = xb_add(&bar[XB_TOP], 1u);
            const unsigned tg = og / nx;
            if (og + 1u == (tg + 1u) * nx) xb_add(&bar[XB_TOPGEN], 1u);
            else XB_SPIN(xb_ld(&bar[XB_TOPGEN]) == tg, bar);
            __builtin_amdgcn_fence(__ATOMIC_ACQUIRE, "agent");
            xb_add(&bar[XB_XGEN(b.x)], 1u);
            asm volatile("s_waitcnt vmcnt(0)" ::: "memory");
        } else {
            XB_SPIN(xb_ld(&bar[XB_XGEN(b.x)]) == gen, bar);
            __builtin_amdgcn_fence(__ATOMIC_ACQUIRE, "agent");
            asm volatile("s_waitcnt vmcnt(0)" ::: "memory");
        }
    }
    __syncthreads();
}

typedef unsigned short u16;
using pg8::bf16x8; using pg8::f32x4; using pg8::u32x4;
typedef float f32x2v __attribute__((ext_vector_type(2)));
typedef unsigned u32x2 __attribute__((ext_vector_type(2)));

constexpr int DM = 2048, NB = 4, SEQL = 4096, CTXL = 256, NLAT = NB * SEQL, NCTX = NB * CTXL, MROWS = NLAT + NCTX;
constexpr int DEPTH = 4, NMAIN = 3072, NTR = 1536;
constexpr int PJ_Q = 0, PJ_K = 1024, PJ_SU = 2048, PJ_SIN = 2560;
constexpr int TR_V = 0, TR_SV = 1024;
constexpr int NCHK = 68;
constexpr float EPSN = 1e-6f;

constexpr size_t al256(size_t x) { return (x + 255) & ~(size_t)255; }
constexpr size_t WS_BAR   = 0;
constexpr size_t WS_MOD   = 16384;
constexpr size_t WS_MODP  = al256(WS_MOD + (size_t)DEPTH * 5 * 6 * DM * 4);
constexpr size_t WS_X     = al256(WS_MODP + (size_t)64 * DEPTH * 5 * 6 * DM * 4);
constexpr size_t WS_H     = al256(WS_X + (size_t)MROWS * DM * 4);
constexpr size_t WS_PROJ  = al256(WS_H + (size_t)MROWS * DM * 2);
constexpr size_t WS_TR    = al256(WS_PROJ + (size_t)MROWS * NMAIN * 2);
constexpr size_t WS_ATT   = al256(WS_TR + (size_t)NTR * MROWS * 2);
constexpr size_t WS_SGU   = al256(WS_ATT + (size_t)MROWS * 1024 * 2);
constexpr size_t WS_S5Y   = al256(WS_SGU + (size_t)MROWS * 512 * 2);
constexpr size_t WS_S5O   = al256(WS_S5Y + (size_t)MROWS * 512 * 2);
constexpr size_t WS_YIN   = al256(WS_S5O + (size_t)MROWS * 512 * 2);
constexpr size_t WS_PQ    = al256(WS_YIN + (size_t)MROWS * DM * 2);
constexpr size_t PAIRS_MAX = (size_t)MROWS * 128;
constexpr size_t WS_ET    = al256(WS_PQ + (size_t)MROWS * DM * 2);
constexpr size_t WS_GT    = al256(WS_ET + PAIRS_MAX * 2);
constexpr size_t WS_PART  = al256(WS_GT + PAIRS_MAX * 4);
constexpr size_t WS_WT    = al256(WS_PART + 8 * PAIRS_MAX * 2);
constexpr size_t WS_H8    = al256(WS_WT + PAIRS_MAX * 2);
constexpr size_t WS_HSC   = al256(WS_H8 + (size_t)MROWS * DM);
constexpr size_t WS_SLOC  = al256(WS_HSC + (size_t)MROWS * 4);
constexpr size_t WS_WTS   = al256(WS_SLOC + (size_t)NB * 32 * 2 * NCHK * 64 * 8);
constexpr size_t WL_MAIN = 0;
constexpr size_t WL_TR   = WL_MAIN + (size_t)NMAIN * DM * 2;
constexpr size_t WL_OUT  = WL_TR + (size_t)NTR * DM * 2;
constexpr size_t WL_Q    = WL_OUT + (size_t)DM * DM * 2;
constexpr size_t WL_GLU  = WL_Q + (size_t)DM * DM * 2;
constexpr size_t WL_K12  = WL_GLU + (size_t)512 * 512 * 2;
constexpr size_t WL_U    = WL_K12 + (size_t)2 * 8 * 128 * 128 * 2;
constexpr size_t WL_V    = WL_U + (size_t)16384 * DM / 2;
constexpr size_t WL_SGUW = WL_V + (size_t)16384 * DM / 2;
constexpr size_t WL_SIZE = al256(WL_SGUW + (size_t)4 * 128 * 128 * 2);
constexpr float VSCALE = 5.5f, USCALE = 135.0f;
constexpr int PEER_NSL = 8, PEER_ROWB = 128;
constexpr size_t PEER_SLB = (size_t)16384 * 128;
constexpr size_t WS_END  = WS_WTS + DEPTH * WL_SIZE;

constexpr int LDS_BYTES = 147456;
constexpr int LDS_BARW  = LDS_BYTES - 32;

enum { I_X = 0, I_C, I_CTX, I_CCTX, I_ADAW, I_ADAB, I_NMIX, I_NFFN, I_WIN, I_WOUT, I_ONORM, I_RPB, I_SGUW, I_SGUB, I_SGUN, I_ARE, I_AIM, I_LOGDT, I_BRE, I_BIM, I_CRE, I_CIM, I_S5D, I_GLUW, I_GLUB,
       I_WQ, I_K1, I_K2, I_PU, I_PV, I_FNORM, N_IN };

struct Args { const float* in[N_IN]; float* out; unsigned char* ws; int ph_lo, ph_hi; };

struct Ctx {
    const float* in[N_IN]; float* out; unsigned char* ws; LAS unsigned char* lds;
    int tid, lane, wave, G, bid;
    float* MOD; float* MODP; u16* X; u16* H; u16* PROJ; u16* TR; u16* ATT; u16* SGU; u16* S5Y; u16* S5O; u16* YIN; u16* PQ; u16* ET; float* GT; u16* PART; u16* WT; unsigned char* H8; float* HSC; f32x2v* SLOC;
    int xi, nx, xr, xn;
    __device__ __forceinline__ unsigned char* wl(int l) const { return ws + WS_WTS + (size_t)l * WL_SIZE; }
    __device__ __forceinline__ void fresh() { int t = threadIdx.x; asm volatile("" : "+v"(t)); tid = t; lane = t & 63; wave = __builtin_amdgcn_readfirstlane(t >> 6); }
};

__device__ __forceinline__ float bf2f(u16 v) { return __uint_as_float(((unsigned)v) << 16); }
__device__ __forceinline__ float bflo(unsigned v) { return __uint_as_float(v << 16); }
__device__ __forceinline__ float bfhi(unsigned v) { return __uint_as_float(v & 0xffff0000u); }
__device__ __forceinline__ u16 f2bf(float f) { unsigned u = __float_as_uint(f); u += 0x7FFFu + ((u >> 16) & 1u); return (u16)(u >> 16); }
__device__ __forceinline__ unsigned pk2(float lo, float hi) { return pg8::cvt_pk_bf16(lo, hi); }
__device__ __forceinline__ float gelu_f(float v) {
    const float av = fabsf(v), t = __builtin_amdgcn_rcpf(av * 0.2316418882f + 1.0f);
    float q = t * 0.5307027145f + (-0.7265760135f); q = q * t + 0.7107068705f; q = q * t + (-0.142248368f); q = q * t + 0.127414796f; q = q * t;
    const float e = __builtin_amdgcn_exp2f((v * v) * (-0.72134752044f));
    const float m = v * (q * e);
    return v < 0.f ? m : v - m;
}
__device__ __forceinline__ float wave_sum(float v) {
    v += __shfl_xor(v, 32); v += __shfl_xor(v, 16); v += __shfl_xor(v, 8); v += __shfl_xor(v, 4); v += __shfl_xor(v, 2); v += __shfl_xor(v, 1); return v;
}
__device__ __forceinline__ int row_bidx(int row) { return row < NLAT ? (row >> 12) : 4; }
__device__ __forceinline__ void lds_fence() { asm volatile("s_waitcnt lgkmcnt(0)" ::: "memory"); }

__device__ __forceinline__ void tr_tile(const Ctx& c, const float* src, int ld, int k0, int n0, u16* dst, int drow0) {
    LAS float* T = (LAS float*)c.lds;
    const int t = c.tid, cq = t & 63, r0 = t >> 6;
    f32x4 v[8];
#pragma unroll
    for (int i = 0; i < 8; ++i) v[i] = *(const f32x4*)(src + (size_t)(k0 + r0 + 8 * i) * ld + n0 + 4 * cq);
#pragma unroll
    for (int i = 0; i < 8; ++i) *(LAS f32x4*)(T + (r0 + 8 * i) * 260 + 4 * cq) = v[i];
    __syncthreads();
#pragma unroll
    for (int i = 0; i < 4; ++i) {
        const int idx = t + 512 * i, n = idx >> 3, kc = idx & 7;
        float e[8];
#pragma unroll
        for (int q = 0; q < 8; ++q) e[q] = T[(8 * kc + q) * 260 + n];
        u32x4 o; o.x = pk2(e[0], e[1]); o.y = pk2(e[2], e[3]); o.z = pk2(e[4], e[5]); o.w = pk2(e[6], e[7]);
        *(u32x4*)(dst + (size_t)(drow0 + n) * DM + k0 + 8 * kc) = o;
    }
    __syncthreads();
}

__device__ __forceinline__ unsigned pack_i4(const float4& a, const float4& b) {
    const float ev[8] = {a.x, a.y, a.z, a.w, b.x, b.y, b.z, b.w};
    unsigned nb[8];
#pragma unroll
    for (int k2 = 0; k2 < 8; ++k2) { const int qv = (int)rintf(ev[k2] * USCALE); nb[k2] = (unsigned)(min(max(qv, -8), 7) + 8); }
    return nb[0] | (nb[4] << 4) | (nb[1] << 8) | (nb[5] << 12) | (nb[2] << 16) | (nb[6] << 20) | (nb[3] << 24) | (nb[7] << 28);
}
__device__ __forceinline__ unsigned pack_fp4(const float4& a, const float4& b) {
    unsigned w = 0u;
    w = __builtin_amdgcn_cvt_scalef32_pk_fp4_f32(w, a.x * VSCALE, a.y * VSCALE, 1.0f, 0); w = __builtin_amdgcn_cvt_scalef32_pk_fp4_f32(w, a.z * VSCALE, a.w * VSCALE, 1.0f, 1);
    w = __builtin_amdgcn_cvt_scalef32_pk_fp4_f32(w, b.x * VSCALE, b.y * VSCALE, 1.0f, 2); w = __builtin_amdgcn_cvt_scalef32_pk_fp4_f32(w, b.z * VSCALE, b.w * VSCALE, 1.0f, 3);
    return w;
}
template <bool IS_U>
__device__ __forceinline__ void peer_convert(const Ctx& c, int l, int b0, int nb) {
    if (c.bid < b0 || c.bid >= b0 + nb) return;
    const size_t n32 = (size_t)16384 * DM / 32, stride = (size_t)nb * 512;
    const float4* src = (const float4*)((IS_U ? c.in[I_PU] : c.in[I_PV]) + (size_t)l * 16384 * DM);
    u32x4* dst = (u32x4*)(c.wl(l) + (IS_U ? WL_U : WL_V));
    for (size_t i = (size_t)(c.bid - b0) * 512 + c.tid; i < n32; i += 2 * stride) {
        const size_t i2 = i + stride; const bool two = i2 < n32; const size_t j2 = two ? i2 : i;
        float4 a[8], b[8];
#pragma unroll
        for (int q = 0; q < 8; ++q) { a[q] = src[8 * i + q]; b[q] = src[8 * j2 + q]; }
        u32x4 o, p;
        if (IS_U) { o = (u32x4){pack_i4(a[0], a[1]), pack_i4(a[2], a[3]), pack_i4(a[4], a[5]), pack_i4(a[6], a[7])}; p = (u32x4){pack_i4(b[0], b[1]), pack_i4(b[2], b[3]), pack_i4(b[4], b[5]), pack_i4(b[6], b[7])}; }
        else      { o = (u32x4){pack_fp4(a[0], a[1]), pack_fp4(a[2], a[3]), pack_fp4(a[4], a[5]), pack_fp4(a[6], a[7])}; p = (u32x4){pack_fp4(b[0], b[1]), pack_fp4(b[2], b[3]), pack_fp4(b[4], b[5]), pack_fp4(b[6], b[7])}; }
        dst[((i & 63) >> 3) * 131072 + (i >> 6) * 8 + (i & 7)] = o; if (two) dst[((i2 & 63) >> 3) * 131072 + (i2 >> 6) * 8 + (i2 & 7)] = p;
    }
}
__device__ __forceinline__ void peer_convert_u(const Ctx& c, int l, int b0, int nb) { peer_convert<true>(c, l, b0, nb); }
__device__ __forceinline__ void peer_convert_v(const Ctx& c, int l, int b0, int nb) { peer_convert<false>(c, l, b0, nb); }

__device__ __forceinline__ void phase_prologue(const Ctx& c) {
    const int G = c.G, bid = c.bid, tid = c.tid;
    {
        const size_t n8 = (size_t)MROWS * DM / 8, nl8 = (size_t)NLAT * DM / 8;
        const float4* sx = (const float4*)c.in[I_X]; const float4* sc = (const float4*)c.in[I_CTX]; u32x4* dx = (u32x4*)c.X;
        for (size_t i = (size_t)bid * 512 + tid; i < n8; i += (size_t)G * 512) {
            const float4* s = i < nl8 ? sx + 2 * i : sc + 2 * (i - nl8);
            const float4 a = s[0], b = s[1];
            dx[i] = (u32x4){pk2(a.x, a.y), pk2(a.z, a.w), pk2(b.x, b.y), pk2(b.z, b.w)};
        }
    }
    for (int l = 0; l < DEPTH; ++l) {
        unsigned char* W = c.wl(l);
        const float* win = c.in[I_WIN] + (size_t)l * DM * 4608;
        for (int it = bid; it < 32 * 18; it += G) {
            const int kt = it & 31, nt = it >> 5, n0 = nt * 256;
            u16* dst; int drow;
            if (n0 < 2048) { dst = (u16*)(W + WL_MAIN); drow = n0; }
            else if (n0 < 3072) { dst = (u16*)(W + WL_TR); drow = n0 - 2048; }
            else if (n0 < 3584) { dst = (u16*)(W + WL_MAIN); drow = 2048 + (n0 - 3072); }
            else if (n0 < 4096) { dst = (u16*)(W + WL_TR); drow = 1024 + (n0 - 3584); }
            else { dst = (u16*)(W + WL_MAIN); drow = 2560 + (n0 - 4096); }
            tr_tile(c, win, 4608, kt * 64, n0, dst, drow);
        }
        const float* wout = c.in[I_WOUT] + (size_t)l * DM * DM;
        for (int it = bid; it < 32 * 8; it += G) tr_tile(c, wout, DM, (it & 31) * 64, (it >> 5) * 256, (u16*)(W + WL_OUT), (it >> 5) * 256);
        const float* wq = c.in[I_WQ] + (size_t)l * DM * DM;
        for (int it = bid; it < 32 * 8; it += G) tr_tile(c, wq, DM, (it & 31) * 64, (it >> 5) * 256, (u16*)(W + WL_Q), (it >> 5) * 256);
        {
            const float* gw = c.in[I_GLUW] + (size_t)l * 512 * 512; u16* dst = (u16*)(W + WL_GLU);
            LAS float* T = (LAS float*)c.lds;
            for (int it = bid; it < 8 * 8; it += G) {
                const int k0 = (it & 7) * 64, n0 = (it >> 3) * 64, t = tid;
#pragma unroll
                for (int i = 0; i < 8; ++i) { const int r = (t >> 6) + 8 * i; T[r * 65 + (t & 63)] = gw[(size_t)(k0 + r) * 512 + n0 + (t & 63)]; }
                __syncthreads();
#pragma unroll
                for (int i = 0; i < 4; ++i) { const int n = (t >> 5) + 16 * i, kp = t & 31;
                    *(unsigned*)(dst + (size_t)(n0 + n) * 512 + k0 + 2 * kp) = pk2(T[(2 * kp) * 65 + n], T[(2 * kp + 1) * 65 + n]); }
                __syncthreads();
            }
        }
        {
            const float* sw = c.in[I_SGUW] + (size_t)l * 4 * 128 * 128; u16* dst = (u16*)(W + WL_SGUW);
            for (int i = bid * 512 + tid; i < 4 * 128 * 128 / 2; i += G * 512) *(unsigned*)(dst + 2 * i) = pk2(sw[2 * i], sw[2 * i + 1]);
        }
        {
            u16* dst = (u16*)(W + WL_K12);
            const float* k1 = c.in[I_K1] + (size_t)l * 8 * 128 * 128; const float* k2 = c.in[I_K2] + (size_t)l * 8 * 128 * 128;
            for (int i = bid * 512 + tid; i < 2 * 131072 / 2; i += G * 512) {
                const int e = 2 * i; const float* s = e < 131072 ? k1 + e : k2 + (e - 131072);
                *(unsigned*)(dst + e) = pk2(s[0], s[1]);
            }
        }
    }
    { const int nl = (G == 256) ? 1 : DEPTH;
      for (int l = 0; l < nl; ++l) { peer_convert_u(c, l, 0, G); peer_convert_v(c, l, 0, G); } }
    {
        LAS float* S = (LAS float*)c.lds;
        for (int it = bid; it < DEPTH * 24 * 16; it += G) {
            const int kc = it & 15, nb = (it >> 4) % 24, l = it / (16 * 24);
            __syncthreads();
            for (int i = tid; i < 640; i += 512) { const int r = i >> 7, kk = i & 127; const float v = r < 4 ? c.in[I_C][r * DM + kc * 128 + kk] : c.in[I_CCTX][kc * 128 + kk]; S[i] = v / (1.0f + __expf(-v)); }
            __syncthreads();
            const int cq = tid & 127, kq = tid >> 7, n = nb * 512 + 4 * cq;
            const float* w = c.in[I_ADAW] + ((size_t)l * DM + kc * 128 + kq * 32) * 12288 + n;
            float4 a[5];
#pragma unroll
            for (int r = 0; r < 5; ++r) a[r] = make_float4(0.f, 0.f, 0.f, 0.f);
#pragma unroll 16
            for (int kk = 0; kk < 32; ++kk) {
                const float4 wv = *(const float4*)(w + (size_t)kk * 12288);
#pragma unroll
                for (int r = 0; r < 5; ++r) { const float sv = S[r * 128 + kq * 32 + kk]; a[r].x += sv * wv.x; a[r].y += sv * wv.y; a[r].z += sv * wv.z; a[r].w += sv * wv.w; }
            }
            float* o = c.MODP + ((size_t)((kc * 4 + kq) * DEPTH + l) * 5) * 12288 + n;
#pragma unroll
            for (int r = 0; r < 5; ++r) *(float4*)(o + (size_t)r * 12288) = a[r];
        }
        __syncthreads();
    }
}

__device__ __forceinline__ void phase_modfin(const Ctx& c) {
    const int total = DEPTH * 5 * 12288;
    for (int i = c.bid * 512 + c.tid; i < total; i += c.G * 512) {
        const int n = i % 12288, l = i / (5 * 12288);
        float s = c.in[I_ADAB][l * 12288 + n];
#pragma unroll
        for (int kc = 0; kc < 64; ++kc) s += c.MODP[(size_t)kc * total + i];
        const int mi = n >> 11, col = n & 2047;
        if (mi == 1) s = c.in[I_NMIX][l * DM + col] * (1.0f + s);
        if (mi == 4) s = c.in[I_NFFN][l * DM + col] * (1.0f + s);
        c.MOD[i] = s;
    }
}

__device__ __forceinline__ void phase_normmod(const Ctx& c, int l, int which, int nrows, int row0 = 0, int b0 = 0, int nb = 0) {
    if (nb == 0) nb = c.G;
    if (c.bid < b0 || c.bid >= b0 + nb) return;
    int row = row0 + (c.bid - b0) * 8 + c.wave;
    if (row >= row0 + nrows) return;
    u32x2 xn[8];
    { const u32x2* xp = (const u32x2*)(c.X + (size_t)row * DM);
#pragma unroll
      for (int i = 0; i < 8; ++i) xn[i] = xp[c.lane + 64 * i]; }
    for (; row < row0 + nrows; row += nb * 8) {
        const int bi = row_bidx(row);
        const float* sh = c.MOD + ((size_t)(l * 5 + bi) * 6 + (which ? 3 : 0)) * DM; const float* sc = sh + DM;
        float4 v[8]; float ss = 0.f;
#pragma unroll
        for (int i = 0; i < 8; ++i) { const u32x2 xw = xn[i]; v[i] = make_float4(bflo(xw.x), bfhi(xw.x), bflo(xw.y), bfhi(xw.y)); ss += v[i].x * v[i].x + v[i].y * v[i].y + v[i].z * v[i].z + v[i].w * v[i].w; }
        float4 s1v[8], s0v[8];
#pragma unroll
        for (int i = 0; i < 8; ++i) { const int e = 4 * (c.lane + 64 * i); s1v[i] = *(const float4*)(sc + e); s0v[i] = *(const float4*)(sh + e); }
        asm volatile("" ::: "memory");
        { const u32x2* xp = (const u32x2*)(c.X + (size_t)min(row + nb * 8, row0 + nrows - 1) * DM);
#pragma unroll
          for (int i = 0; i < 8; ++i) xn[i] = xp[c.lane + 64 * i]; }
        asm volatile("" ::: "memory");
        ss = wave_sum(ss);
        const float rstd = rsqrtf(ss * (1.0f / DM) + EPSN);
        uint2* hp = (uint2*)(c.H + (size_t)row * DM);
        float amax = 0.f;
#pragma unroll
        for (int i = 0; i < 8; ++i) {
            const float4 s1 = s1v[i], s0 = s0v[i];
            const float y0 = v[i].x * rstd * s1.x + s0.x, y1 = v[i].y * rstd * s1.y + s0.y;
            const float y2 = v[i].z * rstd * s1.z + s0.z, y3 = v[i].w * rstd * s1.w + s0.w;
            uint2 o; o.x = pk2(y0, y1); o.y = pk2(y2, y3); hp[c.lane + 64 * i] = o;
            if (which) { v[i] = make_float4(y0, y1, y2, y3); amax = fmaxf(fmaxf(amax, fmaxf(fabsf(y0), fabsf(y1))), fmaxf(fabsf(y2), fabsf(y3))); }
        }
        if (which) {
            amax = fmaxf(amax, __shfl_xor(amax, 32)); amax = fmaxf(amax, __shfl_xor(amax, 16)); amax = fmaxf(amax, __shfl_xor(amax, 8));
            amax = fmaxf(amax, __shfl_xor(amax, 4)); amax = fmaxf(amax, __shfl_xor(amax, 2)); amax = fmaxf(amax, __shfl_xor(amax, 1));
            const float qs = amax > 0.f ? 127.0f / amax : 0.f;
            unsigned* qp = (unsigned*)(c.H8 + (size_t)row * DM);
#pragma unroll
            for (int i = 0; i < 8; ++i) {
                const int q0 = (int)rintf(v[i].x * qs), q1 = (int)rintf(v[i].y * qs), q2 = (int)rintf(v[i].z * qs), q3 = (int)rintf(v[i].w * qs);
                qp[c.lane + 64 * i] = (unsigned)(q0 & 0xFF) | ((unsigned)(q1 & 0xFF) << 8) | ((unsigned)(q2 & 0xFF) << 16) | ((unsigned)(q3 & 0xFF) << 24);
            }
            if (c.lane == 0) c.HSC[row] = amax * (1.0f / 127.0f);
        }
    }
}

struct EpiProj {
    static constexpr bool PERM = true, AFTER_DRAIN = false;
    u16* P; u16* T;
    __device__ __forceinline__ void operator()(const f32x4 (&acc)[2][2][4][2], const pg8::Unit& u, int wr, int wc, int fr, int fq) const {
        u16* base = u.w ? T : P; const int ldc = u.w ? MROWS : NMAIN;
        const int row0 = u.pm * 256 + wr * 64 + fr, col0 = u.pn * 256 + wc * 32 + 8 * fq;
#pragma unroll
        for (int ai = 0; ai < 2; ++ai)
#pragma unroll
            for (int m = 0; m < 4; ++m) { u16* rowp = base + (size_t)(row0 + ai * 128 + m * 16) * ldc + col0;
#pragma unroll
                for (int bj = 0; bj < 2; ++bj) { const f32x4 v0 = acc[ai][bj][m][0], v1 = acc[ai][bj][m][1];
                    u32x4 w; w.x = pk2(v0[0], v0[1]); w.y = pk2(v0[2], v0[3]); w.z = pk2(v1[0], v1[1]); w.w = pk2(v1[2], v1[3]);
                    *(u32x4*)(rowp + bj * 128) = w; } }
    }
};
struct EpiResid {
    static constexpr bool PERM = false, AFTER_DRAIN = false;
    u16* X; const float* modl; int row_off;
    __device__ __forceinline__ void operator()(const f32x4 (&acc)[2][2][4][2], const pg8::Unit& u, int wr, int wc, int fr, int fq) const {
        const int row0 = u.pm * 256 + wr * 64 + fr, col0 = u.pn * 256 + wc * 32 + 4 * fq;
        const int bi = row_bidx(u.pm * 256 + row_off);
        const float* gp = modl + ((size_t)bi * 6 + 2) * DM + col0;
        f32x4 gv[2][2];
#pragma unroll
        for (int bj = 0; bj < 2; ++bj)
#pragma unroll
            for (int n = 0; n < 2; ++n) gv[bj][n] = *(const f32x4*)(gp + bj * 128 + n * 16);
#pragma unroll
        for (int ai = 0; ai < 2; ++ai)
#pragma unroll
            for (int m = 0; m < 4; ++m) { u16* rowp = X + (size_t)(row0 + ai * 128 + m * 16) * DM + col0;
#pragma unroll
                for (int bj = 0; bj < 2; ++bj)
#pragma unroll
                    for (int n = 0; n < 2; ++n) { u32x2* p = (u32x2*)(rowp + bj * 128 + n * 16); const u32x2 xw = *p; const f32x4 r = (f32x4){bflo(xw.x), bfhi(xw.x), bflo(xw.y), bfhi(xw.y)} + gv[bj][n] * acc[ai][bj][m][n];
                        *p = (u32x2){pk2(r[0], r[1]), pk2(r[2], r[3])}; } }
    }
};
struct EpiGlu {
    static constexpr bool PERM = true, AFTER_DRAIN = false;
    const u16* Y; u16* O; const float* bias;
    __device__ __forceinline__ void operator()(const f32x4 (&acc)[2][2][4][2], const pg8::Unit& u, int wr, int wc, int fr, int fq) const {
        const int row0 = u.pm * 256 + wr * 64 + fr, col0 = u.pn * 256 + wc * 32 + 8 * fq;
        f32x4 bv[2][2];
#pragma unroll
        for (int bj = 0; bj < 2; ++bj)
#pragma unroll
            for (int n = 0; n < 2; ++n) bv[bj][n] = *(const f32x4*)(bias + col0 + bj * 128 + 4 * n);
#pragma unroll
        for (int ai = 0; ai < 2; ++ai)
#pragma unroll
            for (int m = 0; m < 4; ++m) { const size_t off = (size_t)(row0 + ai * 128 + m * 16) * 512 + col0;
#pragma unroll
                for (int bj = 0; bj < 2; ++bj) {
                    const u32x4 yv = *(const u32x4*)(Y + off + bj * 128);
                    const f32x4 v0 = acc[ai][bj][m][0] + bv[bj][0], v1 = acc[ai][bj][m][1] + bv[bj][1];
                    float y[8] = {bflo(yv.x), bfhi(yv.x), bflo(yv.y), bfhi(yv.y), bflo(yv.z), bfhi(yv.z), bflo(yv.w), bfhi(yv.w)};
                    float z[8] = {v0[0], v0[1], v0[2], v0[3], v1[0], v1[1], v1[2], v1[3]};
#pragma unroll
                    for (int j = 0; j < 8; ++j) y[j] = y[j] / (1.0f + __expf(-z[j]));
                    u32x4 w; w.x = pk2(y[0], y[1]); w.y = pk2(y[2], y[3]); w.z = pk2(y[4], y[5]); w.w = pk2(y[6], y[7]);
                    *(u32x4*)(O + off + bj * 128) = w; } }
    }
};

constexpr int AT_KC_STRIDE = 272, AT_VC_STRIDE = 528;
constexpr int AT_KC_OFF = 0, AT_VC_OFF = 256 * AT_KC_STRIDE, AT_BT_OFF = AT_VC_OFF + 128 * AT_VC_STRIDE, AT_END = AT_BT_OFF + 15 * 64 * 4;
static_assert(AT_END <= LDS_BARW, "attention LDS");
__device__ __forceinline__ void attn_block_load(const Ctx& c, int l, int b, int head) {
    const int tid = c.tid;
    __syncthreads();
    u32x4 tk[8], tv[8];
#pragma unroll
    for (int i = 0; i < 8; ++i) { const int e = tid + 512 * i, key = e >> 4, ch = e & 15; tk[i] = *(const u32x4*)(c.PROJ + (size_t)(NLAT + b * CTXL + key) * NMAIN + PJ_K + head * 128 + ch * 8); }
#pragma unroll
    for (int i = 0; i < 8; ++i) { const int e = tid + 512 * i, d = e >> 5, ch = e & 31; tv[i] = *(const u32x4*)(c.TR + (size_t)(TR_V + head * 128 + d) * MROWS + NLAT + b * CTXL + ch * 8); }
#pragma unroll
    for (int i = 0; i < 8; ++i) { const int e = tid + 512 * i, key = e >> 4, ch = e & 15; *(LAS u32x4*)(c.lds + AT_KC_OFF + key * AT_KC_STRIDE + ch * 16) = tk[i]; }
#pragma unroll
    for (int i = 0; i < 8; ++i) { const int e = tid + 512 * i, d = e >> 5, ch = e & 31; *(LAS u32x4*)(c.lds + AT_VC_OFF + d * AT_VC_STRIDE + ch * 16) = tv[i]; }
    LAS float* BT = (LAS float*)(c.lds + AT_BT_OFF);
    const float* src = c.in[I_RPB] + (size_t)(l * 8 + head) * 465;
    for (int i = tid; i < 15 * 64; i += 512) { const int col = (i & 63) - 16, row = i >> 6; BT[i] = (col >= 0 && col < 31) ? src[row * 31 + col] : 0.f; }
    __syncthreads();
}
template <bool WINDOW>
__device__ __forceinline__ void attn_segment(const Ctx& c, int b, int r, int head, int qt, int r_start, int cbase, const bf16x8 (&qf)[4], f32x4 (&O)[8], float& mrun, float& lrun) {
    const int lane = c.lane, n = lane & 15, lg = lane >> 4;
    f32x4 S[8][2];
    if (WINDOW) {
        const u16* kp0 = c.PROJ + (size_t)(b * SEQL + r_start * 64 + cbase + 8 * (n >> 2) + (n & 3)) * NMAIN + PJ_K + head * 128 + 8 * lg;
#pragma unroll
        for (int gi = 0; gi < 8; ++gi) {
            bf16x8 kf[2][4];
#pragma unroll
            for (int t = 0; t < 2; ++t)
#pragma unroll
                for (int kk = 0; kk < 4; ++kk) kf[t][kk] = *(const bf16x8*)(kp0 + (size_t)(gi * 64 + 4 * t) * NMAIN + 32 * kk);
            __builtin_amdgcn_sched_barrier(0);
#pragma unroll
            for (int t = 0; t < 2; ++t) {
                f32x4 acc = {0.f, 0.f, 0.f, 0.f};
#pragma unroll
                for (int kk = 0; kk < 4; ++kk) acc = __builtin_amdgcn_mfma_f32_16x16x32_bf16(kf[t][kk], qf[kk], acc, 0, 0, 0);
                S[gi][t] = acc;
            }
            __builtin_amdgcn_sched_barrier(0);
        }
    } else {
#pragma unroll
        for (int gi = 0; gi < 8; ++gi) {
#pragma unroll
            for (int t = 0; t < 2; ++t) {
                const int ko = 8 * (n >> 2) + 4 * t + (n & 3);
                f32x4 acc = {0.f, 0.f, 0.f, 0.f};
                const LAS unsigned char* kp = c.lds + AT_KC_OFF + (32 * gi + ko) * AT_KC_STRIDE + 16 * lg;
#pragma unroll
                for (int kk = 0; kk < 4; ++kk) { const bf16x8 a = *(const LAS bf16x8*)(kp + 64 * kk); acc = __builtin_amdgcn_mfma_f32_16x16x32_bf16(a, qf[kk], acc, 0, 0, 0); }
                S[gi][t] = acc;
            }
        }
    }
    const float scale = 0.08838834764831845f;
    float mx = -3.0e38f;
    const int qc = 16 * qt + n, cs = min(max(qc - 8, 0), 48);
    const LAS float* BT = (const LAS float*)(c.lds + AT_BT_OFF);
    const int btbase = WINDOW ? (r_start - r + 7) * 64 + (cbase + 8 * lg - qc + 15 + 16) : 0;
#pragma unroll
    for (int gi = 0; gi < 8; ++gi)
#pragma unroll
        for (int t = 0; t < 2; ++t)
#pragma unroll
            for (int rr = 0; rr < 4; ++rr) {
                float s = S[gi][t][rr] * scale;
                if (WINDOW) {
                    const int kc = cbase + 8 * lg + 4 * t + rr;
                    const bool valid = (kc >= cs) && (kc < cs + 16);
                    const float bias = BT[btbase + gi * 64 + 4 * t + rr];
                    s = valid ? s + bias : -INFINITY;
                }
                S[gi][t][rr] = s; mx = fmaxf(mx, s);
            }
    mx = fmaxf(mx, __shfl_xor(mx, 16)); mx = fmaxf(mx, __shfl_xor(mx, 32));
    const float mnew = fmaxf(mrun, mx), resc = exp2f((mrun - mnew) * 1.4426950408889634f);
    float sum = 0.f;
#pragma unroll
    for (int gi = 0; gi < 8; ++gi)
#pragma unroll
        for (int t = 0; t < 2; ++t)
#pragma unroll
            for (int rr = 0; rr < 4; ++rr) { const float p = exp2f((S[gi][t][rr] - mnew) * 1.4426950408889634f); S[gi][t][rr] = p; sum += p; }
    sum += __shfl_xor(sum, 16); sum += __shfl_xor(sum, 32);
    lrun = lrun * resc + sum; mrun = mnew;
#pragma unroll
    for (int dt = 0; dt < 8; ++dt) O[dt] *= resc;
    if (WINDOW) {
        const u16* vp0 = c.TR + (size_t)(TR_V + head * 128 + n) * MROWS + (b * SEQL + r_start * 64 + cbase) + 8 * lg;
#pragma unroll
        for (int gi = 0; gi < 8; ++gi) {
            u32x4 pw; pw.x = pk2(S[gi][0][0], S[gi][0][1]); pw.y = pk2(S[gi][0][2], S[gi][0][3]); pw.z = pk2(S[gi][1][0], S[gi][1][1]); pw.w = pk2(S[gi][1][2], S[gi][1][3]);
            const bf16x8 pb = __builtin_bit_cast(bf16x8, pw);
            bf16x8 vf[8];
#pragma unroll
            for (int dt = 0; dt < 8; ++dt) vf[dt] = *(const bf16x8*)(vp0 + (size_t)(16 * dt) * MROWS + gi * 64);
            __builtin_amdgcn_sched_barrier(0);
#pragma unroll
            for (int dt = 0; dt < 8; ++dt) O[dt] = __builtin_amdgcn_mfma_f32_16x16x32_bf16(vf[dt], pb, O[dt], 0, 0, 0);
            __builtin_amdgcn_sched_barrier(0);
        }
    } else {
#pragma unroll
        for (int gi = 0; gi < 8; ++gi) {
            u32x4 pw; pw.x = pk2(S[gi][0][0], S[gi][0][1]); pw.y = pk2(S[gi][0][2], S[gi][0][3]); pw.z = pk2(S[gi][1][0], S[gi][1][1]); pw.w = pk2(S[gi][1][2], S[gi][1][3]);
            const bf16x8 pb = __builtin_bit_cast(bf16x8, pw);
            const LAS unsigned char* vp = c.lds + AT_VC_OFF + n * AT_VC_STRIDE + (32 * gi + 8 * lg) * 2;
#pragma unroll
            for (int dt = 0; dt < 8; ++dt) { const bf16x8 va = *(const LAS bf16x8*)(vp + 16 * dt * AT_VC_STRIDE); O[dt] = __builtin_amdgcn_mfma_f32_16x16x32_bf16(va, pb, O[dt], 0, 0, 0); }
        }
    }
}
template <bool LOCAL>
__device__ __forceinline__ void attn_item(const Ctx& c, int b, int r, int head, int qt) {
    const int lane = c.lane, n = lane & 15, lg = lane >> 4;
    const int qrow0 = LOCAL ? (b * SEQL + r * 64 + 16 * qt) : (NLAT + b * CTXL + 16 * qt);
    const int r_start = LOCAL ? min(max(r - 4, 0), 56) : 0;
    const int cbase = LOCAL ? (qt == 0 ? 0 : (qt == 1 ? 8 : (qt == 2 ? 24 : 32))) : 0;
    bf16x8 qf[4];
    { const u16* qp = c.PROJ + (size_t)(qrow0 + n) * NMAIN + PJ_Q + head * 128 + 8 * lg;
#pragma unroll
      for (int kk = 0; kk < 4; ++kk) qf[kk] = *(const bf16x8*)(qp + 32 * kk); }
    f32x4 O[8];
#pragma unroll
    for (int dt = 0; dt < 8; ++dt) O[dt] = (f32x4){0.f, 0.f, 0.f, 0.f};
    float mrun = -3.0e38f, lrun = 0.f;
    attn_segment<false>(c, b, r, head, qt, r_start, cbase, qf, O, mrun, lrun);
    if (LOCAL) attn_segment<true>(c, b, r, head, qt, r_start, cbase, qf, O, mrun, lrun);
    const float inv = 1.0f / lrun;
    u16* op = c.ATT + (size_t)(qrow0 + n) * 1024 + head * 128 + 4 * lg;
#pragma unroll
    for (int dt = 0; dt < 8; ++dt) { uint2 o; o.x = pk2(O[dt][0] * inv, O[dt][1] * inv); o.y = pk2(O[dt][2] * inv, O[dt][3] * inv); *(uint2*)(op + 16 * dt) = o; }
}
__device__ __forceinline__ void phase_attention(const Ctx& c, int l, bool last) {
    for (int bh = c.bid; bh < 256; bh += c.G) {
        const int b = bh >> 6, head = (bh >> 3) & 7, sub = bh & 7;
        attn_block_load(c, l, b, head);
#pragma unroll 1
        for (int i = 0; i < 4; ++i) { const int item = c.wave + 8 * i; attn_item<true>(c, b, sub * 8 + (item >> 2), head, item & 3); }
        if (!last && c.wave < 2) attn_item<false>(c, b, 0, head, sub * 2 + c.wave);
    }
    __syncthreads();
}

__device__ __forceinline__ void sgu_item(const Ctx& c, int l, int chunk) {
    const int tid = c.tid, lane = c.lane, n = lane & 15, lg = lane >> 4;
    const int tok0 = chunk < 128 ? chunk * 128 : NLAT + (chunk - 128) * 128;
    LAS float* part = (LAS float*)c.lds;
    LAS float* rstd = part + 32 * 128;
    __syncthreads();
    {
        const int sg = tid & 15, cg = tid >> 4;
        float a[8];
#pragma unroll
        for (int j = 0; j < 8; ++j) a[j] = 0.f;
        for (int cc = 0; cc < 16; ++cc) {
            const u32x4 v = *(const u32x4*)(c.TR + (size_t)(TR_SV + cg * 16 + cc) * MROWS + tok0 + 8 * sg);
            const float x[8] = {bflo(v.x), bfhi(v.x), bflo(v.y), bfhi(v.y), bflo(v.z), bfhi(v.z), bflo(v.w), bfhi(v.w)};
#pragma unroll
            for (int j = 0; j < 8; ++j) { const float g = gelu_f(x[j]); a[j] += g * g; }
        }
#pragma unroll
        for (int j = 0; j < 8; ++j) part[cg * 128 + 8 * sg + j] = a[j];
    }
    __syncthreads();
    if (tid < 128) { float s = 0.f; for (int cg = 0; cg < 32; ++cg) s += part[cg * 128 + tid]; rstd[tid] = rsqrtf(s * (1.0f / 512.0f) + EPSN); }
    __syncthreads();
    const int hs = c.wave >> 1, th = c.wave & 1;
    const u16* wsp = (const u16*)(c.wl(l) + WL_SGUW) + ((size_t)hs * 128) * 128;
    const float* gn = c.in[I_SGUN] + (size_t)l * 512 + hs * 128;
    const float* bsp = c.in[I_SGUB] + (size_t)(l * 4 + hs) * 128;
#pragma unroll 1
    for (int ch = 0; ch < 2; ++ch) {
        f32x4 acc[4][4];
#pragma unroll
        for (int mt = 0; mt < 4; ++mt)
#pragma unroll
            for (int ct = 0; ct < 4; ++ct) acc[mt][ct] = (f32x4){0.f, 0.f, 0.f, 0.f};
#pragma unroll 1
        for (int kk = 0; kk < 4; ++kk) {
            bf16x8 af[4];
#pragma unroll
            for (int mt = 0; mt < 4; ++mt) af[mt] = *(const bf16x8*)(wsp + (size_t)(64 * th + 16 * mt + n) * 128 + 32 * kk + 8 * lg);
            const f32x4 r0 = *(const LAS f32x4*)(rstd + 32 * kk + 8 * lg), r1 = *(const LAS f32x4*)(rstd + 32 * kk + 8 * lg + 4);
#pragma unroll
            for (int ct = 0; ct < 4; ++ct) {
                const int cl = 64 * ch + 16 * ct + n;
                const u32x4 v = *(const u32x4*)(c.TR + (size_t)(TR_SV + hs * 128 + cl) * MROWS + tok0 + 32 * kk + 8 * lg);
                const float gc = gn[cl];
                const float x0 = gelu_f(bflo(v.x)) * r0[0] * gc, x1 = gelu_f(bfhi(v.x)) * r0[1] * gc, x2 = gelu_f(bflo(v.y)) * r0[2] * gc, x3 = gelu_f(bfhi(v.y)) * r0[3] * gc;
                const float x4 = gelu_f(bflo(v.z)) * r1[0] * gc, x5 = gelu_f(bfhi(v.z)) * r1[1] * gc, x6 = gelu_f(bflo(v.w)) * r1[2] * gc, x7 = gelu_f(bfhi(v.w)) * r1[3] * gc;
                u32x4 pw; pw.x = pk2(x0, x1); pw.y = pk2(x2, x3); pw.z = pk2(x4, x5); pw.w = pk2(x6, x7);
                const bf16x8 bfr = __builtin_bit_cast(bf16x8, pw);
#pragma unroll
                for (int mt = 0; mt < 4; ++mt) acc[mt][ct] = __builtin_amdgcn_mfma_f32_16x16x32_bf16(bfr, af[mt], acc[mt][ct], 0, 0, 0);
            }
        }
#pragma unroll
        for (int mt = 0; mt < 4; ++mt) {
            const int t = 64 * th + 16 * mt + n; const float bs = bsp[t];
            const size_t row = (size_t)(tok0 + t);
#pragma unroll
            for (int ct = 0; ct < 4; ++ct) {
                const int col = hs * 128 + 64 * ch + 16 * ct + 4 * lg;
                const u32x2 sw = *(const u32x2*)(c.PROJ + row * NMAIN + PJ_SU + col);
                const f32x4 a = acc[mt][ct];
                *(u32x2*)(c.SGU + row * 512 + col) = (u32x2){pk2(gelu_f(bflo(sw.x)) * (a[0] + bs), gelu_f(bfhi(sw.x)) * (a[1] + bs)), pk2(gelu_f(bflo(sw.y)) * (a[2] + bs), gelu_f(bfhi(sw.y)) * (a[3] + bs))};
            }
        }
    }
}

__device__ __forceinline__ int s5_row(int dir, int b, int q) {
    if (dir == 0) return q < CTXL ? NLAT + b * CTXL + q : b * SEQL + (q - CTXL);
    return q < CTXL ? NLAT + b * CTXL + (CTXL - 1 - q) : b * SEQL + (SEQL - 1 - (q - CTXL));
}
__device__ __forceinline__ void s5_disc(const Ctx& c, int l, int dir, int grp, int p, float& lr, float& li, float (&bbr)[16], float (&bbi)[16]) {
    const size_t gp = ((size_t)(l * 2 + dir) * 32 + grp) * 64 + p;
    const float are = fminf(c.in[I_ARE][gp], -1e-4f), aim = c.in[I_AIM][gp];
    const float dt = expf(c.in[I_LOGDT][(size_t)(l * 2 + dir) * 32 + grp]);
    const float mag = expf(are * dt); float sn, cs; sincosf(aim * dt, &sn, &cs);
    lr = mag * cs; li = mag * sn;
    const float den = 1.0f / (are * are + aim * aim), nr = lr - 1.0f;
    const float cr = (nr * are + li * aim) * den, ci = (li * are - nr * aim) * den;
    const float* br = c.in[I_BRE] + gp * 16; const float* bi = c.in[I_BIM] + gp * 16;
#pragma unroll
    for (int q4 = 0; q4 < 4; ++q4) {
        const float4 a = *(const float4*)(br + 4 * q4), b = *(const float4*)(bi + 4 * q4);
        bbr[4 * q4 + 0] = cr * a.x - ci * b.x; bbi[4 * q4 + 0] = cr * b.x + ci * a.x;
        bbr[4 * q4 + 1] = cr * a.y - ci * b.y; bbi[4 * q4 + 1] = cr * b.y + ci * a.y;
        bbr[4 * q4 + 2] = cr * a.z - ci * b.z; bbi[4 * q4 + 2] = cr * b.z + ci * a.z;
        bbr[4 * q4 + 3] = cr * a.w - ci * b.w; bbi[4 * q4 + 3] = cr * b.w + ci * a.w;
    }
}
__device__ __forceinline__ void s5_load_u(const Ctx& c, LAS float* U, int row, int grp) {
    const u32x4* sp = (const u32x4*)(c.PROJ + (size_t)row * NMAIN + PJ_SIN + 16 * grp);
    const u32x4 a = sp[0], b = sp[1];
    LAS u32x4* up = (LAS u32x4*)(U + c.lane * 8);
    up[0] = a; up[1] = b;
    lds_fence();
}
__device__ __forceinline__ float s5_u(LAS const float* U, int tok, int ch) { const unsigned w = ((const LAS unsigned*)U)[tok * 8 + (ch >> 1)]; return (ch & 1) ? bfhi(w) : bflo(w); }
typedef float f2s __attribute__((ext_vector_type(2)));
typedef __bf16 bf2s __attribute__((ext_vector_type(2)));
__device__ __forceinline__ float dot2s(unsigned a, unsigned b, float c) { return __builtin_amdgcn_fdot2_f32_bf16(__builtin_bit_cast(bf2s, a), __builtin_bit_cast(bf2s, b), c, false); }
__device__ __forceinline__ void s5_drive4(LAS const float* U, int tok0, int dt, const unsigned (&pr)[8], const unsigned (&pi)[8], f2s (&d)[4]) {
    u32x4 u[4][2];
#pragma unroll
    for (int k = 0; k < 4; ++k) { const LAS u32x4* up = (const LAS u32x4*)(U + (tok0 + dt * k) * 8); u[k][0] = up[0]; u[k][1] = up[1]; }
    asm volatile("" ::: "memory");
#pragma unroll
    for (int k = 0; k < 4; ++k) {
        const unsigned w[8] = {u[k][0].x, u[k][0].y, u[k][0].z, u[k][0].w, u[k][1].x, u[k][1].y, u[k][1].z, u[k][1].w};
        float r0 = 0.f, r1 = 0.f, i0 = 0.f, i1 = 0.f;
#pragma unroll
        for (int q = 0; q < 4; ++q) { r0 = dot2s(pr[q], w[q], r0); r1 = dot2s(pr[4 + q], w[4 + q], r1); i0 = dot2s(pi[q], w[q], i0); i1 = dot2s(pi[4 + q], w[4 + q], i1); }
        d[k] = (f2s){r0 + r1, i0 + i1};
    }
}
__device__ __forceinline__ void phase_s5_pass1(const Ctx& c, int l) {
    const int gw = c.bid * 8 + c.wave, nw = c.G * 8;
    LAS float* U = (LAS float*)(c.lds + c.wave * 4096);
    const int nslot = nw >> 6;
    if (nslot < 1 || (gw >> 6) >= nslot) return;
    const int gd = gw & 63, grp = gd >> 1, dir = gd & 1, slot = gw >> 6;
    float lr, li, bbr[16], bbi[16];
    s5_disc(c, l, dir, grp, c.lane, lr, li, bbr, bbi);
    unsigned pr[8], pi[8];
#pragma unroll
    for (int k = 0; k < 8; ++k) { pr[k] = pk2(bbr[2 * k], bbr[2 * k + 1]); pi[k] = pk2(bbi[2 * k], bbi[2 * k + 1]); }
    int i0, i1;
    if (nslot == 32) { if (slot < 17) { i0 = 3 * slot; i1 = i0 + 3; } else { const int f = slot - 17; i0 = 51 + (f < 11 ? 15 * f : 165 + 14 * (f - 11)); i1 = i0 + (f < 11 ? 15 : 14); } }
    else { const int per = (NB * NCHK + nslot - 1) / nslot; i0 = min(slot * per, NB * NCHK); i1 = min(i0 + per, NB * NCHK); }
    if (i0 >= i1) return;
    u32x4 na, nb;
    { const u32x4* sp = (const u32x4*)(c.PROJ + (size_t)s5_row(dir, i0 / NCHK, 64 * (i0 % NCHK) + c.lane) * NMAIN + PJ_SIN + 16 * grp); na = sp[0]; nb = sp[1]; }
#pragma unroll 1
    for (int bn = i0; bn < i1; ++bn) {
        const u32x4 a = na, b = nb;
        { const int bq = min(bn + 1, NB * NCHK - 1);
          const u32x4* sp = (const u32x4*)(c.PROJ + (size_t)s5_row(dir, bq / NCHK, 64 * (bq % NCHK) + c.lane) * NMAIN + PJ_SIN + 16 * grp); na = sp[0]; nb = sp[1]; }
        lds_fence();
        { LAS u32x4* up = (LAS u32x4*)(U + c.lane * 8); up[0] = a; up[1] = b; }
        lds_fence();
        float hr = 0.f, hi = 0.f;
#pragma unroll 1
        for (int j = 0; j < 64; j += 4) {
            f2s d[4]; s5_drive4(U, j, 1, pr, pi, d);
#pragma unroll
            for (int k = 0; k < 4; ++k) { const float nr = lr * hr - li * hi + d[k].x, ni = lr * hi + li * hr + d[k].y; hr = nr; hi = ni; }
        }
        c.SLOC[((size_t)(((bn / NCHK) * 32 + grp) * 2 + dir) * NCHK + (bn % NCHK)) * 64 + c.lane] = (f32x2v){hr, hi};
    }
}
constexpr int S5_HS = 272;
template <int DIR, int HALF>
__device__ __forceinline__ void s5_half(LAS const float* U, LAS unsigned char* Hb, float lr, float li, const unsigned (&pr)[8], const unsigned (&pi)[8], float& hr, float& hi,
                                        const bf16x8 (&cf)[4], f32x4 (&acc)[4], int lane, int n, int lg) {
#pragma unroll 1
    for (int jj = 0; jj < 32; jj += 4) {
        const int j = 32 * HALF + jj, tok0 = DIR ? 63 - j : j;
        f2s d[4]; s5_drive4(U, tok0, DIR ? -1 : 1, pr, pi, d);
#pragma unroll
        for (int k = 0; k < 4; ++k) {
            const float nr = lr * hr - li * hi + d[k].x, ni = lr * hi + li * hr + d[k].y; hr = nr; hi = ni;
            const int tok = DIR ? tok0 - k : tok0 + k;
            *(LAS unsigned*)(Hb + (tok & 31) * S5_HS + 4 * lane) = pk2(hr, hi);
        }
    }
    lds_fence();
    constexpr int MTB = DIR ? (2 - 2 * HALF) : (2 * HALF);
#pragma unroll
    for (int mi = 0; mi < 2; ++mi)
#pragma unroll
        for (int kk = 0; kk < 4; ++kk) {
            const bf16x8 a = *(const LAS bf16x8*)(Hb + (16 * mi + n) * S5_HS + (32 * kk + 8 * lg) * 2);
            acc[MTB + mi] = __builtin_amdgcn_mfma_f32_16x16x32_bf16(a, cf[kk], acc[MTB + mi], 0, 0, 0);
        }
    lds_fence();
}
template <int DIR>
__device__ __forceinline__ void s5_pass3_dir(const Ctx& c, int l, bool last, int grp, int slot, int nslot, LAS float* U, LAS unsigned char* Hb, float* scratch) {
    const int lane = c.lane, n = lane & 15, lg = lane >> 4;
    float lr, li, bbr[16], bbi[16];
    s5_disc(c, l, DIR, grp, lane, lr, li, bbr, bbi);
    unsigned pr[8], pi[8];
#pragma unroll
    for (int k = 0; k < 8; ++k) { pr[k] = pk2(bbr[2 * k], bbr[2 * k + 1]); pi[k] = pk2(bbi[2 * k], bbi[2 * k + 1]); }
    bf16x8 cf[4];
    {
        const size_t cb = (((size_t)(l * 2 + DIR) * 32 + grp) * 16 + n) * 64;
#pragma unroll
        for (int kk = 0; kk < 4; ++kk) {
            const float4 re = *(const float4*)(c.in[I_CRE] + cb + 16 * kk + 4 * lg), im = *(const float4*)(c.in[I_CIM] + cb + 16 * kk + 4 * lg);
            u32x4 pw; pw.x = pk2(re.x, -im.x); pw.y = pk2(re.y, -im.y); pw.z = pk2(re.z, -im.z); pw.w = pk2(re.w, -im.w);
            cf[kk] = __builtin_bit_cast(bf16x8, pw);
        }
    }
    float tr = lr, ti = li;
#pragma unroll
    for (int s = 0; s < 6; ++s) { const float a = tr * tr - ti * ti, bq = 2.0f * tr * ti; tr = a; ti = bq; }
    const float dv = c.in[I_S5D][(size_t)l * 512 + 16 * grp + n];
    const int nitems = last ? NB * 64 : NB * NCHK;
#pragma unroll 1
    for (int idx = slot; idx < nitems; idx += nslot) {
        const int b = last ? (idx >> 6) : idx / NCHK, tc = last ? (idx & 63) : idx % NCHK;
        const int rowbase = tc < 64 ? b * SEQL + 64 * tc : NLAT + b * CTXL + 64 * (tc - 64);
        lds_fence();
        s5_load_u(c, U, rowbase + lane, grp);
        const int nchunk = tc < 64 ? (DIR == 0 ? 4 + tc : 4 + 63 - tc) : (DIR == 0 ? tc - 64 : 3 - (tc - 64));
        float hr = 0.f, hi = 0.f;
        {
            const f32x2v* sp = c.SLOC + ((size_t)((b * 32 + grp) * 2 + DIR) * NCHK) * 64 + lane;
#pragma unroll 1
            for (int m0 = 0; m0 < nchunk; m0 += 8) {
                f32x2v sv[8];
#pragma unroll
                for (int q = 0; q < 8; ++q) sv[q] = sp[(size_t)min(m0 + q, nchunk - 1) * 64];
#pragma unroll
                for (int q = 0; q < 8; ++q) if (m0 + q < nchunk) { const float nr = hr * tr - hi * ti + sv[q].x, ni = hr * ti + hi * tr + sv[q].y; hr = nr; hi = ni; }
            }
        }
        f32x4 acc[4];
#pragma unroll
        for (int i = 0; i < 4; ++i) acc[i] = (f32x4){0.f, 0.f, 0.f, 0.f};
        s5_half<DIR, 0>(U, Hb, lr, li, pr, pi, hr, hi, cf, acc, lane, n, lg);
        s5_half<DIR, 1>(U, Hb, lr, li, pr, pi, hr, hi, cf, acc, lane, n, lg);
        f32x4* sc = (f32x4*)(scratch + ((size_t)(grp * NB * NCHK + idx) * 64 + lane) * 16);
        if (DIR == 0) {
#pragma unroll
            for (int i = 0; i < 4; ++i) sc[i] = acc[i];
        } else {
#pragma unroll
            for (int mt = 0; mt < 4; ++mt) {
                const f32x4 p0 = sc[mt];
#pragma unroll
                for (int rr = 0; rr < 4; ++rr) {
                    const int tok = 16 * mt + 4 * lg + rr;
                    const float y = acc[mt][rr] + p0[rr] + dv * s5_u(U, tok, n);
                    c.S5Y[(size_t)(rowbase + tok) * 512 + 16 * grp + n] = f2bf(gelu_f(y));
                }
            }
        }
    }
}
__device__ __forceinline__ void phase_s5_pass3(const Ctx& c, int l, bool last) {
    const int gw = c.bid * 8 + c.wave, nw = c.G * 8;
    LAS float* U = (LAS float*)(c.lds + c.wave * 4096); LAS unsigned char* Hb = c.lds + 32768 + c.wave * (32 * S5_HS);
    const int nslot = nw >> 5;
    if (nslot < 1 || (gw >> 5) >= nslot) return;
    const int grp = gw & 31, slot = gw >> 5;
    float* scratch = (float*)c.PART;
    s5_pass3_dir<0>(c, l, last, grp, slot, nslot, U, Hb, scratch);
    asm volatile("s_waitcnt vmcnt(0)" ::: "memory");
    s5_pass3_dir<1>(c, l, last, grp, slot, nslot, U, Hb, scratch);
}

__device__ __forceinline__ void phase_merge(const Ctx& c, int l, int nrows) {
    const float* gn = c.in[I_ONORM] + (size_t)l * DM;
    const int lane = c.lane;
    int row = c.bid * 8 + c.wave;
    if (row >= nrows) return;
    u32x4 na0 = *(const u32x4*)(c.ATT + (size_t)row * 1024 + 8 * lane), na1 = *(const u32x4*)(c.ATT + (size_t)row * 1024 + 512 + 8 * lane);
    u32x4 ns0 = *(const u32x4*)(c.SGU + (size_t)row * 512 + 8 * lane), nz0 = *(const u32x4*)(c.S5O + (size_t)row * 512 + 8 * lane);
    f32x4 gv[8];
#pragma unroll
    for (int q = 0; q < 4; ++q) { gv[2 * q] = *(const f32x4*)(gn + 512 * q + 8 * lane); gv[2 * q + 1] = *(const f32x4*)(gn + 512 * q + 8 * lane + 4); }
    for (; row < nrows; row += c.G * 8) {
        const u32x4 a0 = na0, a1 = na1, s0 = ns0, z0 = nz0;
        { const size_t rn = (size_t)min(row + c.G * 8, nrows - 1);
          na0 = *(const u32x4*)(c.ATT + rn * 1024 + 8 * lane); na1 = *(const u32x4*)(c.ATT + rn * 1024 + 512 + 8 * lane);
          ns0 = *(const u32x4*)(c.SGU + rn * 512 + 8 * lane); nz0 = *(const u32x4*)(c.S5O + rn * 512 + 8 * lane); }
        float va[16] = {bflo(a0.x), bfhi(a0.x), bflo(a0.y), bfhi(a0.y), bflo(a0.z), bfhi(a0.z), bflo(a0.w), bfhi(a0.w), bflo(a1.x), bfhi(a1.x), bflo(a1.y), bfhi(a1.y), bflo(a1.z), bfhi(a1.z), bflo(a1.w), bfhi(a1.w)};
        float vs[8] = {bflo(s0.x), bfhi(s0.x), bflo(s0.y), bfhi(s0.y), bflo(s0.z), bfhi(s0.z), bflo(s0.w), bfhi(s0.w)};
        float vz[8] = {bflo(z0.x), bfhi(z0.x), bflo(z0.y), bfhi(z0.y), bflo(z0.z), bfhi(z0.z), bflo(z0.w), bfhi(z0.w)};
        float sa = 0.f, ss = 0.f, sz = 0.f;
#pragma unroll
        for (int j = 0; j < 16; ++j) sa += va[j] * va[j];
#pragma unroll
        for (int j = 0; j < 8; ++j) { ss += vs[j] * vs[j]; sz += vz[j] * vz[j]; }
        sa = wave_sum(sa); ss = wave_sum(ss); sz = wave_sum(sz);
        const float ra = rsqrtf(sa * (1.0f / 1024.0f) + EPSN), rs = rsqrtf(ss * (1.0f / 512.0f) + EPSN), rz = rsqrtf(sz * (1.0f / 512.0f) + EPSN);
        u16* yp = c.YIN + (size_t)row * DM;
        {   const float g[8] = {gv[0][0], gv[0][1], gv[0][2], gv[0][3], gv[1][0], gv[1][1], gv[1][2], gv[1][3]}; u32x4 o;
            o.x = pk2(va[0] * ra * g[0], va[1] * ra * g[1]); o.y = pk2(va[2] * ra * g[2], va[3] * ra * g[3]); o.z = pk2(va[4] * ra * g[4], va[5] * ra * g[5]); o.w = pk2(va[6] * ra * g[6], va[7] * ra * g[7]);
            *(u32x4*)(yp + 8 * lane) = o; }
        {   const float g[8] = {gv[2][0], gv[2][1], gv[2][2], gv[2][3], gv[3][0], gv[3][1], gv[3][2], gv[3][3]}; u32x4 o;
            o.x = pk2(va[8] * ra * g[0], va[9] * ra * g[1]); o.y = pk2(va[10] * ra * g[2], va[11] * ra * g[3]); o.z = pk2(va[12] * ra * g[4], va[13] * ra * g[5]); o.w = pk2(va[14] * ra * g[6], va[15] * ra * g[7]);
            *(u32x4*)(yp + 512 + 8 * lane) = o; }
        {   const float g[8] = {gv[4][0], gv[4][1], gv[4][2], gv[4][3], gv[5][0], gv[5][1], gv[5][2], gv[5][3]}; u32x4 o;
            o.x = pk2(vs[0] * rs * g[0], vs[1] * rs * g[1]); o.y = pk2(vs[2] * rs * g[2], vs[3] * rs * g[3]); o.z = pk2(vs[4] * rs * g[4], vs[5] * rs * g[5]); o.w = pk2(vs[6] * rs * g[6], vs[7] * rs * g[7]);
            *(u32x4*)(yp + 1024 + 8 * lane) = o; }
        {   const float g[8] = {gv[6][0], gv[6][1], gv[6][2], gv[6][3], gv[7][0], gv[7][1], gv[7][2], gv[7][3]}; u32x4 o;
            o.x = pk2(vz[0] * rz * g[0], vz[1] * rz * g[1]); o.y = pk2(vz[2] * rz * g[2], vz[3] * rz * g[3]); o.z = pk2(vz[4] * rz * g[4], vz[5] * rz * g[5]); o.w = pk2(vz[6] * rz * g[6], vz[7] * rz * g[7]);
            *(u32x4*)(yp + 1536 + 8 * lane) = o; }
    }
}

__device__ __forceinline__ unsigned ord_f(float f) { const unsigned u = __float_as_uint(f); return (u & 0x80000000u) ? ~u : (u | 0x80000000u); }
__device__ __forceinline__ float unord_f(unsigned k) { return __uint_as_float((k & 0x80000000u) ? (k ^ 0x80000000u) : ~k); }
#define INS16(r, x_) do { unsigned _x = (x_); _Pragma("unroll") for (int _j = 0; _j < 16; ++_j) { const unsigned _t = max(r[_j], _x); _x = min(r[_j], _x); r[_j] = _t; } } while (0)

#define CE_DESC(a_, b_) do { const unsigned hi_ = max((a_), (b_)), lo_ = min((a_), (b_)); (a_) = hi_; (b_) = lo_; } while (0)
template <int N> __device__ __forceinline__ void bitonic_sort_desc(unsigned (&v)[N]) {
#pragma unroll
    for (int k = 2; k <= N; k <<= 1)
#pragma unroll
        for (int j = k >> 1; j > 0; j >>= 1)
#pragma unroll
            for (int i = 0; i < N; ++i) { const int l = i ^ j; if (l > i) { if ((i & k) == 0) CE_DESC(v[i], v[l]); else CE_DESC(v[l], v[i]); } }
}
__device__ __forceinline__ void merge_top16(unsigned (&a)[16], const unsigned (&b)[16]) {
#pragma unroll
    for (int i = 0; i < 16; ++i) a[i] = max(a[i], b[15 - i]);
#pragma unroll
    for (int j = 8; j > 0; j >>= 1)
#pragma unroll
        for (int i = 0; i < 16; ++i) { const int l = i ^ j; if (l > i) CE_DESC(a[i], a[l]); }
}
__device__ __forceinline__ void top16_of_64(unsigned (&g0)[16], unsigned (&g1)[16], unsigned (&g2)[16], unsigned (&g3)[16]) {
    bitonic_sort_desc<16>(g0); bitonic_sort_desc<16>(g1); bitonic_sort_desc<16>(g2); bitonic_sort_desc<16>(g3);
    merge_top16(g0, g1); merge_top16(g2, g3); merge_top16(g0, g2);
}
constexpr int TKW_STRIDE = 132, TKW_BYTES = 32 * TKW_STRIDE * 4;
static_assert(8 * TKW_BYTES <= LDS_BARW, "topk LDS");

__device__ __forceinline__ void topk_wave_item(const Ctx& c, int l, int tile32, int head) {
    const int lane = c.lane, n = lane & 15, lg = lane >> 4, tk = lane & 31, hf = lane >> 5;
    const int tok0 = tile32 * 32;
    LAS unsigned* SC = (LAS unsigned*)(c.lds + c.wave * TKW_BYTES);
    unsigned top[2][16];
#pragma unroll
    for (int list = 0; list < 2; ++list) {
        bf16x8 af[2][4];
#pragma unroll
        for (int mt = 0; mt < 2; ++mt)
#pragma unroll
            for (int kk = 0; kk < 4; ++kk) af[mt][kk] = *(const bf16x8*)(c.PQ + (size_t)(tok0 + 16 * mt + n) * DM + head * 256 + list * 128 + 32 * kk + 8 * lg);
        const u16* kb = (const u16*)(c.wl(l) + WL_K12) + ((size_t)(list * 8 + head) * 128) * 128;
        lds_fence();
        bf16x8 bk[4];
#pragma unroll
        for (int kk = 0; kk < 4; ++kk) bk[kk] = *(const bf16x8*)(kb + (size_t)n * 128 + 32 * kk + 8 * lg);
#pragma unroll
        for (int nt = 0; nt < 8; ++nt) {
            bf16x8 bn[4];
            if (nt < 7) {
#pragma unroll
                for (int kk = 0; kk < 4; ++kk) bn[kk] = *(const bf16x8*)(kb + (size_t)(16 * (nt + 1) + n) * 128 + 32 * kk + 8 * lg);
            }
            __builtin_amdgcn_sched_barrier(0);
#pragma unroll
            for (int mt = 0; mt < 2; ++mt) {
                f32x4 acc = {0.f, 0.f, 0.f, 0.f};
#pragma unroll
                for (int kk = 0; kk < 4; ++kk) acc = __builtin_amdgcn_mfma_f32_16x16x32_bf16(af[mt][kk], bk[kk], acc, 0, 0, 0);
                const unsigned ki = (unsigned)(16 * nt + n);
#pragma unroll
                for (int rr = 0; rr < 4; ++rr) SC[(16 * mt + 4 * lg + rr) * TKW_STRIDE + ki] = (ord_f(acc[rr]) & ~0x7Fu) | (127u - ki);
            }
            __builtin_amdgcn_sched_barrier(0);
            if (nt < 7) {
#pragma unroll
                for (int kk = 0; kk < 4; ++kk) bk[kk] = bn[kk];
            }
        }
        lds_fence();
        unsigned r[16], g1[16], g2[16], g3[16];
        const LAS u32x4* sp = (const LAS u32x4*)(SC + tk * TKW_STRIDE + 64 * hf);
#pragma unroll
        for (int i = 0; i < 4; ++i) { const u32x4 a = sp[i], b = sp[4 + i], c2 = sp[8 + i], d = sp[12 + i];
            r[4 * i] = a.x; r[4 * i + 1] = a.y; r[4 * i + 2] = a.z; r[4 * i + 3] = a.w; g1[4 * i] = b.x; g1[4 * i + 1] = b.y; g1[4 * i + 2] = b.z; g1[4 * i + 3] = b.w;
            g2[4 * i] = c2.x; g2[4 * i + 1] = c2.y; g2[4 * i + 2] = c2.z; g2[4 * i + 3] = c2.w; g3[4 * i] = d.x; g3[4 * i + 1] = d.y; g3[4 * i + 2] = d.z; g3[4 * i + 3] = d.w; }
        top16_of_64(r, g1, g2, g3);
        unsigned o[16];
#pragma unroll
        for (int j = 0; j < 16; ++j) o[j] = (unsigned)__shfl_xor((int)r[j], 32);
        merge_top16(r, o);
#pragma unroll
        for (int j = 0; j < 16; ++j) top[list][j] = r[j];
    }
    float v1[16], v2[16];
#pragma unroll
    for (int j = 0; j < 16; ++j) { v1[j] = unord_f(top[0][j] & ~0x7Fu); v2[j] = unord_f(top[1][j] & ~0x7Fu); }
    unsigned r[16], q1[16], q2[16], q3[16];
    {
        unsigned cand[64]; int nc = 0;
#pragma unroll
        for (int a = 0; a < 16; ++a)
#pragma unroll
            for (int b = 0; b < 16; ++b)
                if ((a + 1) * (b + 1) <= 16) { cand[nc] = (ord_f(v1[a] + v2[b]) & ~0xFFu) | (unsigned)(255 - (a * 16 + b)); ++nc; }
#pragma unroll
        for (int i = 50; i < 64; ++i) cand[i] = 0u;
#pragma unroll
        for (int i = 0; i < 16; ++i) { r[i] = cand[i]; q1[i] = cand[16 + i]; q2[i] = cand[32 + i]; q3[i] = cand[48 + i]; }
    }
    top16_of_64(r, q1, q2, q3);
    if (hf == 0) {
#pragma unroll
        for (int j = 0; j < 16; ++j) { SC[tk * TKW_STRIDE + j] = top[0][j]; SC[tk * TKW_STRIDE + 16 + j] = top[1][j]; }
    }
    lds_fence();
    float s[16], sum = 0.f;
    const float mx = unord_f(r[0] & ~0xFFu);
#pragma unroll
    for (int k = 0; k < 16; ++k) { s[k] = __expf(unord_f(r[k] & ~0xFFu) - mx); sum += s[k]; }
    const float inv = 1.0f / sum;
    unsigned ev[16];
#pragma unroll
    for (int k = 0; k < 16; ++k) {
        const int flat = 255 - (int)(r[k] & 0xFFu), a = flat >> 4, b = flat & 15;
        const int i1 = 127 - (int)(SC[tk * TKW_STRIDE + a] & 0x7Fu), i2 = 127 - (int)(SC[tk * TKW_STRIDE + 16 + b] & 0x7Fu);
        ev[k] = (unsigned)(i1 * 128 + i2);
    }
    if (hf == 0) {
        const size_t o = (size_t)(tok0 + tk) * 128 + head * 16;
        u32x4* ep = (u32x4*)(c.ET + o);
        ep[0] = (u32x4){ev[0] | (ev[1] << 16), ev[2] | (ev[3] << 16), ev[4] | (ev[5] << 16), ev[6] | (ev[7] << 16)};
        ep[1] = (u32x4){ev[8] | (ev[9] << 16), ev[10] | (ev[11] << 16), ev[12] | (ev[13] << 16), ev[14] | (ev[15] << 16)};
        f32x4* gp = (f32x4*)(c.GT + o);
        gp[0] = (f32x4){s[0] * inv, s[1] * inv, s[2] * inv, s[3] * inv}; gp[1] = (f32x4){s[4] * inv, s[5] * inv, s[6] * inv, s[7] * inv};
        gp[2] = (f32x4){s[8] * inv, s[9] * inv, s[10] * inv, s[11] * inv}; gp[3] = (f32x4){s[12] * inv, s[13] * inv, s[14] * inv, s[15] * inv};
    }
    lds_fence();
}

#define CFENCE() asm volatile("" ::: "memory")
typedef float f2 __attribute__((ext_vector_type(2)));
__device__ __forceinline__ float dpp_xor1(float v) { return __builtin_bit_cast(float, __builtin_amdgcn_update_dpp(0, __builtin_bit_cast(int, v), 0xB1, 0xF, 0xF, true)); }
__device__ __forceinline__ float dpp_xor2(float v) { return __builtin_bit_cast(float, __builtin_amdgcn_update_dpp(0, __builtin_bit_cast(int, v), 0x4E, 0xF, 0xF, true)); }

typedef __bf16 bf2v __attribute__((ext_vector_type(2)));
#define FP4_DOT(a_, w_, h_, o_) do { a_ += (h_)[(o_) + 0] * __builtin_amdgcn_cvt_scalef32_pk_f32_fp4((w_), 1.0f, 0); a_ += (h_)[(o_) + 1] * __builtin_amdgcn_cvt_scalef32_pk_f32_fp4((w_), 1.0f, 1); \
    a_ += (h_)[(o_) + 2] * __builtin_amdgcn_cvt_scalef32_pk_f32_fp4((w_), 1.0f, 2); a_ += (h_)[(o_) + 3] * __builtin_amdgcn_cvt_scalef32_pk_f32_fp4((w_), 1.0f, 3); } while (0)
#define PEER_E(ew_, i_) (((i_) & 1) ? ((ew_)[(i_) >> 1] >> 16) : ((ew_)[(i_) >> 1] & 0xFFFFu))

#define I4_DOT(a_, w_, h_, o_) do { a_ = __builtin_amdgcn_sdot4((int)((w_) & 0x0F0F0F0Fu), (int)(h_)[(o_)], a_, false); a_ = __builtin_amdgcn_sdot4((int)(((w_) >> 4) & 0x0F0F0F0Fu), (int)(h_)[(o_) + 1], a_, false); } while (0)
__device__ __forceinline__ void phase_peer_u(const Ctx& c, int l, int nrows) {
    const int lane = c.lane, g = lane >> 3, j = lane & 7;
    const int tstep = c.xn * 8;
    for (int s = c.xi; s < PEER_NSL; s += c.nx) {
        const unsigned char* ub = c.wl(l) + WL_U + PEER_SLB * s + 16 * j;
        const unsigned char* hs = c.H8 + 256 * s + 32 * j;
        u16* part = c.PART + (size_t)s * PAIRS_MAX;
        int t = c.xr * 8 + c.wave;
        if (t >= nrows) continue;
        u32x4 ea, eb, segN[16], hN[2]; float scN;
        { const u32x4* ep = (const u32x4*)(c.ET + (size_t)t * 128 + 16 * g); ea = ep[0]; eb = ep[1]; }
        { const unsigned ew[8] = {ea.x, ea.y, ea.z, ea.w, eb.x, eb.y, eb.z, eb.w};
#pragma unroll
          for (int i = 0; i < 16; ++i) segN[i] = *(const u32x4*)(ub + (size_t)PEER_E(ew, i) * PEER_ROWB);
          const u32x4* hp = (const u32x4*)(hs + (size_t)t * DM); hN[0] = hp[0]; hN[1] = hp[1]; scN = c.HSC[t]; }
        { const u32x4* ep = (const u32x4*)(c.ET + (size_t)min(t + tstep, nrows - 1) * 128 + 16 * g); ea = ep[0]; eb = ep[1]; }
#pragma unroll 1
        for (; t < nrows; t += tstep) {
            u32x4 seg[16];
#pragma unroll
            for (int i = 0; i < 16; ++i) seg[i] = segN[i];
            const unsigned hv[8] = {hN[0].x, hN[0].y, hN[0].z, hN[0].w, hN[1].x, hN[1].y, hN[1].z, hN[1].w};
            const float hsc = scN;
            {
                const int tn = min(t + tstep, nrows - 1);
                const unsigned ew[8] = {ea.x, ea.y, ea.z, ea.w, eb.x, eb.y, eb.z, eb.w};
#pragma unroll
                for (int i = 0; i < 16; ++i) segN[i] = *(const u32x4*)(ub + (size_t)PEER_E(ew, i) * PEER_ROWB);
                const u32x4* hp = (const u32x4*)(hs + (size_t)tn * DM); hN[0] = hp[0]; hN[1] = hp[1]; scN = c.HSC[tn];
                const u32x4* ep = (const u32x4*)(c.ET + (size_t)min(t + 2 * tstep, nrows - 1) * 128 + 16 * g); ea = ep[0]; eb = ep[1];
            }
            int hsum = 0;
#pragma unroll
            for (int q = 0; q < 8; ++q) hsum = __builtin_amdgcn_sdot4((int)hv[q], 0x01010101, hsum, false);
            const float fs = hsc;
            float acc[16];
#pragma unroll
            for (int i = 0; i < 16; ++i) {
                int a = 0, b = 0;
                I4_DOT(a, seg[i].x, hv, 0); I4_DOT(b, seg[i].y, hv, 2); I4_DOT(a, seg[i].z, hv, 4); I4_DOT(b, seg[i].w, hv, 6);
                acc[i] = (float)(a + b - 8 * hsum) * fs;
            }
            float r8[8], r4[4], r2[2];
            { const bool hi = (j & 4) != 0;
#pragma unroll
              for (int m = 0; m < 8; ++m) { const float keep = hi ? acc[8 + m] : acc[m], send = hi ? acc[m] : acc[8 + m]; r8[m] = keep + __shfl_xor(send, 4); } }
            { const bool hi = (j & 2) != 0;
#pragma unroll
              for (int m = 0; m < 4; ++m) { const float keep = hi ? r8[4 + m] : r8[m], send = hi ? r8[m] : r8[4 + m]; r4[m] = keep + dpp_xor2(send); } }
            { const bool hi = (j & 1) != 0;
#pragma unroll
              for (int m = 0; m < 2; ++m) { const float keep = hi ? r4[2 + m] : r4[m], send = hi ? r4[m] : r4[2 + m]; r2[m] = keep + dpp_xor1(send); } }
            *(unsigned*)(part + (size_t)t * 128 + 2 * lane) = pk2(r2[0], r2[1]);
        }
    }
}

__device__ __forceinline__ void phase_peer_reduce(const Ctx& c, int nrows) {
    const size_t n8 = (size_t)nrows * 128 / 8;
    for (size_t i = (size_t)c.bid * 512 + c.tid; i < n8; i += (size_t)c.G * 512) {
        float s[8];
#pragma unroll
        for (int q = 0; q < 8; ++q) s[q] = 0.f;
#pragma unroll
        for (int sl = 0; sl < PEER_NSL; ++sl) {
            const u32x4 v = *(const u32x4*)(c.PART + (size_t)sl * PAIRS_MAX + 8 * i);
            s[0] += bflo(v.x); s[1] += bfhi(v.x); s[2] += bflo(v.y); s[3] += bfhi(v.y); s[4] += bflo(v.z); s[5] += bfhi(v.z); s[6] += bflo(v.w); s[7] += bfhi(v.w);
        }
        const f32x4 g0 = *(const f32x4*)(c.GT + 8 * i), g1 = *(const f32x4*)(c.GT + 8 * i + 4);
        const float is = 1.0f / USCALE;
        u32x4 o;
        o.x = pk2(g0[0] * gelu_f(s[0] * is), g0[1] * gelu_f(s[1] * is)); o.y = pk2(g0[2] * gelu_f(s[2] * is), g0[3] * gelu_f(s[3] * is));
        o.z = pk2(g1[0] * gelu_f(s[4] * is), g1[1] * gelu_f(s[5] * is)); o.w = pk2(g1[2] * gelu_f(s[6] * is), g1[3] * gelu_f(s[7] * is));
        *(u32x4*)(c.WT + 8 * i) = o;
    }
}

#define FP4_AXPY(o_, w2_, w_, b_) do { (o_)[(b_) + 0] += (w2_) * __builtin_amdgcn_cvt_scalef32_pk_f32_fp4((w_), 1.0f, 0); (o_)[(b_) + 1] += (w2_) * __builtin_amdgcn_cvt_scalef32_pk_f32_fp4((w_), 1.0f, 1); \
    (o_)[(b_) + 2] += (w2_) * __builtin_amdgcn_cvt_scalef32_pk_f32_fp4((w_), 1.0f, 2); (o_)[(b_) + 3] += (w2_) * __builtin_amdgcn_cvt_scalef32_pk_f32_fp4((w_), 1.0f, 3); } while (0)
__device__ __forceinline__ f2 shfl2(f2 v, int m) { return (f2){__shfl_xor(v.x, m), __shfl_xor(v.y, m)}; }
__device__ __forceinline__ void phase_peer_v(const Ctx& c, int l, int nrows, u16* xdst) {
    const int lane = c.lane, g = lane >> 3, j = lane & 7;
    const int tstep = c.xn * 8;
    for (int s = c.xi; s < PEER_NSL; s += c.nx) {
        const unsigned char* vb = c.wl(l) + WL_V + PEER_SLB * s + 16 * j;
        int t = c.xr * 8 + c.wave;
        if (t >= nrows) continue;
        u32x4 ea, eb, segN[16], wN[2];
        { const u32x4* ep = (const u32x4*)(c.ET + (size_t)t * 128 + 16 * g); ea = ep[0]; eb = ep[1]; }
        { const unsigned ew[8] = {ea.x, ea.y, ea.z, ea.w, eb.x, eb.y, eb.z, eb.w};
#pragma unroll
          for (int i = 0; i < 16; ++i) segN[i] = *(const u32x4*)(vb + (size_t)PEER_E(ew, i) * PEER_ROWB);
          const u32x4* wp = (const u32x4*)(c.WT + (size_t)t * 128 + 16 * g); wN[0] = wp[0]; wN[1] = wp[1]; }
        { const u32x4* ep = (const u32x4*)(c.ET + (size_t)min(t + tstep, nrows - 1) * 128 + 16 * g); ea = ep[0]; eb = ep[1]; }
#pragma unroll 1
        for (; t < nrows; t += tstep) {
            u32x4 seg[16];
#pragma unroll
            for (int i = 0; i < 16; ++i) seg[i] = segN[i];
            const unsigned ww[8] = {wN[0].x, wN[0].y, wN[0].z, wN[0].w, wN[1].x, wN[1].y, wN[1].z, wN[1].w};
            const int col = 256 * s + 32 * j + 4 * g;
            const f32x4 q = *(const f32x4*)(c.MOD + ((size_t)(l * 5 + row_bidx(t)) * 6 + 5) * DM + col); const u32x2 xw = *(const u32x2*)(c.X + (size_t)t * DM + col);
            {
                const int tn = min(t + tstep, nrows - 1);
                const unsigned ew[8] = {ea.x, ea.y, ea.z, ea.w, eb.x, eb.y, eb.z, eb.w};
#pragma unroll
                for (int i = 0; i < 16; ++i) segN[i] = *(const u32x4*)(vb + (size_t)PEER_E(ew, i) * PEER_ROWB);
                const u32x4* wp = (const u32x4*)(c.WT + (size_t)tn * 128 + 16 * g); wN[0] = wp[0]; wN[1] = wp[1];
                const u32x4* ep = (const u32x4*)(c.ET + (size_t)min(t + 2 * tstep, nrows - 1) * 128 + 16 * g); ea = ep[0]; eb = ep[1];
            }
            f2 o[16];
#pragma unroll
            for (int q = 0; q < 16; ++q) o[q] = (f2){0.f, 0.f};
#pragma unroll
            for (int i = 0; i < 16; ++i) {
                const float w = (i & 1) ? bfhi(ww[i >> 1]) : bflo(ww[i >> 1]);
                const f2 w2 = {w, w};
                FP4_AXPY(o, w2, seg[i].x, 0); FP4_AXPY(o, w2, seg[i].y, 4); FP4_AXPY(o, w2, seg[i].z, 8); FP4_AXPY(o, w2, seg[i].w, 12);
            }
            f2 r8[8], r4[4], r2[2];
#pragma unroll
            for (int m = 0; m < 8; ++m) {
                const u32x2 sx = __builtin_amdgcn_permlane32_swap(__float_as_uint(o[m].x), __float_as_uint(o[8 + m].x), false, false);
                const u32x2 sy = __builtin_amdgcn_permlane32_swap(__float_as_uint(o[m].y), __float_as_uint(o[8 + m].y), false, false);
                r8[m] = (f2){__uint_as_float(sx.x) + __uint_as_float(sx.y), __uint_as_float(sy.x) + __uint_as_float(sy.y)};
            }
#pragma unroll
            for (int m = 0; m < 4; ++m) {
                const u32x2 sx = __builtin_amdgcn_permlane16_swap(__float_as_uint(r8[m].x), __float_as_uint(r8[4 + m].x), false, false);
                const u32x2 sy = __builtin_amdgcn_permlane16_swap(__float_as_uint(r8[m].y), __float_as_uint(r8[4 + m].y), false, false);
                r4[m] = (f2){__uint_as_float(sx.x) + __uint_as_float(sx.y), __uint_as_float(sy.x) + __uint_as_float(sy.y)};
            }
            { const bool hi = (g & 1) != 0;
#pragma unroll
              for (int m = 0; m < 2; ++m) { const f2 keep = hi ? r4[2 + m] : r4[m], send = hi ? r4[m] : r4[2 + m];
                  r2[m] = keep + shfl2(send, 8); } }
            const float is = 1.0f / VSCALE;
            *(u32x2*)(xdst + (size_t)t * DM + col) = (u32x2){pk2(bflo(xw.x) + q[0] * r2[0].x * is, bfhi(xw.x) + q[1] * r2[0].y * is), pk2(bflo(xw.y) + q[2] * r2[1].x * is, bfhi(xw.y) + q[3] * r2[1].y * is)};
        }
    }
}

__device__ __forceinline__ void phase_final(const Ctx& c) {
    const float* gain = c.in[I_FNORM];
    int row = c.bid * 8 + c.wave;
    if (row >= NLAT) return;
    float4 g[8];
#pragma unroll
    for (int i = 0; i < 8; ++i) g[i] = *(const float4*)(gain + 4 * (c.lane + 64 * i));
    u32x2 xn[8];
    { const u32x2* xp = (const u32x2*)(c.X + (size_t)row * DM);
#pragma unroll
      for (int i = 0; i < 8; ++i) xn[i] = xp[c.lane + 64 * i]; }
    for (; row < NLAT; row += c.G * 8) {
        float4 v[8]; float ss = 0.f;
#pragma unroll
        for (int i = 0; i < 8; ++i) { const u32x2 xw = xn[i]; v[i] = make_float4(bflo(xw.x), bfhi(xw.x), bflo(xw.y), bfhi(xw.y)); ss += v[i].x * v[i].x + v[i].y * v[i].y + v[i].z * v[i].z + v[i].w * v[i].w; }
        { const u32x2* xp = (const u32x2*)(c.X + (size_t)min(row + c.G * 8, NLAT - 1) * DM);
#pragma unroll
          for (int i = 0; i < 8; ++i) xn[i] = xp[c.lane + 64 * i]; }
        ss = wave_sum(ss);
        const float rstd = rsqrtf(ss * (1.0f / DM) + EPSN);
        float4* op = (float4*)(c.out + (size_t)row * DM);
#pragma unroll
        for (int i = 0; i < 8; ++i)
            op[c.lane + 64 * i] = make_float4(v[i].x * rstd * g[i].x, v[i].y * rstd * g[i].y, v[i].z * rstd * g[i].z, v[i].w * rstd * g[i].w);
    }
}

constexpr int PH_PRO = 0, PH_MODFIN = 1, PH_NORM0 = 2, PH_L0 = 3, PH_PER_LAYER = 13, N_PHASES = PH_L0 + DEPTH * PH_PER_LAYER;

__global__ void __launch_bounds__(512, 2) fwd_kernel(Args args) {
    extern __shared__ __attribute__((aligned(16))) unsigned char lds_raw[];
    Ctx c;
#pragma unroll
    for (int i = 0; i < N_IN; ++i) c.in[i] = args.in[i];
    c.out = args.out; c.ws = args.ws; c.lds = (LAS unsigned char*)lds_raw;
    c.tid = threadIdx.x; c.lane = c.tid & 63; c.wave = __builtin_amdgcn_readfirstlane(c.tid >> 6); c.G = gridDim.x; c.bid = blockIdx.x;
    unsigned char* ws = args.ws;
    c.MOD = (float*)(ws + WS_MOD); c.MODP = (float*)(ws + WS_MODP); c.X = (u16*)(ws + WS_X); c.H = (u16*)(ws + WS_H); c.PROJ = (u16*)(ws + WS_PROJ); c.TR = (u16*)(ws + WS_TR);
    c.ATT = (u16*)(ws + WS_ATT); c.SGU = (u16*)(ws + WS_SGU); c.S5Y = (u16*)(ws + WS_S5Y); c.S5O = (u16*)(ws + WS_S5O); c.YIN = (u16*)(ws + WS_YIN); c.PQ = (u16*)(ws + WS_PQ);
    c.ET = (u16*)(ws + WS_ET); c.GT = (float*)(ws + WS_GT); c.PART = (u16*)(ws + WS_PART); c.WT = (u16*)(ws + WS_WT); c.H8 = ws + WS_H8; c.HSC = (float*)(ws + WS_HSC);
    c.xi = c.bid % 8; c.nx = 8; c.xr = c.bid / 8; c.xn = (c.G + 7) / 8; c.SLOC = (f32x2v*)(ws + WS_SLOC);

    const int lo = args.ph_lo, hi = args.ph_hi;
    XcdBarrier bar; bar.bar = (unsigned*)(ws + WS_BAR); bar.x = 0; bar.st = (volatile LAS unsigned*)(c.lds + LDS_BARW);
    if (hi - lo > 1) {
        if (c.tid == 0) { bar.st[0] = 0u; bar.st[1] = 0u; }
        __syncthreads();
        bar = xcd_barrier_post((unsigned*)(ws + WS_BAR), (volatile LAS unsigned*)(c.lds + LDS_BARW));
    }
#ifndef PHASE_MASK
#define PHASE_MASK 0xFFFFFF
#endif
#define EN(i) ((PHASE_MASK >> (i)) & 1)
#ifndef PROBE_MASK
#define PROBE_MASK 0
#endif
#define NREP(i) (((PROBE_MASK >> (i)) & 1) ? 2 : 1)
#ifndef USE_CENSUS
#define USE_CENSUS 1
#endif
#define IN_PH(k) (lo <= (k) && (k) < hi)
#define SEAM(k) do { if (IN_PH((k) + 1)) { xcd_barrier(bar); if (NREP(22) == 2) xcd_barrier(bar); } } while (0)

    if (EN(0) && IN_PH(PH_PRO)) { for (int rep = 0; rep < NREP(0); ++rep) phase_prologue(c); SEAM(PH_PRO); }
    if (USE_CENSUS && hi - lo > 1 && lo == 0) {
        volatile LAS unsigned* st = (volatile LAS unsigned*)(c.lds + LDS_BARW);
        if (c.tid == 0) {
            unsigned below = 0, pop = 0, mine = 1;
#pragma unroll
            for (unsigned jx = 0; jx < 16; ++jx) { const unsigned cn = xb_ld((unsigned*)(ws + WS_BAR) + XB_XCNT(jx)); pop += cn ? 1u : 0u; below += (cn && jx < bar.x) ? 1u : 0u; mine = (jx == bar.x) ? cn : mine; }
            st[4] = below; st[5] = pop ? pop : 1u; st[6] = mine ? mine : 1u;
        }
        __syncthreads();
        c.xi = (int)st[4]; c.nx = (int)st[5]; c.xn = (int)st[6]; c.xr = (int)st[2];
        if (c.xr >= c.xn) c.xr = c.xn - 1;
    }
    if (EN(1) && IN_PH(PH_MODFIN)) { phase_modfin(c); SEAM(PH_MODFIN); }
    if (EN(2) && IN_PH(PH_NORM0)) { phase_normmod(c, 0, 0, MROWS); SEAM(PH_NORM0); }

#pragma unroll 1
    for (int l = 0; l < DEPTH; ++l) {
        const int base = PH_L0 + l * PH_PER_LAYER;
        const bool last = (l == DEPTH - 1);
        const int mrows = last ? NLAT : MROWS;
        unsigned char* W = c.wl(l);
        if (EN(3) && IN_PH(base + 0)) { c.fresh();
            for (int rep = 0; rep < NREP(3); ++rep) {
            { pg8::Gemm g{c.H, (const u16*)(W + WL_MAIN), MROWS, NMAIN, DM, (const u16*)(W + WL_TR), c.H}; pg8::DualOrder S; S.init(MROWS, NMAIN, NTR, MROWS, c.G, c.bid);
              EpiProj E{c.PROJ, c.TR};
              pg8::gemm_phase<EpiProj, pg8::DualOrder>(c.lds, g, S, E, nullptr); }
            }
            SEAM(base + 0);
        }
        if (EN(4) && IN_PH(base + 1)) { c.fresh();
            const int gw = c.bid * 8 + c.wave, nw = c.G * 8;
            for (int rep = 0; rep < NREP(13); ++rep) if (EN(13)) phase_attention(c, l, last);
            for (int rep = 0; rep < NREP(15); ++rep)
            if (EN(15)) for (int it = c.bid; it < (last ? 128 : 136); it += c.G) sgu_item(c, l, it);
            __syncthreads();
            for (int rep = 0; rep < NREP(16); ++rep)
            if (EN(16)) phase_s5_pass1(c, l);
            SEAM(base + 1);
        }
        if (EN(5) && IN_PH(base + 2)) { c.fresh();
            for (int rep = 0; rep < NREP(5); ++rep) phase_s5_pass3(c, l, last);
            SEAM(base + 2);
        }
        if (EN(6) && IN_PH(base + 3)) { c.fresh();
            for (int rep = 0; rep < NREP(6); ++rep) {
            pg8::Gemm g{c.S5Y, (const u16*)(W + WL_GLU), mrows, 512, 512, nullptr, nullptr}; pg8::StaticOrder S; S.init(mrows, 512, c.G, c.bid);
            EpiGlu E{c.S5Y, c.S5O, c.in[I_GLUB] + (size_t)l * 512};
            pg8::gemm_phase<EpiGlu, pg8::StaticOrder>(c.lds, g, S, E, nullptr);
            }
            if (!last && c.G == 256) peer_convert_u(c, l + 1, (MROWS / 256) * 2, c.G - (MROWS / 256) * 2);
            SEAM(base + 3);
        }
        if (EN(7) && IN_PH(base + 4)) { c.fresh(); for (int rep = 0; rep < NREP(7); ++rep) phase_merge(c, l, mrows); SEAM(base + 4); }
        constexpr int NCU = 32;
        const bool split = !last && c.G > 2 * NCU;
        if (EN(8) && IN_PH(base + 5)) { c.fresh();
            const int m5 = split ? NLAT : mrows;
            pg8::Gemm g{c.YIN, (const u16*)(W + WL_OUT), m5, DM, DM, nullptr, nullptr}; pg8::StaticOrder S; S.init(m5, DM, c.G, c.bid);
            EpiResid E{c.X, c.MOD + (size_t)l * 5 * 6 * DM, 0};
            pg8::gemm_phase<EpiResid, pg8::StaticOrder>(c.lds, g, S, E, nullptr);
            SEAM(base + 5);
        }
        if (EN(9) && IN_PH(base + 6)) { c.fresh();
            if (!split) phase_normmod(c, l, 1, mrows);
            else if (c.bid < NCU) {
                pg8::Gemm g{c.YIN + (size_t)NLAT * DM, (const u16*)(W + WL_OUT), NCTX, DM, DM, nullptr, nullptr}; pg8::StaticOrder S; S.init(NCTX, DM, NCU, c.bid);
                EpiResid E{c.X + (size_t)NLAT * DM, c.MOD + (size_t)l * 5 * 6 * DM, NLAT};
                pg8::gemm_phase<EpiResid, pg8::StaticOrder>(c.lds, g, S, E, nullptr);
            } else phase_normmod(c, l, 1, NLAT, 0, NCU, c.G - NCU);
            SEAM(base + 6);
        }
        if (EN(10) && IN_PH(base + 7)) { c.fresh();
            const int m7 = split ? NLAT : mrows;
            pg8::Gemm g{c.H, (const u16*)(W + WL_Q), m7, DM, DM, nullptr, nullptr}; pg8::StaticOrder S; S.init(m7, DM, c.G, c.bid);
            pg8::EpiBf16<0> E{c.PQ, DM, nullptr, 0, 0};
            pg8::gemm_phase<pg8::EpiBf16<0>, pg8::StaticOrder>(c.lds, g, S, E, nullptr);
            if (split) phase_normmod(c, l, 1, NCTX, NLAT);
            SEAM(base + 7);
        }
        if (EN(11) && IN_PH(base + 8)) { c.fresh();
            if (!split) { for (int it = c.bid * 8 + c.wave; it < (mrows / 32) * 8; it += c.G * 8) topk_wave_item(c, l, it >> 3, it & 7); }
            else if (c.bid < NCU) {
                pg8::Gemm g{c.H + (size_t)NLAT * DM, (const u16*)(W + WL_Q), NCTX, DM, DM, nullptr, nullptr}; pg8::StaticOrder S; S.init(NCTX, DM, NCU, c.bid);
                pg8::EpiBf16<0> E{c.PQ + (size_t)NLAT * DM, DM, nullptr, 0, 0};
                pg8::gemm_phase<pg8::EpiBf16<0>, pg8::StaticOrder>(c.lds, g, S, E, nullptr);
                pg8::Unit u; S.next(0, u);
                asm volatile("s_waitcnt vmcnt(0)" ::: "memory"); __syncthreads();
                topk_wave_item(c, l, (NLAT + 256 * u.pm) / 32 + c.wave, u.pn);
            } else { for (int it = (c.bid - NCU) * 8 + c.wave; it < (NLAT / 32) * 8; it += (c.G - NCU) * 8) topk_wave_item(c, l, it >> 3, it & 7);
                if (c.G == 256) peer_convert_v(c, l + 1, 96, c.G - 96); }
            SEAM(base + 8);
        }
        if (EN(12) && IN_PH(base + 9)) { c.fresh(); for (int rep = 0; rep < NREP(17); ++rep) phase_peer_u(c, l, mrows); SEAM(base + 9); }
        if (EN(12) && IN_PH(base + 10)) { c.fresh(); for (int rep = 0; rep < NREP(18); ++rep) phase_peer_reduce(c, mrows); SEAM(base + 10); }
        if (EN(12) && IN_PH(base + 11)) { c.fresh(); phase_peer_v(c, l, mrows, c.X); SEAM(base + 11); }
        if (EN(12) && IN_PH(base + 12)) { c.fresh();
            for (int rep = 0; rep < NREP(20); ++rep)
            if (!last) phase_normmod(c, l + 1, 0, MROWS); else phase_final(c);
            SEAM(base + 12);
        }
    }
}

#ifndef N_LAUNCH_MODE
#define N_LAUNCH_MODE 1
#endif
extern "C" void kernel_launch(void* const* d_in, const int* in_sizes, int n_in, void* d_out, int out_size, void* d_ws, size_t ws_size, hipStream_t stream) {
    static int grid = 0;
    if (grid == 0) {
        if (n_in != N_IN || ws_size < WS_END) { fprintf(stderr, "kernel_launch: unexpected n_in %d or ws %zu < %zu\n", n_in, ws_size, (size_t)WS_END); grid = -1; return; }
        int dev = 0, cus = 0, per_cu = 0;
        hipGetDevice(&dev); hipDeviceGetAttribute(&cus, hipDeviceAttributeMultiprocessorCount, dev);
        if (hipFuncSetAttribute((const void*)fwd_kernel, hipFuncAttributeMaxDynamicSharedMemorySize, LDS_BYTES) != hipSuccess) { fprintf(stderr, "kernel_launch: hipFuncSetAttribute failed\n"); grid = -1; return; }
        if (hipOccupancyMaxActiveBlocksPerMultiprocessor(&per_cu, (const void*)fwd_kernel, 512, LDS_BYTES) != hipSuccess || per_cu < 1) fprintf(stderr, "kernel_launch: occupancy query says %d\n", per_cu);
        (void)hipGetLastError();
        grid = cus > 0 ? cus : 256;
    }
    if (grid < 0) return;
    hipMemsetAsync((char*)d_ws + WS_BAR, 0, 16384, stream);
    Args a{};
    for (int i = 0; i < N_IN; ++i) a.in[i] = (const float*)d_in[i];
    a.out = (float*)d_out; a.ws = (unsigned char*)d_ws;
#if N_LAUNCH_MODE == 1
    a.ph_lo = 0; a.ph_hi = N_PHASES;
    hipLaunchKernelGGL(fwd_kernel, dim3(grid), dim3(512), LDS_BYTES, stream, a);
#else
    for (int p = 0; p < N_PHASES; ++p) { a.ph_lo = p; a.ph_hi = p + 1; hipLaunchKernelGGL(fwd_kernel, dim3(grid), dim3(512), LDS_BYTES, stream, a); }
#endif
}
```

```cpp
#include <hip/hip_runtime.h>
#include <cstdio>
namespace pg8 {
#define PG8_LAS __attribute__((address_space(3)))
typedef unsigned short bf16_t;
typedef short bf16x8 __attribute__((ext_vector_type(8)));
typedef float f32x4 __attribute__((ext_vector_type(4)));
typedef unsigned u32x4 __attribute__((ext_vector_type(4)));
constexpr int BM = 256, BK = 64, HALF = 128, HTB = HALF * BK * 2  , STAGE_BYTES = 8 * HTB, NXCD = 8, WGM = 8;

__host__ __device__ __forceinline__ int lds_byte(int r, int c) { const int st = (r >> 4) * 2 + (c >> 5), rr = r & 15, cc = c & 31, ob = rr * 64 + cc * 2; return st * 1024 + (ob ^ (((ob >> 9) & 1) << 5)); }
__host__ __device__ __forceinline__ void stage_rc(int b, int& R, int& C) { const int st = b / 1024, sb = b % 1024, swz = sb ^ (((sb >> 9) & 1) << 5); R = (st >> 1) * 16 + swz / 64; C = (st & 1) * 32 + (swz % 64) / 2; }
__host__ __device__ __forceinline__ int perm32(int rho) { const int n = rho >> 4, i = rho & 15; return 8 * (i >> 2) + 4 * n + (i & 3); }

struct Unit { int pm, pn, w; };
struct Gemm { const bf16_t* A; const bf16_t* Bt; int M, N, K; const bf16_t* A2; const bf16_t* Bt2; };

struct StaticOrder {
    int nM, nN, nwg, G, c;
    __host__ __device__ void init(int M, int N, int G_, int c_) { nM = M / BM; nN = N / BM; nwg = nM * nN; G = G_; c = c_; }
    __host__ __device__ bool next(int i, Unit& u) const {
        const long L = (long)i * G + c; if (L >= nwg) return false;
        int wgid = (int)L; { const int q = nwg / NXCD, r = nwg % NXCD, xcd = wgid % NXCD, off = wgid / NXCD; wgid = (xcd < r ? xcd * (q + 1) : r * (q + 1) + (xcd - r) * q) + off; }
        const int nig = WGM * nN, gid = wgid / nig, fm = gid * WGM, gsz = (nM - fm) < WGM ? (nM - fm) : WGM;
        u.pm = fm + ((wgid % nig) % gsz); u.pn = (wgid % nig) / gsz; u.w = 0; return true;
    }
    __device__ __forceinline__ void a_ready(const Unit&) const {}
    __device__ __forceinline__ void done(const Unit&) const {}
};
struct DualOrder {
    StaticOrder s0, s1; int G, c;
    __host__ __device__ void init(int M0, int N0, int M1, int N1, int G_, int c_) { s0.init(M0, N0, 1, 0); s1.init(M1, N1, 1, 0); G = G_; c = c_; }
    __host__ __device__ bool next(int i, Unit& u) const {
        const long L = (long)i * G + c;
        if (L < s0.nwg) { s0.next((int)L, u); u.w = 0; return true; }
        if (L < s0.nwg + s1.nwg) { s1.next((int)(L - s0.nwg), u); u.w = 1; return true; }
        return false;
    }
    __device__ __forceinline__ void a_ready(const Unit&) const {}
    __device__ __forceinline__ void done(const Unit&) const {}
};
__device__ __forceinline__ unsigned cvt_pk_bf16(float lo, float hi) { unsigned r; asm volatile("v_cvt_pk_bf16_f32 %0, %1, %2" : "=v"(r) : "v"(lo), "v"(hi)); return r; }
typedef float f32x2 __attribute__((ext_vector_type(2)));
__device__ __forceinline__ f32x2 gelu_pk(f32x2 v) {
    const f32x2 av = __builtin_elementwise_abs(v), d = av * 0.2316418882f + 1.0f;
    f32x2 t; t.x = __builtin_amdgcn_rcpf(d.x); t.y = __builtin_amdgcn_rcpf(d.y);
    f32x2 q = t * 0.5307027145f + (-0.7265760135f); q = q * t + 0.7107068705f; q = q * t + (-0.142248368f); q = q * t + 0.127414796f; q = q * t;
    const f32x2 s = (v * v) * (-0.72134752044f);
    f32x2 e; e.x = __builtin_amdgcn_exp2f(s.x); e.y = __builtin_amdgcn_exp2f(s.y);
    const f32x2 m = v * (q * e), r = v - m;
    f32x2 o; o.x = v.x < 0.f ? m.x : r.x; o.y = v.y < 0.f ? m.y : r.y; return o;
}
template <int ACT  > struct EpiBf16 {
    static constexpr bool PERM = true, AFTER_DRAIN = false;
    bf16_t* O; int ldc; const float* bias; int split_cols; size_t split_stride;
    __device__ __forceinline__ void operator()(const f32x4 (&acc)[2][2][4][2], const Unit& u, int wr, int wc, int fr, int fq) const {
        const int row0 = u.pm * BM + wr * 64 + fr; int colt = u.pn * BM; bf16_t* base = O;
        if (split_cols) { const int t = colt / split_cols; base += (size_t)t * split_stride; colt -= t * split_cols; }
        const int col0 = colt + wc * 32 + 8 * fq, bcol0 = u.pn * BM + wc * 32 + 8 * fq;
        f32x4 bv[2][2];
#pragma unroll
        for (int bj = 0; bj < 2; ++bj)
#pragma unroll
            for (int n = 0; n < 2; ++n) bv[bj][n] = bias ? *(const f32x4*)(bias + bcol0 + bj * HALF + 4 * n) : (f32x4){0.f, 0.f, 0.f, 0.f};
#pragma unroll
        for (int ai = 0; ai < 2; ++ai)
#pragma unroll
            for (int m = 0; m < 4; ++m) { bf16_t* rowp = base + (size_t)(row0 + ai * HALF + m * 16) * ldc + col0;
#pragma unroll
                for (int bj = 0; bj < 2; ++bj) { f32x4 v0 = acc[ai][bj][m][0] + bv[bj][0], v1 = acc[ai][bj][m][1] + bv[bj][1];
                    if (ACT == 1) { f32x2 a = gelu_pk((f32x2){v0[0], v0[1]}), b = gelu_pk((f32x2){v0[2], v0[3]}), c = gelu_pk((f32x2){v1[0], v1[1]}), d = gelu_pk((f32x2){v1[2], v1[3]});
                        v0 = (f32x4){a.x, a.y, b.x, b.y}; v1 = (f32x4){c.x, c.y, d.x, d.y}; }
                    if (ACT == 2) {
#pragma unroll
                        for (int j = 0; j < 4; ++j) { v0[j] = 0.5f * v0[j] * (1.0f + erff(v0[j] * 0.70710678f)); v1[j] = 0.5f * v1[j] * (1.0f + erff(v1[j] * 0.70710678f)); } }
                    u32x4 w; w.x = cvt_pk_bf16(v0[0], v0[1]); w.y = cvt_pk_bf16(v0[2], v0[3]); w.z = cvt_pk_bf16(v1[0], v1[1]); w.w = cvt_pk_bf16(v1[2], v1[3]);
                    *(u32x4*)(rowp + bj * HALF) = w; } }
    }
};
template <class Epi, class Sched, bool STAMP = false>
__device__ __forceinline__ void gemm_phase(PG8_LAS unsigned char* lds, const Gemm g, const Sched& S, const Epi& E, unsigned long long* stamps) {
    int tid = threadIdx.x; asm volatile("" : "+v"(tid)); const int wid = __builtin_amdgcn_readfirstlane(tid >> 6), lane = tid & 63, wr = wid >> 2, wc = wid & 3, fr = lane & 15, fq = lane >> 4;
    const int K = g.K, nt = K / BK;
    int ts_lo = 0, ts_hi = 0, nts = 0; const unsigned long long rt_entry = STAMP ? (unsigned long long)wall_clock64() : 0ull;
#define PG8_STAMP() do { if (STAMP && wid == 0 && nts < 64) { const unsigned long long _c = (unsigned long long)clock64(); \
        ts_lo = (lane == nts) ? (int)(unsigned)_c : ts_lo; ts_hi = (lane == nts) ? (int)(unsigned)(_c >> 32) : ts_hi; ++nts; } } while (0)
    PG8_STAMP();
    unsigned voffA[2], voffB[2];
#pragma unroll
    for (int i = 0; i < 2; ++i) { int R, C; stage_rc(tid * 16 + i * 8192, R, C); const int Rb = Epi::PERM ? ((R & ~31) + perm32(R & 31)) : R;
        voffA[i] = (unsigned)(R * K + C) * 2u; voffB[i] = (unsigned)(Rb * K + C) * 2u; }
    const size_t kstep = (size_t)(BK * 2);
    const size_t hstep = (size_t)HALF * K * 2;
    const size_t tstep = 2 * hstep;
    const unsigned ldsw = (unsigned)wid * 1024u;
    const int aoff = lds_byte(wr * 64 + fr, fq * 8), boff = lds_byte(wc * 32 + fr, fq * 8);
#define PG8_SA(b, h) (((b) * 2 + (h)) * HTB)
#define PG8_SB(b, h) ((4 + (b) * 2 + (h)) * HTB)
#define PG8_STAGE(bufoff, gbase, voff) do { _Pragma("unroll") for (int _i = 0; _i < 2; ++_i) \
        __builtin_amdgcn_global_load_lds((const unsigned*)((const char*)(gbase) + (voff)[_i]), (PG8_LAS unsigned*)(lds + (bufoff) + ldsw + _i * 8192), 16, 0, 0); } while (0)
#define PG8_LDA(dst, b, h) do { _Pragma("unroll") for (int m = 0; m < 4; ++m) _Pragma("unroll") for (int k = 0; k < 2; ++k) dst[m][k] = *(const PG8_LAS bf16x8*)(lds + PG8_SA(b, h) + aoff + m * 2048 + k * 1024); } while (0)
#define PG8_LDB(dst, b, h) do { _Pragma("unroll") for (int n = 0; n < 2; ++n) _Pragma("unroll") for (int k = 0; k < 2; ++k) dst[n][k] = *(const PG8_LAS bf16x8*)(lds + PG8_SB(b, h) + boff + n * 2048 + k * 1024); } while (0)
#define PG8_MMA(ai, bj, At, Bt) do { __builtin_amdgcn_s_setprio(1); _Pragma("unroll") for (int m = 0; m < 4; ++m) _Pragma("unroll") for (int n = 0; n < 2; ++n) _Pragma("unroll") for (int k = 0; k < 2; ++k) \
        acc[ai][bj][m][n] = __builtin_amdgcn_mfma_f32_16x16x32_bf16(Bt[n][k], At[m][k], acc[ai][bj][m][n], 0, 0, 0); __builtin_amdgcn_s_setprio(0); } while (0)
#define PG8_WAIT_V(n) asm volatile("s_waitcnt vmcnt(" #n ")" ::: "memory")
#define PG8_WAIT_L(n) asm volatile("s_waitcnt lgkmcnt(" #n ")" ::: "memory")
#define PG8_BAR __builtin_amdgcn_s_barrier()
#define PG8_SCHED __builtin_amdgcn_sched_barrier(0)
    Unit cur, nxt; int ui = 0;
    if (!S.next(0, cur)) return;
    f32x4 acc[2][2][4][2];
#pragma unroll
    for (int a = 0; a < 2; ++a)
#pragma unroll
        for (int b = 0; b < 2; ++b)
#pragma unroll
            for (int m = 0; m < 4; ++m)
#pragma unroll
                for (int n = 0; n < 2; ++n) acc[a][b][m][n] = (f32x4){0.f, 0.f, 0.f, 0.f};
    bf16x8 At[4][2], B0[2][2], B1[2][2];
    const char* cA = (const char*)(cur.w ? g.A2 : g.A) + (size_t)cur.pm * tstep; const char* cB = (const char*)(cur.w ? g.Bt2 : g.Bt) + (size_t)cur.pn * tstep;
    S.a_ready(cur);
    PG8_STAGE(PG8_SB(0, 0), cB, voffB); PG8_STAGE(PG8_SA(0, 0), cA, voffA); PG8_STAGE(PG8_SB(0, 1), cB + hstep, voffB); PG8_STAGE(PG8_SA(0, 1), cA + hstep, voffA);
    if (wr == 1) PG8_BAR;
    PG8_WAIT_V(4); PG8_BAR;
    PG8_STAGE(PG8_SB(1, 0), cB + kstep, voffB); PG8_STAGE(PG8_SA(1, 0), cA + kstep, voffA); PG8_STAGE(PG8_SB(1, 1), cB + hstep + kstep, voffB);
    PG8_WAIT_V(6); PG8_BAR;
    PG8_STAMP();
    for (;;) {
        const bool has_next = S.next(ui + 1, nxt);
        const char* nA = has_next ? (const char*)(nxt.w ? g.A2 : g.A) + (size_t)nxt.pm * tstep : cA; const char* nB = has_next ? (const char*)(nxt.w ? g.Bt2 : g.Bt) + (size_t)nxt.pn * tstep : cB;
        for (int t = 0; t < nt; t += 2) {
            const bool last = (t == nt - 2);
            const char* a1 = cA + (size_t)(t + 1) * kstep;
            const char* a2 = last ? nA : cA + (size_t)(t + 2) * kstep; const char* b2 = last ? nB : cB + (size_t)(t + 2) * kstep;
            const char* a3 = a2 + kstep; const char* b3 = b2 + kstep;
            if (last && has_next) S.a_ready(nxt);
            PG8_LDB(B0, 0, 0); PG8_SCHED; PG8_LDA(At, 0, 0); PG8_STAGE(PG8_SA(1, 1), a1 + hstep, voffA);
            PG8_WAIT_L(8); PG8_BAR; PG8_WAIT_L(0); PG8_MMA(0, 0, At, B0); PG8_BAR; PG8_SCHED;
            PG8_LDB(B1, 0, 1); PG8_STAGE(PG8_SB(0, 0), b2, voffB);
            PG8_BAR; PG8_WAIT_L(0); PG8_MMA(0, 1, At, B1); PG8_BAR;
            PG8_LDA(At, 0, 1); PG8_STAGE(PG8_SA(0, 0), a2, voffA);
            PG8_BAR; PG8_WAIT_L(0); PG8_MMA(1, 0, At, B0); PG8_BAR; PG8_SCHED;
            PG8_STAGE(PG8_SB(0, 1), b2 + hstep, voffB);
            PG8_WAIT_V(6); PG8_BAR; PG8_MMA(1, 1, At, B1); PG8_BAR;
            PG8_LDB(B0, 1, 0); PG8_SCHED; PG8_LDA(At, 1, 0); PG8_STAGE(PG8_SA(0, 1), a2 + hstep, voffA);
            PG8_WAIT_L(8); PG8_BAR; PG8_WAIT_L(0); PG8_MMA(0, 0, At, B0); PG8_BAR; PG8_SCHED;
            PG8_LDB(B1, 1, 1); PG8_STAGE(PG8_SB(1, 0), b3, voffB);
            PG8_BAR; PG8_WAIT_L(0); PG8_MMA(0, 1, At, B1); PG8_BAR;
            PG8_LDA(At, 1, 1); PG8_STAGE(PG8_SA(1, 0), a3, voffA);
            PG8_BAR; PG8_WAIT_L(0); PG8_MMA(1, 0, At, B0); PG8_BAR; PG8_SCHED;
            PG8_STAGE(PG8_SB(1, 1), b3 + hstep, voffB);
            PG8_WAIT_V(6); PG8_BAR; PG8_MMA(1, 1, At, B1); PG8_BAR;
        }
        PG8_STAMP();
        if constexpr (!Epi::AFTER_DRAIN) { E(acc, cur, wr, wc, fr, fq); S.done(cur); }
        PG8_STAMP();
        if (!has_next) break;
#pragma unroll
        for (int a = 0; a < 2; ++a)
#pragma unroll
            for (int b = 0; b < 2; ++b)
#pragma unroll
                for (int m = 0; m < 4; ++m)
#pragma unroll
                    for (int n = 0; n < 2; ++n) acc[a][b][m][n] = (f32x4){0.f, 0.f, 0.f, 0.f};
        cur = nxt; cA = nA; cB = nB; ++ui;
    }
    PG8_WAIT_V(0);
    if (wr == 0) PG8_BAR;
    PG8_BAR;
    if constexpr (Epi::AFTER_DRAIN) { E.fused(acc, cur, wr, wc, fr, fq, lds, wid, lane); S.done(cur); }
    PG8_STAMP();
    if (STAMP && wid == 0) { stamps[lane] = lane < nts ? (((unsigned long long)(unsigned)ts_hi << 32) | (unsigned)ts_lo) : 0ull;
        if (lane == 62) stamps[62] = rt_entry; if (lane == 63) stamps[63] = (unsigned long long)wall_clock64(); }
#undef PG8_STAMP
#undef PG8_SA
#undef PG8_SB
#undef PG8_STAGE
#undef PG8_LDA
#undef PG8_LDB
#undef PG8_MMA
#undef PG8_WAIT_V
#undef PG8_WAIT_L
#undef PG8_BAR
#undef PG8_SCHED
}
}

#define XB_TMO      128
#define XB_XCNT(j)  (256  + 64 * (j))
#define XB_XSUB(j)  (1280 + 64 * (j))
#define XB_XGEN(j)  (2304 + 64 * (j))
#define XB_TOP      3328
#define XB_TOPGEN   3392
#define XCD_BAR_WORDS 3456
#define XB_SPIN_CAP (1u << 22)
#define LAS __attribute__((address_space(3)))

__device__ __forceinline__ unsigned xb_ld(unsigned* p)              { return __hip_atomic_load(p, __ATOMIC_RELAXED, __HIP_MEMORY_SCOPE_AGENT); }
__device__ __forceinline__ unsigned xb_add(unsigned* p, unsigned v) { return __hip_atomic_fetch_add(p, v, __ATOMIC_RELAXED, __HIP_MEMORY_SCOPE_AGENT); }
__device__ __forceinline__ unsigned xb_xcc_id() { return (unsigned)__builtin_amdgcn_s_getreg((3 << 11) | 20) & 0xFu; }
#define XB_SPIN(cond, bar) do { unsigned _sp = 0; while (cond) { __builtin_amdgcn_s_sleep(1); \
    if ((++_sp & 255u) == 0u) { if (xb_ld(&(bar)[XB_TMO])) break; if (_sp > XB_SPIN_CAP) { atomicAdd(&(bar)[XB_TMO], 1u); break; } } } } while (0)

struct XcdBarrier { unsigned* bar; unsigned x; volatile LAS unsigned* st; };

__device__ __forceinline__ XcdBarrier xcd_barrier_post(unsigned* bar, volatile LAS unsigned* st) {
    XcdBarrier b; b.bar = bar; b.x = xb_xcc_id(); b.st = st;
    if (threadIdx.x == 0) st[2] = xb_add(&bar[XB_XCNT(b.x)], 1u);
    return b;
}
__device__ __forceinline__ void xcd_barrier_complete(unsigned* bar, unsigned x, unsigned& nloc, unsigned& nx) {
    const unsigned G = gridDim.x * gridDim.y * gridDim.z;
    unsigned sum, cnt, mine, sp = 0u;
    for (;;) {
        sum = 0u; cnt = 0u; mine = 0u;
#pragma unroll
        for (unsigned j = 0; j < 16; ++j) { const unsigned c = xb_ld(&bar[XB_XCNT(j)]); sum += c; cnt += (c > 0u) ? 1u : 0u; mine = (j == x) ? c : mine; }
        if (sum == G) break;
        __builtin_amdgcn_s_sleep(1);
        if ((++sp & 255u) == 0u) { if (xb_ld(&bar[XB_TMO])) break; if (sp > XB_SPIN_CAP) { atomicAdd(&bar[XB_TMO], 1u); break; } }
    }
    nloc = mine > 0u ? mine : 1u; nx = cnt > 0u ? cnt : 1u;
}
__device__ __forceinline__ void xcd_barrier(const XcdBarrier& b) {
    asm volatile("s_waitcnt vmcnt(0)" ::: "memory");
    __syncthreads();
    if (threadIdx.x == 0) {
        unsigned* bar = b.bar;
        __builtin_amdgcn_s_waitcnt(0);
        unsigned nloc = b.st[0], nx = b.st[1];
        if (nloc == 0u) { xcd_barrier_complete(bar, b.x, nloc, nx); b.st[0] = nloc; b.st[1] = nx; }
        const unsigned old = xb_add(&bar[XB_XSUB(b.x)], 1u);
        const unsigned gen = old / nloc;
        if (old + 1u == (gen + 1u) * nloc) {
            __builtin_amdgcn_fence(__ATOMIC_RELEASE, "agent");
            asm volatile("s_waitcnt vmcnt(0)" ::: "memory");
            const unsigned og = xb_add(&bar[XB_TOP], 1u);
            const unsigned tg = og / nx;
            if (og + 1u == (tg + 1u) * nx) xb_add(&bar[XB_TOPGEN], 1u);
            else XB_SPIN(xb_ld(&bar[XB_TOPGEN]) == tg, bar);
            __builtin_amdgcn_fence(__ATOMIC_ACQUIRE, "agent");
            xb_add(&bar[XB_XGEN(b.x)], 1u);
            asm volatile("s_waitcnt vmcnt(0)" ::: "memory");
        } else {
            XB_SPIN(xb_ld(&bar[XB_XGEN(b.x)]) == gen, bar);
            __builtin_amdgcn_fence(__ATOMIC_ACQUIRE, "agent");
            asm volatile("s_waitcnt vmcnt(0)" ::: "memory");
        }
    }
    __syncthreads();
}

typedef unsigned short u16;
using pg8::bf16x8; using pg8::f32x4; using pg8::u32x4;
typedef float f32x2v __attribute__((ext_vector_type(2)));
typedef unsigned u32x2 __attribute__((ext_vector_type(2)));

constexpr int DM = 2048, NB = 4, SEQL = 4096, CTXL = 256, NLAT = NB * SEQL, NCTX = NB * CTXL, MROWS = NLAT + NCTX;
constexpr int DEPTH = 4, NMAIN = 3072, NTR = 1536;
constexpr int PJ_Q = 0, PJ_K = 1024, PJ_SU = 2048, PJ_SIN = 2560;
constexpr int TR_V = 0, TR_SV = 1024;
constexpr int NCHK = 68;
constexpr float EPSN = 1e-6f;

constexpr size_t al256(size_t x) { return (x + 255) & ~(size_t)255; }
constexpr size_t WS_BAR   = 0;
constexpr size_t WS_MOD   = 16384;
constexpr size_t WS_MODP  = al256(WS_MOD + (size_t)DEPTH * 5 * 6 * DM * 4);
constexpr size_t WS_X     = al256(WS_MODP + (size_t)64 * DEPTH * 5 * 6 * DM * 4);
constexpr size_t WS_H     = al256(WS_X + (size_t)MROWS * DM * 4);
constexpr size_t WS_PROJ  = al256(WS_H + (size_t)MROWS * DM * 2);
constexpr size_t WS_TR    = al256(WS_PROJ + (size_t)MROWS * NMAIN * 2);
constexpr size_t WS_ATT   = al256(WS_TR + (size_t)NTR * MROWS * 2);
constexpr size_t WS_SGU   = al256(WS_ATT + (size_t)MROWS * 1024 * 2);
constexpr size_t WS_S5Y   = al256(WS_SGU + (size_t)MROWS * 512 * 2);
constexpr size_t WS_S5O   = al256(WS_S5Y + (size_t)MROWS * 512 * 2);
constexpr size_t WS_YIN   = al256(WS_S5O + (size_t)MROWS * 512 * 2);
constexpr size_t WS_PQ    = al256(WS_YIN + (size_t)MROWS * DM * 2);
constexpr size_t PAIRS_MAX = (size_t)MROWS * 128;
constexpr size_t WS_ET    = al256(WS_PQ + (size_t)MROWS * DM * 2);
constexpr size_t WS_GT    = al256(WS_ET + PAIRS_MAX * 2);
constexpr size_t WS_PART  = al256(WS_GT + PAIRS_MAX * 4);
constexpr size_t WS_WT    = al256(WS_PART + 8 * PAIRS_MAX * 2);
constexpr size_t WS_H8    = al256(WS_WT + PAIRS_MAX * 2);
constexpr size_t WS_HSC   = al256(WS_H8 + (size_t)MROWS * DM);
constexpr size_t WS_SLOC  = al256(WS_HSC + (size_t)MROWS * 4);
constexpr size_t WS_WTS   = al256(WS_SLOC + (size_t)NB * 32 * 2 * NCHK * 64 * 8);
constexpr size_t WL_MAIN = 0;
constexpr size_t WL_TR   = WL_MAIN + (size_t)NMAIN * DM * 2;
constexpr size_t WL_OUT  = WL_TR + (size_t)NTR * DM * 2;
constexpr size_t WL_Q    = WL_OUT + (size_t)DM * DM * 2;
constexpr size_t WL_GLU  = WL_Q + (size_t)DM * DM * 2;
constexpr size_t WL_K12  = WL_GLU + (size_t)512 * 512 * 2;
constexpr size_t WL_U    = WL_K12 + (size_t)2 * 8 * 128 * 128 * 2;
constexpr size_t WL_V    = WL_U + (size_t)16384 * DM / 2;
constexpr size_t WL_SGUW = WL_V + (size_t)16384 * DM / 2;
constexpr size_t WL_SIZE = al256(WL_SGUW + (size_t)4 * 128 * 128 * 2);
constexpr float VSCALE = 5.5f, USCALE = 135.0f;
constexpr int PEER_NSL = 8, PEER_ROWB = 128;
constexpr size_t PEER_SLB = (size_t)16384 * 128;
constexpr size_t WS_END  = WS_WTS + DEPTH * WL_SIZE;

constexpr int LDS_BYTES = 147456;
constexpr int LDS_BARW  = LDS_BYTES - 32;

enum { I_X = 0, I_C, I_CTX, I_CCTX, I_ADAW, I_ADAB, I_NMIX, I_NFFN, I_WIN, I_WOUT, I_ONORM, I_RPB, I_SGUW, I_SGUB, I_SGUN, I_ARE, I_AIM, I_LOGDT, I_BRE, I_BIM, I_CRE, I_CIM, I_S5D, I_GLUW, I_GLUB,
       I_WQ, I_K1, I_K2, I_PU, I_PV, I_FNORM, N_IN };

struct Args { const float* in[N_IN]; float* out; unsigned char* ws; int ph_lo, ph_hi; };

struct Ctx {
    const float* in[N_IN]; float* out; unsigned char* ws; LAS unsigned char* lds;
    int tid, lane, wave, G, bid;
    float* MOD; float* MODP; u16* X; u16* H; u16* PROJ; u16* TR; u16* ATT; u16* SGU; u16* S5Y; u16* S5O; u16* YIN; u16* PQ; u16* ET; float* GT; u16* PART; u16* WT; unsigned char* H8; float* HSC; f32x2v* SLOC;
    int xi, nx, xr, xn;
    __device__ __forceinline__ unsigned char* wl(int l) const { return ws + WS_WTS + (size_t)l * WL_SIZE; }
    __device__ __forceinline__ void fresh() { int t = threadIdx.x; asm volatile("" : "+v"(t)); tid = t; lane = t & 63; wave = __builtin_amdgcn_readfirstlane(t >> 6); }
};

__device__ __forceinline__ float bf2f(u16 v) { return __uint_as_float(((unsigned)v) << 16); }
__device__ __forceinline__ float bflo(unsigned v) { return __uint_as_float(v << 16); }
__device__ __forceinline__ float bfhi(unsigned v) { return __uint_as_float(v & 0xffff0000u); }
__device__ __forceinline__ u16 f2bf(float f) { unsigned u = __float_as_uint(f); u += 0x7FFFu + ((u >> 16) & 1u); return (u16)(u >> 16); }
__device__ __forceinline__ unsigned pk2(float lo, float hi) { return pg8::cvt_pk_bf16(lo, hi); }
__device__ __forceinline__ float gelu_f(float v) {
    const float av = fabsf(v), t = __builtin_amdgcn_rcpf(av * 0.2316418882f + 1.0f);
    float q = t * 0.5307027145f + (-0.7265760135f); q = q * t + 0.7107068705f; q = q * t + (-0.142248368f); q = q * t + 0.127414796f; q = q * t;
    const float e = __builtin_amdgcn_exp2f((v * v) * (-0.72134752044f));
    const float m = v * (q * e);
    return v < 0.f ? m : v - m;
}
__device__ __forceinline__ float wave_sum(float v) {
    v += __shfl_xor(v, 32); v += __shfl_xor(v, 16); v += __shfl_xor(v, 8); v += __shfl_xor(v, 4); v += __shfl_xor(v, 2); v += __shfl_xor(v, 1); return v;
}
__device__ __forceinline__ int row_bidx(int row) { return row < NLAT ? (row >> 12) : 4; }
__device__ __forceinline__ void lds_fence() { asm volatile("s_waitcnt lgkmcnt(0)" ::: "memory"); }

__device__ __forceinline__ void tr_tile(const Ctx& c, const float* src, int ld, int k0, int n0, u16* dst, int drow0) {
    LAS float* T = (LAS float*)c.lds;
    const int t = c.tid, cq = t & 63, r0 = t >> 6;
    f32x4 v[8];
#pragma unroll
    for (int i = 0; i < 8; ++i) v[i] = *(const f32x4*)(src + (size_t)(k0 + r0 + 8 * i) * ld + n0 + 4 * cq);
#pragma unroll
    for (int i = 0; i < 8; ++i) *(LAS f32x4*)(T + (r0 + 8 * i) * 260 + 4 * cq) = v[i];
    __syncthreads();
#pragma unroll
    for (int i = 0; i < 4; ++i) {
        const int idx = t + 512 * i, n = idx >> 3, kc = idx & 7;
        float e[8];
#pragma unroll
        for (int q = 0; q < 8; ++q) e[q] = T[(8 * kc + q) * 260 + n];
        u32x4 o; o.x = pk2(e[0], e[1]); o.y = pk2(e[2], e[3]); o.z = pk2(e[4], e[5]); o.w = pk2(e[6], e[7]);
        *(u32x4*)(dst + (size_t)(drow0 + n) * DM + k0 + 8 * kc) = o;
    }
    __syncthreads();
}

__device__ __forceinline__ unsigned pack_i4(const float4& a, const float4& b) {
    const float ev[8] = {a.x, a.y, a.z, a.w, b.x, b.y, b.z, b.w};
    unsigned nb[8];
#pragma unroll
    for (int k2 = 0; k2 < 8; ++k2) { const int qv = (int)rintf(ev[k2] * USCALE); nb[k2] = (unsigned)(min(max(qv, -8), 7) + 8); }
    return nb[0] | (nb[4] << 4) | (nb[1] << 8) | (nb[5] << 12) | (nb[2] << 16) | (nb[6] << 20) | (nb[3] << 24) | (nb[7] << 28);
}
__device__ __forceinline__ unsigned pack_fp4(const float4& a, const float4& b) {
    unsigned w = 0u;
    w = __builtin_amdgcn_cvt_scalef32_pk_fp4_f32(w, a.x * VSCALE, a.y * VSCALE, 1.0f, 0); w = __builtin_amdgcn_cvt_scalef32_pk_fp4_f32(w, a.z * VSCALE, a.w * VSCALE, 1.0f, 1);
    w = __builtin_amdgcn_cvt_scalef32_pk_fp4_f32(w, b.x * VSCALE, b.y * VSCALE, 1.0f, 2); w = __builtin_amdgcn_cvt_scalef32_pk_fp4_f32(w, b.z * VSCALE, b.w * VSCALE, 1.0f, 3);
    return w;
}
template <bool IS_U>
__device__ __forceinline__ void peer_convert(const Ctx& c, int l, int b0, int nb) {
    if (c.bid < b0 || c.bid >= b0 + nb) return;
    const size_t n32 = (size_t)16384 * DM / 32, stride = (size_t)nb * 512;
    const float4* src = (const float4*)((IS_U ? c.in[I_PU] : c.in[I_PV]) + (size_t)l * 16384 * DM);
    u32x4* dst = (u32x4*)(c.wl(l) + (IS_U ? WL_U : WL_V));
    for (size_t i = (size_t)(c.bid - b0) * 512 + c.tid; i < n32; i += 2 * stride) {
        const size_t i2 = i + stride; const bool two = i2 < n32; const size_t j2 = two ? i2 : i;
        float4 a[8], b[8];
#pragma unroll
        for (int q = 0; q < 8; ++q) { a[q] = src[8 * i + q]; b[q] = src[8 * j2 + q]; }
        u32x4 o, p;
        if (IS_U) { o = (u32x4){pack_i4(a[0], a[1]), pack_i4(a[2], a[3]), pack_i4(a[4], a[5]), pack_i4(a[6], a[7])}; p = (u32x4){pack_i4(b[0], b[1]), pack_i4(b[2], b[3]), pack_i4(b[4], b[5]), pack_i4(b[6], b[7])}; }
        else      { o = (u32x4){pack_fp4(a[0], a[1]), pack_fp4(a[2], a[3]), pack_fp4(a[4], a[5]), pack_fp4(a[6], a[7])}; p = (u32x4){pack_fp4(b[0], b[1]), pack_fp4(b[2], b[3]), pack_fp4(b[4], b[5]), pack_fp4(b[6], b[7])}; }
        dst[((i & 63) >> 3) * 131072 + (i >> 6) * 8 + (i & 7)] = o; if (two) dst[((i2 & 63) >> 3) * 131072 + (i2 >> 6) * 8 + (i2 & 7)] = p;
    }
}
__device__ __forceinline__ void peer_convert_u(const Ctx& c, int l, int b0, int nb) { peer_convert<true>(c, l, b0, nb); }
__device__ __forceinline__ void peer_convert_v(const Ctx& c, int l, int b0, int nb) { peer_convert<false>(c, l, b0, nb); }

__device__ __forceinline__ void phase_prologue(const Ctx& c) {
    const int G = c.G, bid = c.bid, tid = c.tid;
    {
        const size_t n8 = (size_t)MROWS * DM / 8, nl8 = (size_t)NLAT * DM / 8;
        const float4* sx = (const float4*)c.in[I_X]; const float4* sc = (const float4*)c.in[I_CTX]; u32x4* dx = (u32x4*)c.X;
        for (size_t i = (size_t)bid * 512 + tid; i < n8; i += (size_t)G * 512) {
            const float4* s = i < nl8 ? sx + 2 * i : sc + 2 * (i - nl8);
            const float4 a = s[0], b = s[1];
            dx[i] = (u32x4){pk2(a.x, a.y), pk2(a.z, a.w), pk2(b.x, b.y), pk2(b.z, b.w)};
        }
    }
    for (int l = 0; l < DEPTH; ++l) {
        unsigned char* W = c.wl(l);
        const float* win = c.in[I_WIN] + (size_t)l * DM * 4608;
        for (int it = bid; it < 32 * 18; it += G) {
            const int kt = it & 31, nt = it >> 5, n0 = nt * 256;
            u16* dst; int drow;
            if (n0 < 2048) { dst = (u16*)(W + WL_MAIN); drow = n0; }
            else if (n0 < 3072) { dst = (u16*)(W + WL_TR); drow = n0 - 2048; }
            else if (n0 < 3584) { dst = (u16*)(W + WL_MAIN); drow = 2048 + (n0 - 3072); }
            else if (n0 < 4096) { dst = (u16*)(W + WL_TR); drow = 1024 + (n0 - 3584); }
            else { dst = (u16*)(W + WL_MAIN); drow = 2560 + (n0 - 4096); }
            tr_tile(c, win, 4608, kt * 64, n0, dst, drow);
        }
        const float* wout = c.in[I_WOUT] + (size_t)l * DM * DM;
        for (int it = bid; it < 32 * 8; it += G) tr_tile(c, wout, DM, (it & 31) * 64, (it >> 5) * 256, (u16*)(W + WL_OUT), (it >> 5) * 256);
        const float* wq = c.in[I_WQ] + (size_t)l * DM * DM;
        for (int it = bid; it < 32 * 8; it += G) tr_tile(c, wq, DM, (it & 31) * 64, (it >> 5) * 256, (u16*)(W + WL_Q), (it >> 5) * 256);
        {
            const float* gw = c.in[I_GLUW] + (size_t)l * 512 * 512; u16* dst = (u16*)(W + WL_GLU);
            LAS float* T = (LAS float*)c.lds;
            for (int it = bid; it < 8 * 8; it += G) {
                const int k0 = (it & 7) * 64, n0 = (it >> 3) * 64, t = tid;
#pragma unroll
                for (int i = 0; i < 8; ++i) { const int r = (t >> 6) + 8 * i; T[r * 65 + (t & 63)] = gw[(size_t)(k0 + r) * 512 + n0 + (t & 63)]; }
                __syncthreads();
#pragma unroll
                for (int i = 0; i < 4; ++i) { const int n = (t >> 5) + 16 * i, kp = t & 31;
                    *(unsigned*)(dst + (size_t)(n0 + n) * 512 + k0 + 2 * kp) = pk2(T[(2 * kp) * 65 + n], T[(2 * kp + 1) * 65 + n]); }
                __syncthreads();
            }
        }
        {
            const float* sw = c.in[I_SGUW] + (size_t)l * 4 * 128 * 128; u16* dst = (u16*)(W + WL_SGUW);
            for (int i = bid * 512 + tid; i < 4 * 128 * 128 / 2; i += G * 512) *(unsigned*)(dst + 2 * i) = pk2(sw[2 * i], sw[2 * i + 1]);
        }
        {
            u16* dst = (u16*)(W + WL_K12);
            const float* k1 = c.in[I_K1] + (size_t)l * 8 * 128 * 128; const float* k2 = c.in[I_K2] + (size_t)l * 8 * 128 * 128;
            for (int i = bid * 512 + tid; i < 2 * 131072 / 2; i += G * 512) {
                const int e = 2 * i; const float* s = e < 131072 ? k1 + e : k2 + (e - 131072);
                *(unsigned*)(dst + e) = pk2(s[0], s[1]);
            }
        }
    }
    { const int nl = (G == 256) ? 1 : DEPTH;
      for (int l = 0; l < nl; ++l) { peer_convert_u(c, l, 0, G); peer_convert_v(c, l, 0, G); } }
    {
        LAS float* S = (LAS float*)c.lds;
        for (int it = bid; it < DEPTH * 24 * 16; it += G) {
            const int kc = it & 15, nb = (it >> 4) % 24, l = it / (16 * 24);
            __syncthreads();
            for (int i = tid; i < 640; i += 512) { const int r = i >> 7, kk = i & 127; const float v = r < 4 ? c.in[I_C][r * DM + kc * 128 + kk] : c.in[I_CCTX][kc * 128 + kk]; S[i] = v / (1.0f + __expf(-v)); }
            __syncthreads();
            const int cq = tid & 127, kq = tid >> 7, n = nb * 512 + 4 * cq;
            const float* w = c.in[I_ADAW] + ((size_t)l * DM + kc * 128 + kq * 32) * 12288 + n;
            float4 a[5];
#pragma unroll
            for (int r = 0; r < 5; ++r) a[r] = make_float4(0.f, 0.f, 0.f, 0.f);
#pragma unroll 16
            for (int kk = 0; kk < 32; ++kk) {
                const float4 wv = *(const float4*)(w + (size_t)kk * 12288);
#pragma unroll
                for (int r = 0; r < 5; ++r) { const float sv = S[r * 128 + kq * 32 + kk]; a[r].x += sv * wv.x; a[r].y += sv * wv.y; a[r].z += sv * wv.z; a[r].w += sv * wv.w; }
            }
            float* o = c.MODP + ((size_t)((kc * 4 + kq) * DEPTH + l) * 5) * 12288 + n;
#pragma unroll
            for (int r = 0; r < 5; ++r) *(float4*)(o + (size_t)r * 12288) = a[r];
        }
        __syncthreads();
    }
}

__device__ __forceinline__ void phase_modfin(const Ctx& c) {
    const int total = DEPTH * 5 * 12288;
    for (int i = c.bid * 512 + c.tid; i < total; i += c.G * 512) {
        const int n = i % 12288, l = i / (5 * 12288);
        float s = c.in[I_ADAB][l * 12288 + n];
#pragma unroll
        for (int kc = 0; kc < 64; ++kc) s += c.MODP[(size_t)kc * total + i];
        const int mi = n >> 11, col = n & 2047;
        if (mi == 1) s = c.in[I_NMIX][l * DM + col] * (1.0f + s);
        if (mi == 4) s = c.in[I_NFFN][l * DM + col] * (1.0f + s);
        c.MOD[i] = s;
    }
}

__device__ __forceinline__ void phase_normmod(const Ctx& c, int l, int which, int nrows, int row0 = 0, int b0 = 0, int nb = 0) {
    if (nb == 0) nb = c.G;
    if (c.bid < b0 || c.bid >= b0 + nb) return;
    int row = row0 + (c.bid - b0) * 8 + c.wave;
    if (row >= row0 + nrows) return;
    u32x2 xn[8];
    { const u32x2* xp = (const u32x2*)(c.X + (size_t)row * DM);
#pragma unroll
      for (int i = 0; i < 8; ++i) xn[i] = xp[c.lane + 64 * i]; }
    for (; row < row0 + nrows; row += nb * 8) {
        const int bi = row_bidx(row);
        const float* sh = c.MOD + ((size_t)(l * 5 + bi) * 6 + (which ? 3 : 0)) * DM; const float* sc = sh + DM;
        float4 v[8]; float ss = 0.f;
#pragma unroll
        for (int i = 0; i < 8; ++i) { const u32x2 xw = xn[i]; v[i] = make_float4(bflo(xw.x), bfhi(xw.x), bflo(xw.y), bfhi(xw.y)); ss += v[i].x * v[i].x + v[i].y * v[i].y + v[i].z * v[i].z + v[i].w * v[i].w; }
        float4 s1v[8], s0v[8];
#pragma unroll
        for (int i = 0; i < 8; ++i) { const int e = 4 * (c.lane + 64 * i); s1v[i] = *(const float4*)(sc + e); s0v[i] = *(const float4*)(sh + e); }
        asm volatile("" ::: "memory");
        { const u32x2* xp = (const u32x2*)(c.X + (size_t)min(row + nb * 8, row0 + nrows - 1) * DM);
#pragma unroll
          for (int i = 0; i < 8; ++i) xn[i] = xp[c.lane + 64 * i]; }
        asm volatile("" ::: "memory");
        ss = wave_sum(ss);
        const float rstd = rsqrtf(ss * (1.0f / DM) + EPSN);
        uint2* hp = (uint2*)(c.H + (size_t)row * DM);
        float amax = 0.f;
#pragma unroll
        for (int i = 0; i < 8; ++i) {
            const float4 s1 = s1v[i], s0 = s0v[i];
            const float y0 = v[i].x * rstd * s1.x + s0.x, y1 = v[i].y * rstd * s1.y + s0.y;
            const float y2 = v[i].z * rstd * s1.z + s0.z, y3 = v[i].w * rstd * s1.w + s0.w;
            uint2 o; o.x = pk2(y0, y1); o.y = pk2(y2, y3); hp[c.lane + 64 * i] = o;
            if (which) { v[i] = make_float4(y0, y1, y2, y3); amax = fmaxf(fmaxf(amax, fmaxf(fabsf(y0), fabsf(y1))), fmaxf(fabsf(y2), fabsf(y3))); }
        }
        if (which) {
            amax = fmaxf(amax, __shfl_xor(amax, 32)); amax = fmaxf(amax, __shfl_xor(amax, 16)); amax = fmaxf(amax, __shfl_xor(amax, 8));
            amax = fmaxf(amax, __shfl_xor(amax, 4)); amax = fmaxf(amax, __shfl_xor(amax, 2)); amax = fmaxf(amax, __shfl_xor(amax, 1));
            const float qs = amax > 0.f ? 127.0f / amax : 0.f;
            unsigned* qp = (unsigned*)(c.H8 + (size_t)row * DM);
#pragma unroll
            for (int i = 0; i < 8; ++i) {
                const int q0 = (int)rintf(v[i].x * qs), q1 = (int)rintf(v[i].y * qs), q2 = (int)rintf(v[i].z * qs), q3 = (int)rintf(v[i].w * qs);
                qp[c.lane + 64 * i] = (unsigned)(q0 & 0xFF) | ((unsigned)(q1 & 0xFF) << 8) | ((unsigned)(q2 & 0xFF) << 16) | ((unsigned)(q3 & 0xFF) << 24);
            }
            if (c.lane == 0) c.HSC[row] = amax * (1.0f / 127.0f);
        }
    }
}

struct EpiProj {
    static constexpr bool PERM = true, AFTER_DRAIN = false;
    u16* P; u16* T;
    __device__ __forceinline__ void operator()(const f32x4 (&acc)[2][2][4][2], const pg8::Unit& u, int wr, int wc, int fr, int fq) const {
        u16* base = u.w ? T : P; const int ldc = u.w ? MROWS : NMAIN;
        const int row0 = u.pm * 256 + wr * 64 + fr, col0 = u.pn * 256 + wc * 32 + 8 * fq;
#pragma unroll
        for (int ai = 0; ai < 2; ++ai)
#pragma unroll
            for (int m = 0; m < 4; ++m) { u16* rowp = base + (size_t)(row0 + ai * 128 + m * 16) * ldc + col0;
#pragma unroll
                for (int bj = 0; bj < 2; ++bj) { const f32x4 v0 = acc[ai][bj][m][0], v1 = acc[ai][bj][m][1];
                    u32x4 w; w.x = pk2(v0[0], v0[1]); w.y = pk2(v0[2], v0[3]); w.z = pk2(v1[0], v1[1]); w.w = pk2(v1[2], v1[3]);
                    *(u32x4*)(rowp + bj * 128) = w; } }
    }
};
struct EpiResid {
    static constexpr bool PERM = false, AFTER_DRAIN = false;
    u16* X; const float* modl; int row_off;
    __device__ __forceinline__ void operator()(const f32x4 (&acc)[2][2][4][2], const pg8::Unit& u, int wr, int wc, int fr, int fq) const {
        const int row0 = u.pm * 256 + wr * 64 + fr, col0 = u.pn * 256 + wc * 32 + 4 * fq;
        const int bi = row_bidx(u.pm * 256 + row_off);
        const float* gp = modl + ((size_t)bi * 6 + 2) * DM + col0;
        f32x4 gv[2][2];
#pragma unroll
        for (int bj = 0; bj < 2; ++bj)
#pragma unroll
            for (int n = 0; n < 2; ++n) gv[bj][n] = *(const f32x4*)(gp + bj * 128 + n * 16);
#pragma unroll
        for (int ai = 0; ai < 2; ++ai)
#pragma unroll
            for (int m = 0; m < 4; ++m) { u16* rowp = X + (size_t)(row0 + ai * 128 + m * 16) * DM + col0;
#pragma unroll
                for (int bj = 0; bj < 2; ++bj)
#pragma unroll
                    for (int n = 0; n < 2; ++n) { u32x2* p = (u32x2*)(rowp + bj * 128 + n * 16); const u32x2 xw = *p; const f32x4 r = (f32x4){bflo(xw.x), bfhi(xw.x), bflo(xw.y), bfhi(xw.y)} + gv[bj][n] * acc[ai][bj][m][n];
                        *p = (u32x2){pk2(r[0], r[1]), pk2(r[2], r[3])}; } }
    }
};
struct EpiGlu {
    static constexpr bool PERM = true, AFTER_DRAIN = false;
    const u16* Y; u16* O; const float* bias;
    __device__ __forceinline__ void operator()(const f32x4 (&acc)[2][2][4][2], const pg8::Unit& u, int wr, int wc, int fr, int fq) const {
        const int row0 = u.pm * 256 + wr * 64 + fr, col0 = u.pn * 256 + wc * 32 + 8 * fq;
        f32x4 bv[2][2];
#pragma unroll
        for (int bj = 0; bj < 2; ++bj)
#pragma unroll
            for (int n = 0; n < 2; ++n) bv[bj][n] = *(const f32x4*)(bias + col0 + bj * 128 + 4 * n);
#pragma unroll
        for (int ai = 0; ai < 2; ++ai)
#pragma unroll
            for (int m = 0; m < 4; ++m) { const size_t off = (size_t)(row0 + ai * 128 + m * 16) * 512 + col0;
#pragma unroll
                for (int bj = 0; bj < 2; ++bj) {
                    const u32x4 yv = *(const u32x4*)(Y + off + bj * 128);
                    const f32x4 v0 = acc[ai][bj][m][0] + bv[bj][0], v1 = acc[ai][bj][m][1] + bv[bj][1];
                    float y[8] = {bflo(yv.x), bfhi(yv.x), bflo(yv.y), bfhi(yv.y), bflo(yv.z), bfhi(yv.z), bflo(yv.w), bfhi(yv.w)};
                    float z[8] = {v0[0], v0[1], v0[2], v0[3], v1[0], v1[1], v1[2], v1[3]};
#pragma unroll
                    for (int j = 0; j < 8; ++j) y[j] = y[j] / (1.0f + __expf(-z[j]));
                    u32x4 w; w.x = pk2(y[0], y[1]); w.y = pk2(y[2], y[3]); w.z = pk2(y[4], y[5]); w.w = pk2(y[6], y[7]);
                    *(u32x4*)(O + off + bj * 128) = w; } }
    }
};

constexpr int AT_KC_STRIDE = 272, AT_VC_STRIDE = 528;
constexpr int AT_KC_OFF = 0, AT_VC_OFF = 256 * AT_KC_STRIDE, AT_BT_OFF = AT_VC_OFF + 128 * AT_VC_STRIDE, AT_END = AT_BT_OFF + 15 * 64 * 4;
static_assert(AT_END <= LDS_BARW, "attention LDS");
__device__ __forceinline__ void attn_block_load(const Ctx& c, int l, int b, int head) {
    const int tid = c.tid;
    __syncthreads();
    u32x4 tk[8], tv[8];
#pragma unroll
    for (int i = 0; i < 8; ++i) { const int e = tid + 512 * i, key = e >> 4, ch = e & 15; tk[i] = *(const u32x4*)(c.PROJ + (size_t)(NLAT + b * CTXL + key) * NMAIN + PJ_K + head * 128 + ch * 8); }
#pragma unroll
    for (int i = 0; i < 8; ++i) { const int e = tid + 512 * i, d = e >> 5, ch = e & 31; tv[i] = *(const u32x4*)(c.TR + (size_t)(TR_V + head * 128 + d) * MROWS + NLAT + b * CTXL + ch * 8); }
#pragma unroll
    for (int i = 0; i < 8; ++i) { const int e = tid + 512 * i, key = e >> 4, ch = e & 15; *(LAS u32x4*)(c.lds + AT_KC_OFF + key * AT_KC_STRIDE + ch * 16) = tk[i]; }
#pragma unroll
    for (int i = 0; i < 8; ++i) { const int e = tid + 512 * i, d = e >> 5, ch = e & 31; *(LAS u32x4*)(c.lds + AT_VC_OFF + d * AT_VC_STRIDE + ch * 16) = tv[i]; }
    LAS float* BT = (LAS float*)(c.lds + AT_BT_OFF);
    const float* src = c.in[I_RPB] + (size_t)(l * 8 + head) * 465;
    for (int i = tid; i < 15 * 64; i += 512) { const int col = (i & 63) - 16, row = i >> 6; BT[i] = (col >= 0 && col < 31) ? src[row * 31 + col] : 0.f; }
    __syncthreads();
}
template <bool WINDOW>
__device__ __forceinline__ void attn_segment(const Ctx& c, int b, int r, int head, int qt, int r_start, int cbase, const bf16x8 (&qf)[4], f32x4 (&O)[8], float& mrun, float& lrun) {
    const int lane = c.lane, n = lane & 15, lg = lane >> 4;
    f32x4 S[8][2];
    if (WINDOW) {
        const u16* kp0 = c.PROJ + (size_t)(b * SEQL + r_start * 64 + cbase + 8 * (n >> 2) + (n & 3)) * NMAIN + PJ_K + head * 128 + 8 * lg;
#pragma unroll
        for (int gi = 0; gi < 8; ++gi) {
            bf16x8 kf[2][4];
#pragma unroll
            for (int t = 0; t < 2; ++t)
#pragma unroll
                for (int kk = 0; kk < 4; ++kk) kf[t][kk] = *(const bf16x8*)(kp0 + (size_t)(gi * 64 + 4 * t) * NMAIN + 32 * kk);
            __builtin_amdgcn_sched_barrier(0);
#pragma unroll
            for (int t = 0; t < 2; ++t) {
                f32x4 acc = {0.f, 0.f, 0.f, 0.f};
#pragma unroll
                for (int kk = 0; kk < 4; ++kk) acc = __builtin_amdgcn_mfma_f32_16x16x32_bf16(kf[t][kk], qf[kk], acc, 0, 0, 0);
                S[gi][t] = acc;
            }
            __builtin_amdgcn_sched_barrier(0);
        }
    } else {
#pragma unroll
        for (int gi = 0; gi < 8; ++gi) {
#pragma unroll
            for (int t = 0; t < 2; ++t) {
                const int ko = 8 * (n >> 2) + 4 * t + (n & 3);
                f32x4 acc = {0.f, 0.f, 0.f, 0.f};
                const LAS unsigned char* kp = c.lds + AT_KC_OFF + (32 * gi + ko) * AT_KC_STRIDE + 16 * lg;
#pragma unroll
                for (int kk = 0; kk < 4; ++kk) { const bf16x8 a = *(const LAS bf16x8*)(kp + 64 * kk); acc = __builtin_amdgcn_mfma_f32_16x16x32_bf16(a, qf[kk], acc, 0, 0, 0); }
                S[gi][t] = acc;
            }
        }
    }
    const float scale = 0.08838834764831845f;
    float mx = -3.0e38f;
    const int qc = 16 * qt + n, cs = min(max(qc - 8, 0), 48);
    const LAS float* BT = (const LAS float*)(c.lds + AT_BT_OFF);
    const int btbase = WINDOW ? (r_start - r + 7) * 64 + (cbase + 8 * lg - qc + 15 + 16) : 0;
#pragma unroll
    for (int gi = 0; gi < 8; ++gi)
#pragma unroll
        for (int t = 0; t < 2; ++t)
#pragma unroll
            for (int rr = 0; rr < 4; ++rr) {
                float s = S[gi][t][rr] * scale;
                if (WINDOW) {
                    const int kc = cbase + 8 * lg + 4 * t + rr;
                    const bool valid = (kc >= cs) && (kc < cs + 16);
                    const float bias = BT[btbase + gi * 64 + 4 * t + rr];
                    s = valid ? s + bias : -INFINITY;
                }
                S[gi][t][rr] = s; mx = fmaxf(mx, s);
            }
    mx = fmaxf(mx, __shfl_xor(mx, 16)); mx = fmaxf(mx, __shfl_xor(mx, 32));
    const float mnew = fmaxf(mrun, mx), resc = exp2f((mrun - mnew) * 1.4426950408889634f);
    float sum = 0.f;
#pragma unroll
    for (int gi = 0; gi < 8; ++gi)
#pragma unroll
        for (int t = 0; t < 2; ++t)
#pragma unroll
            for (int rr = 0; rr < 4; ++rr) { const float p = exp2f((S[gi][t][rr] - mnew) * 1.4426950408889634f); S[gi][t][rr] = p; sum += p; }
    sum += __shfl_xor(sum, 16); sum += __shfl_xor(sum, 32);
    lrun = lrun * resc + sum; mrun = mnew;
#pragma unroll
    for (int dt = 0; dt < 8; ++dt) O[dt] *= resc;
    if (WINDOW) {
        const u16* vp0 = c.TR + (size_t)(TR_V + head * 128 + n) * MROWS + (b * SEQL + r_start * 64 + cbase) + 8 * lg;
#pragma unroll
        for (int gi = 0; gi < 8; ++gi) {
            u32x4 pw; pw.x = pk2(S[gi][0][0], S[gi][0][1]); pw.y = pk2(S[gi][0][2], S[gi][0][3]); pw.z = pk2(S[gi][1][0], S[gi][1][1]); pw.w = pk2(S[gi][1][2], S[gi][1][3]);
            const bf16x8 pb = __builtin_bit_cast(bf16x8, pw);
            bf16x8 vf[8];
#pragma unroll
            for (int dt = 0; dt < 8; ++dt) vf[dt] = *(const bf16x8*)(vp0 + (size_t)(16 * dt) * MROWS + gi * 64);
            __builtin_amdgcn_sched_barrier(0);
#pragma unroll
            for (int dt = 0; dt < 8; ++dt) O[dt] = __builtin_amdgcn_mfma_f32_16x16x32_bf16(vf[dt], pb, O[dt], 0, 0, 0);
            __builtin_amdgcn_sched_barrier(0);
        }
    } else {
#pragma unroll
        for (int gi = 0; gi < 8; ++gi) {
            u32x4 pw; pw.x = pk2(S[gi][0][0], S[gi][0][1]); pw.y = pk2(S[gi][0][2], S[gi][0][3]); pw.z = pk2(S[gi][1][0], S[gi][1][1]); pw.w = pk2(S[gi][1][2], S[gi][1][3]);
            const bf16x8 pb = __builtin_bit_cast(bf16x8, pw);
            const LAS unsigned char* vp = c.lds + AT_VC_OFF + n * AT_VC_STRIDE + (32 * gi + 8 * lg) * 2;
#pragma unroll
            for (int dt = 0; dt < 8; ++dt) { const bf16x8 va = *(const LAS bf16x8*)(vp + 16 * dt * AT_VC_STRIDE); O[dt] = __builtin_amdgcn_mfma_f32_16x16x32_bf16(va, pb, O[dt], 0, 0, 0); }
        }
    }
}
template <bool LOCAL>
__device__ __forceinline__ void attn_item(const Ctx& c, int b, int r, int head, int qt) {
    const int lane = c.lane, n = lane & 15, lg = lane >> 4;
    const int qrow0 = LOCAL ? (b * SEQL + r * 64 + 16 * qt) : (NLAT + b * CTXL + 16 * qt);
    const int r_start = LOCAL ? min(max(r - 4, 0), 56) : 0;
    const int cbase = LOCAL ? (qt == 0 ? 0 : (qt == 1 ? 8 : (qt == 2 ? 24 : 32))) : 0;
    bf16x8 qf[4];
    { const u16* qp = c.PROJ + (size_t)(qrow0 + n) * NMAIN + PJ_Q + head * 128 + 8 * lg;
#pragma unroll
      for (int kk = 0; kk < 4; ++kk) qf[kk] = *(const bf16x8*)(qp + 32 * kk); }
    f32x4 O[8];
#pragma unroll
    for (int dt = 0; dt < 8; ++dt) O[dt] = (f32x4){0.f, 0.f, 0.f, 0.f};
    float mrun = -3.0e38f, lrun = 0.f;
    attn_segment<false>(c, b, r, head, qt, r_start, cbase, qf, O, mrun, lrun);
    if (LOCAL) attn_segment<true>(c, b, r, head, qt, r_start, cbase, qf, O, mrun, lrun);
    const float inv = 1.0f / lrun;
    u16* op = c.ATT + (size_t)(qrow0 + n) * 1024 + head * 128 + 4 * lg;
#pragma unroll
    for (int dt = 0; dt < 8; ++dt) { uint2 o; o.x = pk2(O[dt][0] * inv, O[dt][1] * inv); o.y = pk2(O[dt][2] * inv, O[dt][3] * inv); *(uint2*)(op + 16 * dt) = o; }
}
__device__ __forceinline__ void phase_attention(const Ctx& c, int l, bool last) {
    for (int bh = c.bid; bh < 256; bh += c.G) {
        const int b = bh >> 6, head = (bh >> 3) & 7, sub = bh & 7;
        attn_block_load(c, l, b, head);
#pragma unroll 1
        for (int i = 0; i < 4; ++i) { const int item = c.wave + 8 * i; attn_item<true>(c, b, sub * 8 + (item >> 2), head, item & 3); }
        if (!last && c.wave < 2) attn_item<false>(c, b, 0, head, sub * 2 + c.wave);
    }
    __syncthreads();
}

__device__ __forceinline__ void sgu_item(const Ctx& c, int l, int chunk) {
    const int tid = c.tid, lane = c.lane, n = lane & 15, lg = lane >> 4;
    const int tok0 = chunk < 128 ? chunk * 128 : NLAT + (chunk - 128) * 128;
    LAS float* part = (LAS float*)c.lds;
    LAS float* rstd = part + 32 * 128;
    __syncthreads();
    {
        const int sg = tid & 15, cg = tid >> 4;
        float a[8];
#pragma unroll
        for (int j = 0; j < 8; ++j) a[j] = 0.f;
        u32x4 vv[16];
#pragma unroll
        for (int cc = 0; cc < 16; ++cc) vv[cc] = *(const u32x4*)(c.TR + (size_t)(TR_SV + cg * 16 + cc) * MROWS + tok0 + 8 * sg);
        __builtin_amdgcn_sched_barrier(0);
#pragma unroll
        for (int cc = 0; cc < 16; ++cc) {
            const u32x4 v = vv[cc];
            const float x[8] = {bflo(v.x), bfhi(v.x), bflo(v.y), bfhi(v.y), bflo(v.z), bfhi(v.z), bflo(v.w), bfhi(v.w)};
#pragma unroll
            for (int j = 0; j < 8; ++j) { const float g = gelu_f(x[j]); a[j] += g * g; }
        }
#pragma unroll
        for (int j = 0; j < 8; ++j) part[cg * 128 + 8 * sg + j] = a[j];
    }
    __syncthreads();
    if (tid < 128) { float s = 0.f; for (int cg = 0; cg < 32; ++cg) s += part[cg * 128 + tid]; rstd[tid] = rsqrtf(s * (1.0f / 512.0f) + EPSN); }
    __syncthreads();
    const int hs = c.wave >> 1, th = c.wave & 1;
    const u16* wsp = (const u16*)(c.wl(l) + WL_SGUW) + ((size_t)hs * 128) * 128;
    const float* gn = c.in[I_SGUN] + (size_t)l * 512 + hs * 128;
    const float* bsp = c.in[I_SGUB] + (size_t)(l * 4 + hs) * 128;
#pragma unroll 1
    for (int ch = 0; ch < 2; ++ch) {
        f32x4 acc[4][4];
#pragma unroll
        for (int mt = 0; mt < 4; ++mt)
#pragma unroll
            for (int ct = 0; ct < 4; ++ct) acc[mt][ct] = (f32x4){0.f, 0.f, 0.f, 0.f};
        float gcv[4];
#pragma unroll
        for (int ct = 0; ct < 4; ++ct) gcv[ct] = gn[64 * ch + 16 * ct + n];
        bf16x8 afN[4]; u32x4 vN[4];
#pragma unroll
        for (int mt = 0; mt < 4; ++mt) afN[mt] = *(const bf16x8*)(wsp + (size_t)(64 * th + 16 * mt + n) * 128 + 8 * lg);
#pragma unroll
        for (int ct = 0; ct < 4; ++ct) vN[ct] = *(const u32x4*)(c.TR + (size_t)(TR_SV + hs * 128 + 64 * ch + 16 * ct + n) * MROWS + tok0 + 8 * lg);
#pragma unroll 1
        for (int kk = 0; kk < 4; ++kk) {
            bf16x8 af[4]; u32x4 vq[4];
#pragma unroll
            for (int q = 0; q < 4; ++q) { af[q] = afN[q]; vq[q] = vN[q]; }
            { const int kn = kk < 3 ? kk + 1 : 3;
#pragma unroll
              for (int mt = 0; mt < 4; ++mt) afN[mt] = *(const bf16x8*)(wsp + (size_t)(64 * th + 16 * mt + n) * 128 + 32 * kn + 8 * lg);
#pragma unroll
              for (int ct = 0; ct < 4; ++ct) vN[ct] = *(const u32x4*)(c.TR + (size_t)(TR_SV + hs * 128 + 64 * ch + 16 * ct + n) * MROWS + tok0 + 32 * kn + 8 * lg); }
            __builtin_amdgcn_sched_barrier(0);
            const f32x4 r0 = *(const LAS f32x4*)(rstd + 32 * kk + 8 * lg), r1 = *(const LAS f32x4*)(rstd + 32 * kk + 8 * lg + 4);
#pragma unroll
            for (int ct = 0; ct < 4; ++ct) {
                const u32x4 v = vq[ct];
                const float gc = gcv[ct];
                const float x0 = gelu_f(bflo(v.x)) * r0[0] * gc, x1 = gelu_f(bfhi(v.x)) * r0[1] * gc, x2 = gelu_f(bflo(v.y)) * r0[2] * gc, x3 = gelu_f(bfhi(v.y)) * r0[3] * gc;
                const float x4 = gelu_f(bflo(v.z)) * r1[0] * gc, x5 = gelu_f(bfhi(v.z)) * r1[1] * gc, x6 = gelu_f(bflo(v.w)) * r1[2] * gc, x7 = gelu_f(bfhi(v.w)) * r1[3] * gc;
                u32x4 pw; pw.x = pk2(x0, x1); pw.y = pk2(x2, x3); pw.z = pk2(x4, x5); pw.w = pk2(x6, x7);
                const bf16x8 bfr = __builtin_bit_cast(bf16x8, pw);
#pragma unroll
                for (int mt = 0; mt < 4; ++mt) acc[mt][ct] = __builtin_amdgcn_mfma_f32_16x16x32_bf16(bfr, af[mt], acc[mt][ct], 0, 0, 0);
            }
        }
        float bsv[4]; u32x2 swv[4][4];
#pragma unroll
        for (int mt = 0; mt < 4; ++mt) {
            bsv[mt] = bsp[64 * th + 16 * mt + n];
#pragma unroll
            for (int ct = 0; ct < 4; ++ct) swv[mt][ct] = *(const u32x2*)(c.PROJ + (size_t)(tok0 + 64 * th + 16 * mt + n) * NMAIN + PJ_SU + hs * 128 + 64 * ch + 16 * ct + 4 * lg);
        }
        __builtin_amdgcn_sched_barrier(0);
#pragma unroll
        for (int mt = 0; mt < 4; ++mt) {
            const int t = 64 * th + 16 * mt + n; const float bs = bsv[mt];
            const size_t row = (size_t)(tok0 + t);
#pragma unroll
            for (int ct = 0; ct < 4; ++ct) {
                const int col = hs * 128 + 64 * ch + 16 * ct + 4 * lg;
                const u32x2 sw = swv[mt][ct];
                const f32x4 a = acc[mt][ct];
                *(u32x2*)(c.SGU + row * 512 + col) = (u32x2){pk2(gelu_f(bflo(sw.x)) * (a[0] + bs), gelu_f(bfhi(sw.x)) * (a[1] + bs)), pk2(gelu_f(bflo(sw.y)) * (a[2] + bs), gelu_f(bfhi(sw.y)) * (a[3] + bs))};
            }
        }
    }
}

__device__ __forceinline__ int s5_row(int dir, int b, int q) {
    if (dir == 0) return q < CTXL ? NLAT + b * CTXL + q : b * SEQL + (q - CTXL);
    return q < CTXL ? NLAT + b * CTXL + (CTXL - 1 - q) : b * SEQL + (SEQL - 1 - (q - CTXL));
}
__device__ __forceinline__ void s5_disc(const Ctx& c, int l, int dir, int grp, int p, float& lr, float& li, float (&bbr)[16], float (&bbi)[16]) {
    const size_t gp = ((size_t)(l * 2 + dir) * 32 + grp) * 64 + p;
    const float are = fminf(c.in[I_ARE][gp], -1e-4f), aim = c.in[I_AIM][gp];
    const float dt = expf(c.in[I_LOGDT][(size_t)(l * 2 + dir) * 32 + grp]);
    const float mag = expf(are * dt); float sn, cs; sincosf(aim * dt, &sn, &cs);
    lr = mag * cs; li = mag * sn;
    const float den = 1.0f / (are * are + aim * aim), nr = lr - 1.0f;
    const float cr = (nr * are + li * aim) * den, ci = (li * are - nr * aim) * den;
    const float* br = c.in[I_BRE] + gp * 16; const float* bi = c.in[I_BIM] + gp * 16;
#pragma unroll
    for (int q4 = 0; q4 < 4; ++q4) {
        const float4 a = *(const float4*)(br + 4 * q4), b = *(const float4*)(bi + 4 * q4);
        bbr[4 * q4 + 0] = cr * a.x - ci * b.x; bbi[4 * q4 + 0] = cr * b.x + ci * a.x;
        bbr[4 * q4 + 1] = cr * a.y - ci * b.y; bbi[4 * q4 + 1] = cr * b.y + ci * a.y;
        bbr[4 * q4 + 2] = cr * a.z - ci * b.z; bbi[4 * q4 + 2] = cr * b.z + ci * a.z;
        bbr[4 * q4 + 3] = cr * a.w - ci * b.w; bbi[4 * q4 + 3] = cr * b.w + ci * a.w;
    }
}
__device__ __forceinline__ void s5_load_u(const Ctx& c, LAS float* U, int row, int grp) {
    const u32x4* sp = (const u32x4*)(c.PROJ + (size_t)row * NMAIN + PJ_SIN + 16 * grp);
    const u32x4 a = sp[0], b = sp[1];
    LAS u32x4* up = (LAS u32x4*)(U + c.lane * 8);
    up[0] = a; up[1] = b;
    lds_fence();
}
__device__ __forceinline__ float s5_u(LAS const float* U, int tok, int ch) { const unsigned w = ((const LAS unsigned*)U)[tok * 8 + (ch >> 1)]; return (ch & 1) ? bfhi(w) : bflo(w); }
typedef float f2s __attribute__((ext_vector_type(2)));
typedef __bf16 bf2s __attribute__((ext_vector_type(2)));
__device__ __forceinline__ float dot2s(unsigned a, unsigned b, float c) { return __builtin_amdgcn_fdot2_f32_bf16(__builtin_bit_cast(bf2s, a), __builtin_bit_cast(bf2s, b), c, false); }
__device__ __forceinline__ void s5_drive4(LAS const float* U, int tok0, int dt, const unsigned (&pr)[8], const unsigned (&pi)[8], f2s (&d)[4]) {
    u32x4 u[4][2];
#pragma unroll
    for (int k = 0; k < 4; ++k) { const LAS u32x4* up = (const LAS u32x4*)(U + (tok0 + dt * k) * 8); u[k][0] = up[0]; u[k][1] = up[1]; }
    asm volatile("" ::: "memory");
#pragma unroll
    for (int k = 0; k < 4; ++k) {
        const unsigned w[8] = {u[k][0].x, u[k][0].y, u[k][0].z, u[k][0].w, u[k][1].x, u[k][1].y, u[k][1].z, u[k][1].w};
        float r0 = 0.f, r1 = 0.f, i0 = 0.f, i1 = 0.f;
#pragma unroll
        for (int q = 0; q < 4; ++q) { r0 = dot2s(pr[q], w[q], r0); r1 = dot2s(pr[4 + q], w[4 + q], r1); i0 = dot2s(pi[q], w[q], i0); i1 = dot2s(pi[4 + q], w[4 + q], i1); }
        d[k] = (f2s){r0 + r1, i0 + i1};
    }
}
constexpr int S5P1_X = 7;
__device__ __forceinline__ void phase_s5_pass1(const Ctx& c, int l) {
    const int gw = c.bid * 8 + c.wave, nw = c.G * 8;
    LAS float* U = (LAS float*)(c.lds + c.wave * 4096);
    const int nslot = nw >> 6;
    if (nslot < 1 || (gw >> 6) >= nslot) return;
    const int gd = gw & 63, grp = gd >> 1, dir = gd & 1, slot = gw >> 6;
    float lr, li, bbr[16], bbi[16];
    s5_disc(c, l, dir, grp, c.lane, lr, li, bbr, bbi);
    unsigned pr[8], pi[8];
#pragma unroll
    for (int k = 0; k < 8; ++k) { pr[k] = pk2(bbr[2 * k], bbr[2 * k + 1]); pi[k] = pk2(bbi[2 * k], bbi[2 * k + 1]); }
    int i0, i1;
    if (nslot == 32) { constexpr int X = S5P1_X, REM = 272 - 17 * X, Q = REM / 15, R = REM % 15;
        if (slot < 17) { i0 = X * slot; i1 = i0 + X; } else { const int f = slot - 17; i0 = 17 * X + f * Q + min(f, R); i1 = i0 + Q + (f < R ? 1 : 0); } }
    else { const int per = (NB * NCHK + nslot - 1) / nslot; i0 = min(slot * per, NB * NCHK); i1 = min(i0 + per, NB * NCHK); }
    if (i0 >= i1) return;
    u32x4 na, nb;
    { const u32x4* sp = (const u32x4*)(c.PROJ + (size_t)s5_row(dir, i0 / NCHK, 64 * (i0 % NCHK) + c.lane) * NMAIN + PJ_SIN + 16 * grp); na = sp[0]; nb = sp[1]; }
#pragma unroll 1
    for (int bn = i0; bn < i1; ++bn) {
        const u32x4 a = na, b = nb;
        { const int bq = min(bn + 1, NB * NCHK - 1);
          const u32x4* sp = (const u32x4*)(c.PROJ + (size_t)s5_row(dir, bq / NCHK, 64 * (bq % NCHK) + c.lane) * NMAIN + PJ_SIN + 16 * grp); na = sp[0]; nb = sp[1]; }
        lds_fence();
        { LAS u32x4* up = (LAS u32x4*)(U + c.lane * 8); up[0] = a; up[1] = b; }
        lds_fence();
        float hr = 0.f, hi = 0.f;
#pragma unroll 1
        for (int j = 0; j < 64; j += 4) {
            f2s d[4]; s5_drive4(U, j, 1, pr, pi, d);
#pragma unroll
            for (int k = 0; k < 4; ++k) { const float nr = lr * hr - li * hi + d[k].x, ni = lr * hi + li * hr + d[k].y; hr = nr; hi = ni; }
        }
        c.SLOC[((size_t)(((bn / NCHK) * 32 + grp) * 2 + dir) * NCHK + (bn % NCHK)) * 64 + c.lane] = (f32x2v){hr, hi};
    }
}
constexpr int S5_HS = 272;
template <int DIR, int HALF>
__device__ __forceinline__ void s5_half(LAS const float* U, LAS unsigned char* Hb, float lr, float li, const unsigned (&pr)[8], const unsigned (&pi)[8], float& hr, float& hi,
                                        const bf16x8 (&cf)[4], f32x4 (&acc)[4], int lane, int n, int lg) {
#pragma unroll 1
    for (int jj = 0; jj < 32; jj += 4) {
        const int j = 32 * HALF + jj, tok0 = DIR ? 63 - j : j;
        f2s d[4]; s5_drive4(U, tok0, DIR ? -1 : 1, pr, pi, d);
#pragma unroll
        for (int k = 0; k < 4; ++k) {
            const float nr = lr * hr - li * hi + d[k].x, ni = lr * hi + li * hr + d[k].y; hr = nr; hi = ni;
            const int tok = DIR ? tok0 - k : tok0 + k;
            *(LAS unsigned*)(Hb + (tok & 31) * S5_HS + 4 * lane) = pk2(hr, hi);
        }
    }
    lds_fence();
    constexpr int MTB = DIR ? (2 - 2 * HALF) : (2 * HALF);
#pragma unroll
    for (int mi = 0; mi < 2; ++mi)
#pragma unroll
        for (int kk = 0; kk < 4; ++kk) {
            const bf16x8 a = *(const LAS bf16x8*)(Hb + (16 * mi + n) * S5_HS + (32 * kk + 8 * lg) * 2);
            acc[MTB + mi] = __builtin_amdgcn_mfma_f32_16x16x32_bf16(a, cf[kk], acc[MTB + mi], 0, 0, 0);
        }
    lds_fence();
}
template <int DIR>
__device__ __forceinline__ void s5_pass3_dir(const Ctx& c, int l, bool last, int grp, int slot, int nslot, LAS float* U, LAS unsigned char* Hb, float* scratch) {
    const int lane = c.lane, n = lane & 15, lg = lane >> 4;
    float lr, li, bbr[16], bbi[16];
    s5_disc(c, l, DIR, grp, lane, lr, li, bbr, bbi);
    unsigned pr[8], pi[8];
#pragma unroll
    for (int k = 0; k < 8; ++k) { pr[k] = pk2(bbr[2 * k], bbr[2 * k + 1]); pi[k] = pk2(bbi[2 * k], bbi[2 * k + 1]); }
    bf16x8 cf[4];
    {
        const size_t cb = (((size_t)(l * 2 + DIR) * 32 + grp) * 16 + n) * 64;
#pragma unroll
        for (int kk = 0; kk < 4; ++kk) {
            const float4 re = *(const float4*)(c.in[I_CRE] + cb + 16 * kk + 4 * lg), im = *(const float4*)(c.in[I_CIM] + cb + 16 * kk + 4 * lg);
            u32x4 pw; pw.x = pk2(re.x, -im.x); pw.y = pk2(re.y, -im.y); pw.z = pk2(re.z, -im.z); pw.w = pk2(re.w, -im.w);
            cf[kk] = __builtin_bit_cast(bf16x8, pw);
        }
    }
    float tr = lr, ti = li;
#pragma unroll
    for (int s = 0; s < 6; ++s) { const float a = tr * tr - ti * ti, bq = 2.0f * tr * ti; tr = a; ti = bq; }
    const float dv = c.in[I_S5D][(size_t)l * 512 + 16 * grp + n];
    const int nitems = last ? NB * 64 : NB * NCHK;
#pragma unroll 1
    for (int idx = slot; idx < nitems; idx += nslot) {
        const int b = last ? (idx >> 6) : idx / NCHK, tc = last ? (idx & 63) : idx % NCHK;
        const int rowbase = tc < 64 ? b * SEQL + 64 * tc : NLAT + b * CTXL + 64 * (tc - 64);
        lds_fence();
        s5_load_u(c, U, rowbase + lane, grp);
        const int nchunk = tc < 64 ? (DIR == 0 ? 4 + tc : 4 + 63 - tc) : (DIR == 0 ? tc - 64 : 3 - (tc - 64));
        float hr = 0.f, hi = 0.f;
        {
            const f32x2v* sp = c.SLOC + ((size_t)((b * 32 + grp) * 2 + DIR) * NCHK) * 64 + lane;
#pragma unroll 1
            for (int m0 = 0; m0 < nchunk; m0 += 8) {
                f32x2v sv[8];
#pragma unroll
                for (int q = 0; q < 8; ++q) sv[q] = sp[(size_t)min(m0 + q, nchunk - 1) * 64];
#pragma unroll
                for (int q = 0; q < 8; ++q) if (m0 + q < nchunk) { const float nr = hr * tr - hi * ti + sv[q].x, ni = hr * ti + hi * tr + sv[q].y; hr = nr; hi = ni; }
            }
        }
        f32x4 acc[4];
#pragma unroll
        for (int i = 0; i < 4; ++i) acc[i] = (f32x4){0.f, 0.f, 0.f, 0.f};
        s5_half<DIR, 0>(U, Hb, lr, li, pr, pi, hr, hi, cf, acc, lane, n, lg);
        s5_half<DIR, 1>(U, Hb, lr, li, pr, pi, hr, hi, cf, acc, lane, n, lg);
        f32x4* sc = (f32x4*)(scratch + ((size_t)(grp * NB * NCHK + idx) * 64 + lane) * 16);
        if (DIR == 0) {
#pragma unroll
            for (int i = 0; i < 4; ++i) sc[i] = acc[i];
        } else {
#pragma unroll
            for (int mt = 0; mt < 4; ++mt) {
                const f32x4 p0 = sc[mt];
#pragma unroll
                for (int rr = 0; rr < 4; ++rr) {
                    const int tok = 16 * mt + 4 * lg + rr;
                    const float y = acc[mt][rr] + p0[rr] + dv * s5_u(U, tok, n);
                    c.S5Y[(size_t)(rowbase + tok) * 512 + 16 * grp + n] = f2bf(gelu_f(y));
                }
            }
        }
    }
}
__device__ __forceinline__ void phase_s5_pass3(const Ctx& c, int l, bool last) {
    const int gw = c.bid * 8 + c.wave, nw = c.G * 8;
    LAS float* U = (LAS float*)(c.lds + c.wave * 4096); LAS unsigned char* Hb = c.lds + 32768 + c.wave * (32 * S5_HS);
    const int nslot = nw >> 5;
    if (nslot < 1 || (gw >> 5) >= nslot) return;
    const int grp = gw & 31, slot = gw >> 5;
    float* scratch = (float*)c.PART;
    s5_pass3_dir<0>(c, l, last, grp, slot, nslot, U, Hb, scratch);
    asm volatile("s_waitcnt vmcnt(0)" ::: "memory");
    s5_pass3_dir<1>(c, l, last, grp, slot, nslot, U, Hb, scratch);
}

__device__ __forceinline__ void phase_merge(const Ctx& c, int l, int nrows) {
    const float* gn = c.in[I_ONORM] + (size_t)l * DM;
    const int lane = c.lane;
    int row = c.bid * 8 + c.wave;
    if (row >= nrows) return;
    u32x4 na0 = *(const u32x4*)(c.ATT + (size_t)row * 1024 + 8 * lane), na1 = *(const u32x4*)(c.ATT + (size_t)row * 1024 + 512 + 8 * lane);
    u32x4 ns0 = *(const u32x4*)(c.SGU + (size_t)row * 512 + 8 * lane), nz0 = *(const u32x4*)(c.S5O + (size_t)row * 512 + 8 * lane);
    f32x4 gv[8];
#pragma unroll
    for (int q = 0; q < 4; ++q) { gv[2 * q] = *(const f32x4*)(gn + 512 * q + 8 * lane); gv[2 * q + 1] = *(const f32x4*)(gn + 512 * q + 8 * lane + 4); }
    for (; row < nrows; row += c.G * 8) {
        const u32x4 a0 = na0, a1 = na1, s0 = ns0, z0 = nz0;
        { const size_t rn = (size_t)min(row + c.G * 8, nrows - 1);
          na0 = *(const u32x4*)(c.ATT + rn * 1024 + 8 * lane); na1 = *(const u32x4*)(c.ATT + rn * 1024 + 512 + 8 * lane);
          ns0 = *(const u32x4*)(c.SGU + rn * 512 + 8 * lane); nz0 = *(const u32x4*)(c.S5O + rn * 512 + 8 * lane); }
        float va[16] = {bflo(a0.x), bfhi(a0.x), bflo(a0.y), bfhi(a0.y), bflo(a0.z), bfhi(a0.z), bflo(a0.w), bfhi(a0.w), bflo(a1.x), bfhi(a1.x), bflo(a1.y), bfhi(a1.y), bflo(a1.z), bfhi(a1.z), bflo(a1.w), bfhi(a1.w)};
        float vs[8] = {bflo(s0.x), bfhi(s0.x), bflo(s0.y), bfhi(s0.y), bflo(s0.z), bfhi(s0.z), bflo(s0.w), bfhi(s0.w)};
        float vz[8] = {bflo(z0.x), bfhi(z0.x), bflo(z0.y), bfhi(z0.y), bflo(z0.z), bfhi(z0.z), bflo(z0.w), bfhi(z0.w)};
        float sa = 0.f, ss = 0.f, sz = 0.f;
#pragma unroll
        for (int j = 0; j < 16; ++j) sa += va[j] * va[j];
#pragma unroll
        for (int j = 0; j < 8; ++j) { ss += vs[j] * vs[j]; sz += vz[j] * vz[j]; }
        sa = wave_sum(sa); ss = wave_sum(ss); sz = wave_sum(sz);
        const float ra = rsqrtf(sa * (1.0f / 1024.0f) + EPSN), rs = rsqrtf(ss * (1.0f / 512.0f) + EPSN), rz = rsqrtf(sz * (1.0f / 512.0f) + EPSN);
        u16* yp = c.YIN + (size_t)row * DM;
        {   const float g[8] = {gv[0][0], gv[0][1], gv[0][2], gv[0][3], gv[1][0], gv[1][1], gv[1][2], gv[1][3]}; u32x4 o;
            o.x = pk2(va[0] * ra * g[0], va[1] * ra * g[1]); o.y = pk2(va[2] * ra * g[2], va[3] * ra * g[3]); o.z = pk2(va[4] * ra * g[4], va[5] * ra * g[5]); o.w = pk2(va[6] * ra * g[6], va[7] * ra * g[7]);
            *(u32x4*)(yp + 8 * lane) = o; }
        {   const float g[8] = {gv[2][0], gv[2][1], gv[2][2], gv[2][3], gv[3][0], gv[3][1], gv[3][2], gv[3][3]}; u32x4 o;
            o.x = pk2(va[8] * ra * g[0], va[9] * ra * g[1]); o.y = pk2(va[10] * ra * g[2], va[11] * ra * g[3]); o.z = pk2(va[12] * ra * g[4], va[13] * ra * g[5]); o.w = pk2(va[14] * ra * g[6], va[15] * ra * g[7]);
            *(u32x4*)(yp + 512 + 8 * lane) = o; }
        {   const float g[8] = {gv[4][0], gv[4][1], gv[4][2], gv[4][3], gv[5][0], gv[5][1], gv[5][2], gv[5][3]}; u32x4 o;
            o.x = pk2(vs[0] * rs * g[0], vs[1] * rs * g[1]); o.y = pk2(vs[2] * rs * g[2], vs[3] * rs * g[3]); o.z = pk2(vs[4] * rs * g[4], vs[5] * rs * g[5]); o.w = pk2(vs[6] * rs * g[6], vs[7] * rs * g[7]);
            *(u32x4*)(yp + 1024 + 8 * lane) = o; }
        {   const float g[8] = {gv[6][0], gv[6][1], gv[6][2], gv[6][3], gv[7][0], gv[7][1], gv[7][2], gv[7][3]}; u32x4 o;
            o.x = pk2(vz[0] * rz * g[0], vz[1] * rz * g[1]); o.y = pk2(vz[2] * rz * g[2], vz[3] * rz * g[3]); o.z = pk2(vz[4] * rz * g[4], vz[5] * rz * g[5]); o.w = pk2(vz[6] * rz * g[6], vz[7] * rz * g[7]);
            *(u32x4*)(yp + 1536 + 8 * lane) = o; }
    }
}

__device__ __forceinline__ unsigned ord_f(float f) { const unsigned u = __float_as_uint(f); return (u & 0x80000000u) ? ~u : (u | 0x80000000u); }
__device__ __forceinline__ float unord_f(unsigned k) { return __uint_as_float((k & 0x80000000u) ? (k ^ 0x80000000u) : ~k); }
#define INS16(r, x_) do { unsigned _x = (x_); _Pragma("unroll") for (int _j = 0; _j < 16; ++_j) { const unsigned _t = max(r[_j], _x); _x = min(r[_j], _x); r[_j] = _t; } } while (0)

#define CE_DESC(a_, b_) do { const unsigned hi_ = max((a_), (b_)), lo_ = min((a_), (b_)); (a_) = hi_; (b_) = lo_; } while (0)
template <int N> __device__ __forceinline__ void bitonic_sort_desc(unsigned (&v)[N]) {
#pragma unroll
    for (int k = 2; k <= N; k <<= 1)
#pragma unroll
        for (int j = k >> 1; j > 0; j >>= 1)
#pragma unroll
            for (int i = 0; i < N; ++i) { const int l = i ^ j; if (l > i) { if ((i & k) == 0) CE_DESC(v[i], v[l]); else CE_DESC(v[l], v[i]); } }
}
__device__ __forceinline__ void merge_top16(unsigned (&a)[16], const unsigned (&b)[16]) {
#pragma unroll
    for (int i = 0; i < 16; ++i) a[i] = max(a[i], b[15 - i]);
#pragma unroll
    for (int j = 8; j > 0; j >>= 1)
#pragma unroll
        for (int i = 0; i < 16; ++i) { const int l = i ^ j; if (l > i) CE_DESC(a[i], a[l]); }
}
__device__ __forceinline__ void top16_of_64(unsigned (&g0)[16], unsigned (&g1)[16], unsigned (&g2)[16], unsigned (&g3)[16]) {
    bitonic_sort_desc<16>(g0); bitonic_sort_desc<16>(g1); bitonic_sort_desc<16>(g2); bitonic_sort_desc<16>(g3);
    merge_top16(g0, g1); merge_top16(g2, g3); merge_top16(g0, g2);
}
constexpr int TKW_STRIDE = 132, TKW_BYTES = 32 * TKW_STRIDE * 4;
static_assert(8 * TKW_BYTES <= LDS_BARW, "topk LDS");

__device__ __forceinline__ void topk_wave_item(const Ctx& c, int l, int tile32, int head) {
    const int lane = c.lane, n = lane & 15, lg = lane >> 4, tk = lane & 31, hf = lane >> 5;
    const int tok0 = tile32 * 32;
    LAS unsigned* SC = (LAS unsigned*)(c.lds + c.wave * TKW_BYTES);
    unsigned top[2][16];
#pragma unroll
    for (int list = 0; list < 2; ++list) {
        bf16x8 af[2][4];
#pragma unroll
        for (int mt = 0; mt < 2; ++mt)
#pragma unroll
            for (int kk = 0; kk < 4; ++kk) af[mt][kk] = *(const bf16x8*)(c.PQ + (size_t)(tok0 + 16 * mt + n) * DM + head * 256 + list * 128 + 32 * kk + 8 * lg);
        const u16* kb = (const u16*)(c.wl(l) + WL_K12) + ((size_t)(list * 8 + head) * 128) * 128;
        lds_fence();
        bf16x8 bk[4];
#pragma unroll
        for (int kk = 0; kk < 4; ++kk) bk[kk] = *(const bf16x8*)(kb + (size_t)n * 128 + 32 * kk + 8 * lg);
#pragma unroll
        for (int nt = 0; nt < 8; ++nt) {
            bf16x8 bn[4];
            if (nt < 7) {
#pragma unroll
                for (int kk = 0; kk < 4; ++kk) bn[kk] = *(const bf16x8*)(kb + (size_t)(16 * (nt + 1) + n) * 128 + 32 * kk + 8 * lg);
            }
            __builtin_amdgcn_sched_barrier(0);
#pragma unroll
            for (int mt = 0; mt < 2; ++mt) {
                f32x4 acc = {0.f, 0.f, 0.f, 0.f};
#pragma unroll
                for (int kk = 0; kk < 4; ++kk) acc = __builtin_amdgcn_mfma_f32_16x16x32_bf16(af[mt][kk], bk[kk], acc, 0, 0, 0);
                const unsigned ki = (unsigned)(16 * nt + n);
#pragma unroll
                for (int rr = 0; rr < 4; ++rr) SC[(16 * mt + 4 * lg + rr) * TKW_STRIDE + ki] = (ord_f(acc[rr]) & ~0x7Fu) | (127u - ki);
            }
            __builtin_amdgcn_sched_barrier(0);
            if (nt < 7) {
#pragma unroll
                for (int kk = 0; kk < 4; ++kk) bk[kk] = bn[kk];
            }
        }
        lds_fence();
        unsigned r[16], g1[16], g2[16], g3[16];
        const LAS u32x4* sp = (const LAS u32x4*)(SC + tk * TKW_STRIDE + 64 * hf);
#pragma unroll
        for (int i = 0; i < 4; ++i) { const u32x4 a = sp[i], b = sp[4 + i], c2 = sp[8 + i], d = sp[12 + i];
            r[4 * i] = a.x; r[4 * i + 1] = a.y; r[4 * i + 2] = a.z; r[4 * i + 3] = a.w; g1[4 * i] = b.x; g1[4 * i + 1] = b.y; g1[4 * i + 2] = b.z; g1[4 * i + 3] = b.w;
            g2[4 * i] = c2.x; g2[4 * i + 1] = c2.y; g2[4 * i + 2] = c2.z; g2[4 * i + 3] = c2.w; g3[4 * i] = d.x; g3[4 * i + 1] = d.y; g3[4 * i + 2] = d.z; g3[4 * i + 3] = d.w; }
        top16_of_64(r, g1, g2, g3);
        unsigned o[16];
#pragma unroll
        for (int j = 0; j < 16; ++j) o[j] = (unsigned)__shfl_xor((int)r[j], 32);
        merge_top16(r, o);
#pragma unroll
        for (int j = 0; j < 16; ++j) top[list][j] = r[j];
    }
    float v1[16], v2[16];
#pragma unroll
    for (int j = 0; j < 16; ++j) { v1[j] = unord_f(top[0][j] & ~0x7Fu); v2[j] = unord_f(top[1][j] & ~0x7Fu); }
    unsigned r[16], q1[16], q2[16], q3[16];
    {
        unsigned cand[64]; int nc = 0;
#pragma unroll
        for (int a = 0; a < 16; ++a)
#pragma unroll
            for (int b = 0; b < 16; ++b)
                if ((a + 1) * (b + 1) <= 16) { cand[nc] = (ord_f(v1[a] + v2[b]) & ~0xFFu) | (unsigned)(255 - (a * 16 + b)); ++nc; }
#pragma unroll
        for (int i = 50; i < 64; ++i) cand[i] = 0u;
#pragma unroll
        for (int i = 0; i < 16; ++i) { r[i] = cand[i]; q1[i] = cand[16 + i]; q2[i] = cand[32 + i]; q3[i] = cand[48 + i]; }
    }
    top16_of_64(r, q1, q2, q3);
    if (hf == 0) {
#pragma unroll
        for (int j = 0; j < 16; ++j) { SC[tk * TKW_STRIDE + j] = top[0][j]; SC[tk * TKW_STRIDE + 16 + j] = top[1][j]; }
    }
    lds_fence();
    float s[16], sum = 0.f;
    const float mx = unord_f(r[0] & ~0xFFu);
#pragma unroll
    for (int k = 0; k < 16; ++k) { s[k] = __expf(unord_f(r[k] & ~0xFFu) - mx); sum += s[k]; }
    const float inv = 1.0f / sum;
    unsigned ev[16];
#pragma unroll
    for (int k = 0; k < 16; ++k) {
        const int flat = 255 - (int)(r[k] & 0xFFu), a = flat >> 4, b = flat & 15;
        const int i1 = 127 - (int)(SC[tk * TKW_STRIDE + a] & 0x7Fu), i2 = 127 - (int)(SC[tk * TKW_STRIDE + 16 + b] & 0x7Fu);
        ev[k] = (unsigned)(i1 * 128 + i2);
    }
    if (hf == 0) {
        const size_t o = (size_t)(tok0 + tk) * 128 + head * 16;
        u32x4* ep = (u32x4*)(c.ET + o);
        ep[0] = (u32x4){ev[0] | (ev[1] << 16), ev[2] | (ev[3] << 16), ev[4] | (ev[5] << 16), ev[6] | (ev[7] << 16)};
        ep[1] = (u32x4){ev[8] | (ev[9] << 16), ev[10] | (ev[11] << 16), ev[12] | (ev[13] << 16), ev[14] | (ev[15] << 16)};
        f32x4* gp = (f32x4*)(c.GT + o);
        gp[0] = (f32x4){s[0] * inv, s[1] * inv, s[2] * inv, s[3] * inv}; gp[1] = (f32x4){s[4] * inv, s[5] * inv, s[6] * inv, s[7] * inv};
        gp[2] = (f32x4){s[8] * inv, s[9] * inv, s[10] * inv, s[11] * inv}; gp[3] = (f32x4){s[12] * inv, s[13] * inv, s[14] * inv, s[15] * inv};
    }
    lds_fence();
}

#define CFENCE() asm volatile("" ::: "memory")
typedef float f2 __attribute__((ext_vector_type(2)));
__device__ __forceinline__ float dpp_xor1(float v) { return __builtin_bit_cast(float, __builtin_amdgcn_update_dpp(0, __builtin_bit_cast(int, v), 0xB1, 0xF, 0xF, true)); }
__device__ __forceinline__ float dpp_xor2(float v) { return __builtin_bit_cast(float, __builtin_amdgcn_update_dpp(0, __builtin_bit_cast(int, v), 0x4E, 0xF, 0xF, true)); }

typedef __bf16 bf2v __attribute__((ext_vector_type(2)));
#define FP4_DOT(a_, w_, h_, o_) do { a_ += (h_)[(o_) + 0] * __builtin_amdgcn_cvt_scalef32_pk_f32_fp4((w_), 1.0f, 0); a_ += (h_)[(o_) + 1] * __builtin_amdgcn_cvt_scalef32_pk_f32_fp4((w_), 1.0f, 1); \
    a_ += (h_)[(o_) + 2] * __builtin_amdgcn_cvt_scalef32_pk_f32_fp4((w_), 1.0f, 2); a_ += (h_)[(o_) + 3] * __builtin_amdgcn_cvt_scalef32_pk_f32_fp4((w_), 1.0f, 3); } while (0)
#define PEER_E(ew_, i_) (((i_) & 1) ? ((ew_)[(i_) >> 1] >> 16) : ((ew_)[(i_) >> 1] & 0xFFFFu))

#define I4_DOT(a_, w_, h_, o_) do { a_ = __builtin_amdgcn_sdot4((int)((w_) & 0x0F0F0F0Fu), (int)(h_)[(o_)], a_, false); a_ = __builtin_amdgcn_sdot4((int)(((w_) >> 4) & 0x0F0F0F0Fu), (int)(h_)[(o_) + 1], a_, false); } while (0)
__device__ __forceinline__ void phase_peer_u(const Ctx& c, int l, int nrows) {
    const int lane = c.lane, g = lane >> 3, j = lane & 7;
    const int tstep = c.xn * 8;
    for (int s = c.xi; s < PEER_NSL; s += c.nx) {
        const unsigned char* ub = c.wl(l) + WL_U + PEER_SLB * s + 16 * j;
        const unsigned char* hs = c.H8 + 256 * s + 32 * j;
        u16* part = c.PART + (size_t)s * PAIRS_MAX;
        int t = c.xr * 8 + c.wave;
        if (t >= nrows) continue;
        u32x4 ea, eb, segN[16], hN[2]; float scN;
        { const u32x4* ep = (const u32x4*)(c.ET + (size_t)t * 128 + 16 * g); ea = ep[0]; eb = ep[1]; }
        { const unsigned ew[8] = {ea.x, ea.y, ea.z, ea.w, eb.x, eb.y, eb.z, eb.w};
#pragma unroll
          for (int i = 0; i < 16; ++i) segN[i] = *(const u32x4*)(ub + (size_t)PEER_E(ew, i) * PEER_ROWB);
          const u32x4* hp = (const u32x4*)(hs + (size_t)t * DM); hN[0] = hp[0]; hN[1] = hp[1]; scN = c.HSC[t]; }
        { const u32x4* ep = (const u32x4*)(c.ET + (size_t)min(t + tstep, nrows - 1) * 128 + 16 * g); ea = ep[0]; eb = ep[1]; }
#pragma unroll 1
        for (; t < nrows; t += tstep) {
            u32x4 seg[16];
#pragma unroll
            for (int i = 0; i < 16; ++i) seg[i] = segN[i];
            const unsigned hv[8] = {hN[0].x, hN[0].y, hN[0].z, hN[0].w, hN[1].x, hN[1].y, hN[1].z, hN[1].w};
            const float hsc = scN;
            {
                const int tn = min(t + tstep, nrows - 1);
                const unsigned ew[8] = {ea.x, ea.y, ea.z, ea.w, eb.x, eb.y, eb.z, eb.w};
#pragma unroll
                for (int i = 0; i < 16; ++i) segN[i] = *(const u32x4*)(ub + (size_t)PEER_E(ew, i) * PEER_ROWB);
                const u32x4* hp = (const u32x4*)(hs + (size_t)tn * DM); hN[0] = hp[0]; hN[1] = hp[1]; scN = c.HSC[tn];
                const u32x4* ep = (const u32x4*)(c.ET + (size_t)min(t + 2 * tstep, nrows - 1) * 128 + 16 * g); ea = ep[0]; eb = ep[1];
            }
            int hsum = 0;
#pragma unroll
            for (int q = 0; q < 8; ++q) hsum = __builtin_amdgcn_sdot4((int)hv[q], 0x01010101, hsum, false);
            const float fs = hsc;
            float acc[16];
#pragma unroll
            for (int i = 0; i < 16; ++i) {
                int a = 0, b = 0;
                I4_DOT(a, seg[i].x, hv, 0); I4_DOT(b, seg[i].y, hv, 2); I4_DOT(a, seg[i].z, hv, 4); I4_DOT(b, seg[i].w, hv, 6);
                acc[i] = (float)(a + b - 8 * hsum) * fs;
            }
            float r8[8], r4[4], r2[2];
            { const bool hi = (j & 4) != 0;
#pragma unroll
              for (int m = 0; m < 8; ++m) { const float keep = hi ? acc[8 + m] : acc[m], send = hi ? acc[m] : acc[8 + m]; r8[m] = keep + __shfl_xor(send, 4); } }
            { const bool hi = (j & 2) != 0;
#pragma unroll
              for (int m = 0; m < 4; ++m) { const float keep = hi ? r8[4 + m] : r8[m], send = hi ? r8[m] : r8[4 + m]; r4[m] = keep + dpp_xor2(send); } }
            { const bool hi = (j & 1) != 0;
#pragma unroll
              for (int m = 0; m < 2; ++m) { const float keep = hi ? r4[2 + m] : r4[m], send = hi ? r4[m] : r4[2 + m]; r2[m] = keep + dpp_xor1(send); } }
            *(unsigned*)(part + (size_t)t * 128 + 2 * lane) = pk2(r2[0], r2[1]);
        }
    }
}

__device__ __forceinline__ void phase_peer_reduce(const Ctx& c, int nrows) {
    const size_t n8 = (size_t)nrows * 128 / 8;
    for (size_t i = (size_t)c.bid * 512 + c.tid; i < n8; i += (size_t)c.G * 512) {
        float s[8];
#pragma unroll
        for (int q = 0; q < 8; ++q) s[q] = 0.f;
#pragma unroll
        for (int sl = 0; sl < PEER_NSL; ++sl) {
            const u32x4 v = *(const u32x4*)(c.PART + (size_t)sl * PAIRS_MAX + 8 * i);
            s[0] += bflo(v.x); s[1] += bfhi(v.x); s[2] += bflo(v.y); s[3] += bfhi(v.y); s[4] += bflo(v.z); s[5] += bfhi(v.z); s[6] += bflo(v.w); s[7] += bfhi(v.w);
        }
        const f32x4 g0 = *(const f32x4*)(c.GT + 8 * i), g1 = *(const f32x4*)(c.GT + 8 * i + 4);
        const float is = 1.0f / USCALE;
        u32x4 o;
        o.x = pk2(g0[0] * gelu_f(s[0] * is), g0[1] * gelu_f(s[1] * is)); o.y = pk2(g0[2] * gelu_f(s[2] * is), g0[3] * gelu_f(s[3] * is));
        o.z = pk2(g1[0] * gelu_f(s[4] * is), g1[1] * gelu_f(s[5] * is)); o.w = pk2(g1[2] * gelu_f(s[6] * is), g1[3] * gelu_f(s[7] * is));
        *(u32x4*)(c.WT + 8 * i) = o;
    }
}

#define FP4_AXPY(o_, w2_, w_, b_) do { (o_)[(b_) + 0] += (w2_) * __builtin_amdgcn_cvt_scalef32_pk_f32_fp4((w_), 1.0f, 0); (o_)[(b_) + 1] += (w2_) * __builtin_amdgcn_cvt_scalef32_pk_f32_fp4((w_), 1.0f, 1); \
    (o_)[(b_) + 2] += (w2_) * __builtin_amdgcn_cvt_scalef32_pk_f32_fp4((w_), 1.0f, 2); (o_)[(b_) + 3] += (w2_) * __builtin_amdgcn_cvt_scalef32_pk_f32_fp4((w_), 1.0f, 3); } while (0)
__device__ __forceinline__ f2 shfl2(f2 v, int m) { return (f2){__shfl_xor(v.x, m), __shfl_xor(v.y, m)}; }
__device__ __forceinline__ void phase_peer_v(const Ctx& c, int l, int nrows, u16* xdst) {
    const int lane = c.lane, g = lane >> 3, j = lane & 7;
    const int tstep = c.xn * 8;
    for (int s = c.xi; s < PEER_NSL; s += c.nx) {
        const unsigned char* vb = c.wl(l) + WL_V + PEER_SLB * s + 16 * j;
        int t = c.xr * 8 + c.wave;
        if (t >= nrows) continue;
        u32x4 ea, eb, segN[16], wN[2];
        { const u32x4* ep = (const u32x4*)(c.ET + (size_t)t * 128 + 16 * g); ea = ep[0]; eb = ep[1]; }
        { const unsigned ew[8] = {ea.x, ea.y, ea.z, ea.w, eb.x, eb.y, eb.z, eb.w};
#pragma unroll
          for (int i = 0; i < 16; ++i) segN[i] = *(const u32x4*)(vb + (size_t)PEER_E(ew, i) * PEER_ROWB);
          const u32x4* wp = (const u32x4*)(c.WT + (size_t)t * 128 + 16 * g); wN[0] = wp[0]; wN[1] = wp[1]; }
        { const u32x4* ep = (const u32x4*)(c.ET + (size_t)min(t + tstep, nrows - 1) * 128 + 16 * g); ea = ep[0]; eb = ep[1]; }
#pragma unroll 1
        for (; t < nrows; t += tstep) {
            u32x4 seg[16];
#pragma unroll
            for (int i = 0; i < 16; ++i) seg[i] = segN[i];
            const unsigned ww[8] = {wN[0].x, wN[0].y, wN[0].z, wN[0].w, wN[1].x, wN[1].y, wN[1].z, wN[1].w};
            const int col = 256 * s + 32 * j + 4 * g;
            const f32x4 q = *(const f32x4*)(c.MOD + ((size_t)(l * 5 + row_bidx(t)) * 6 + 5) * DM + col); const u32x2 xw = *(const u32x2*)(c.X + (size_t)t * DM + col);
            {
                const int tn = min(t + tstep, nrows - 1);
                const unsigned ew[8] = {ea.x, ea.y, ea.z, ea.w, eb.x, eb.y, eb.z, eb.w};
#pragma unroll
                for (int i = 0; i < 16; ++i) segN[i] = *(const u32x4*)(vb + (size_t)PEER_E(ew, i) * PEER_ROWB);
                const u32x4* wp = (const u32x4*)(c.WT + (size_t)tn * 128 + 16 * g); wN[0] = wp[0]; wN[1] = wp[1];
                const u32x4* ep = (const u32x4*)(c.ET + (size_t)min(t + 2 * tstep, nrows - 1) * 128 + 16 * g); ea = ep[0]; eb = ep[1];
            }
            f2 o[16];
#pragma unroll
            for (int q = 0; q < 16; ++q) o[q] = (f2){0.f, 0.f};
#pragma unroll
            for (int i = 0; i < 16; ++i) {
                const float w = (i & 1) ? bfhi(ww[i >> 1]) : bflo(ww[i >> 1]);
                const f2 w2 = {w, w};
                FP4_AXPY(o, w2, seg[i].x, 0); FP4_AXPY(o, w2, seg[i].y, 4); FP4_AXPY(o, w2, seg[i].z, 8); FP4_AXPY(o, w2, seg[i].w, 12);
            }
            f2 r8[8], r4[4], r2[2];
#pragma unroll
            for (int m = 0; m < 8; ++m) {
                const u32x2 sx = __builtin_amdgcn_permlane32_swap(__float_as_uint(o[m].x), __float_as_uint(o[8 + m].x), false, false);
                const u32x2 sy = __builtin_amdgcn_permlane32_swap(__float_as_uint(o[m].y), __float_as_uint(o[8 + m].y), false, false);
                r8[m] = (f2){__uint_as_float(sx.x) + __uint_as_float(sx.y), __uint_as_float(sy.x) + __uint_as_float(sy.y)};
            }
#pragma unroll
            for (int m = 0; m < 4; ++m) {
                const u32x2 sx = __builtin_amdgcn_permlane16_swap(__float_as_uint(r8[m].x), __float_as_uint(r8[4 + m].x), false, false);
                const u32x2 sy = __builtin_amdgcn_permlane16_swap(__float_as_uint(r8[m].y), __float_as_uint(r8[4 + m].y), false, false);
                r4[m] = (f2){__uint_as_float(sx.x) + __uint_as_float(sx.y), __uint_as_float(sy.x) + __uint_as_float(sy.y)};
            }
            { const bool hi = (g & 1) != 0;
#pragma unroll
              for (int m = 0; m < 2; ++m) { const f2 keep = hi ? r4[2 + m] : r4[m], send = hi ? r4[m] : r4[2 + m];
                  r2[m] = keep + shfl2(send, 8); } }
            const float is = 1.0f / VSCALE;
            *(u32x2*)(xdst + (size_t)t * DM + col) = (u32x2){pk2(bflo(xw.x) + q[0] * r2[0].x * is, bfhi(xw.x) + q[1] * r2[0].y * is), pk2(bflo(xw.y) + q[2] * r2[1].x * is, bfhi(xw.y) + q[3] * r2[1].y * is)};
        }
    }
}

__device__ __forceinline__ void phase_final(const Ctx& c) {
    const float* gain = c.in[I_FNORM];
    int row = c.bid * 8 + c.wave;
    if (row >= NLAT) return;
    float4 g[8];
#pragma unroll
    for (int i = 0; i < 8; ++i) g[i] = *(const float4*)(gain + 4 * (c.lane + 64 * i));
    u32x2 xn[8];
    { const u32x2* xp = (const u32x2*)(c.X + (size_t)row * DM);
#pragma unroll
      for (int i = 0; i < 8; ++i) xn[i] = xp[c.lane + 64 * i]; }
    for (; row < NLAT; row += c.G * 8) {
        float4 v[8]; float ss = 0.f;
#pragma unroll
        for (int i = 0; i < 8; ++i) { const u32x2 xw = xn[i]; v[i] = make_float4(bflo(xw.x), bfhi(xw.x), bflo(xw.y), bfhi(xw.y)); ss += v[i].x * v[i].x + v[i].y * v[i].y + v[i].z * v[i].z + v[i].w * v[i].w; }
        { const u32x2* xp = (const u32x2*)(c.X + (size_t)min(row + c.G * 8, NLAT - 1) * DM);
#pragma unroll
          for (int i = 0; i < 8; ++i) xn[i] = xp[c.lane + 64 * i]; }
        ss = wave_sum(ss);
        const float rstd = rsqrtf(ss * (1.0f / DM) + EPSN);
        float4* op = (float4*)(c.out + (size_t)row * DM);
#pragma unroll
        for (int i = 0; i < 8; ++i)
            op[c.lane + 64 * i] = make_float4(v[i].x * rstd * g[i].x, v[i].y * rstd * g[i].y, v[i].z * rstd * g[i].z, v[i].w * rstd * g[i].w);
    }
}

constexpr int PH_PRO = 0, PH_MODFIN = 1, PH_NORM0 = 2, PH_L0 = 3, PH_PER_LAYER = 13, N_PHASES = PH_L0 + DEPTH * PH_PER_LAYER;

__global__ void __launch_bounds__(512, 2) fwd_kernel(Args args) {
    extern __shared__ __attribute__((aligned(16))) unsigned char lds_raw[];
    Ctx c;
#pragma unroll
    for (int i = 0; i < N_IN; ++i) c.in[i] = args.in[i];
    c.out = args.out; c.ws = args.ws; c.lds = (LAS unsigned char*)lds_raw;
    c.tid = threadIdx.x; c.lane = c.tid & 63; c.wave = __builtin_amdgcn_readfirstlane(c.tid >> 6); c.G = gridDim.x; c.bid = blockIdx.x;
    unsigned char* ws = args.ws;
    c.MOD = (float*)(ws + WS_MOD); c.MODP = (float*)(ws + WS_MODP); c.X = (u16*)(ws + WS_X); c.H = (u16*)(ws + WS_H); c.PROJ = (u16*)(ws + WS_PROJ); c.TR = (u16*)(ws + WS_TR);
    c.ATT = (u16*)(ws + WS_ATT); c.SGU = (u16*)(ws + WS_SGU); c.S5Y = (u16*)(ws + WS_S5Y); c.S5O = (u16*)(ws + WS_S5O); c.YIN = (u16*)(ws + WS_YIN); c.PQ = (u16*)(ws + WS_PQ);
    c.ET = (u16*)(ws + WS_ET); c.GT = (float*)(ws + WS_GT); c.PART = (u16*)(ws + WS_PART); c.WT = (u16*)(ws + WS_WT); c.H8 = ws + WS_H8; c.HSC = (float*)(ws + WS_HSC);
    c.xi = c.bid % 8; c.nx = 8; c.xr = c.bid / 8; c.xn = (c.G + 7) / 8; c.SLOC = (f32x2v*)(ws + WS_SLOC);

    const int lo = args.ph_lo, hi = args.ph_hi;
    XcdBarrier bar; bar.bar = (unsigned*)(ws + WS_BAR); bar.x = 0; bar.st = (volatile LAS unsigned*)(c.lds + LDS_BARW);
    if (hi - lo > 1) {
        if (c.tid == 0) { bar.st[0] = 0u; bar.st[1] = 0u; }
        __syncthreads();
        bar = xcd_barrier_post((unsigned*)(ws + WS_BAR), (volatile LAS unsigned*)(c.lds + LDS_BARW));
    }
#ifndef PHASE_MASK
#define PHASE_MASK 0xFFFFFF
#endif
#define EN(i) ((PHASE_MASK >> (i)) & 1)
#ifndef PROBE_MASK
#define PROBE_MASK 0
#endif
#define NREP(i) (((PROBE_MASK >> (i)) & 1) ? 2 : 1)
#ifndef USE_CENSUS
#define USE_CENSUS 1
#endif
#define IN_PH(k) (lo <= (k) && (k) < hi)
#define SEAM(k) do { if (IN_PH((k) + 1)) { xcd_barrier(bar); if (NREP(22) == 2) xcd_barrier(bar); } } while (0)

    if (EN(0) && IN_PH(PH_PRO)) { for (int rep = 0; rep < NREP(0); ++rep) phase_prologue(c); SEAM(PH_PRO); }
    if (USE_CENSUS && hi - lo > 1 && lo == 0) {
        volatile LAS unsigned* st = (volatile LAS unsigned*)(c.lds + LDS_BARW);
        if (c.tid == 0) {
            unsigned below = 0, pop = 0, mine = 1;
#pragma unroll
            for (unsigned jx = 0; jx < 16; ++jx) { const unsigned cn = xb_ld((unsigned*)(ws + WS_BAR) + XB_XCNT(jx)); pop += cn ? 1u : 0u; below += (cn && jx < bar.x) ? 1u : 0u; mine = (jx == bar.x) ? cn : mine; }
            st[4] = below; st[5] = pop ? pop : 1u; st[6] = mine ? mine : 1u;
        }
        __syncthreads();
        c.xi = (int)st[4]; c.nx = (int)st[5]; c.xn = (int)st[6]; c.xr = (int)st[2];
        if (c.xr >= c.xn) c.xr = c.xn - 1;
    }
    if (EN(1) && IN_PH(PH_MODFIN)) { phase_modfin(c); SEAM(PH_MODFIN); }
    if (EN(2) && IN_PH(PH_NORM0)) { phase_normmod(c, 0, 0, MROWS); SEAM(PH_NORM0); }

#pragma unroll 1
    for (int l = 0; l < DEPTH; ++l) {
        const int base = PH_L0 + l * PH_PER_LAYER;
        const bool last = (l == DEPTH - 1);
        const int mrows = last ? NLAT : MROWS;
        unsigned char* W = c.wl(l);
        if (EN(3) && IN_PH(base + 0)) { c.fresh();
            for (int rep = 0; rep < NREP(3); ++rep) {
            { pg8::Gemm g{c.H, (const u16*)(W + WL_MAIN), MROWS, NMAIN, DM, (const u16*)(W + WL_TR), c.H}; pg8::DualOrder S; S.init(MROWS, NMAIN, NTR, MROWS, c.G, c.bid);
              EpiProj E{c.PROJ, c.TR};
              pg8::gemm_phase<EpiProj, pg8::DualOrder>(c.lds, g, S, E, nullptr); }
            }
            SEAM(base + 0);
        }
        if (EN(4) && IN_PH(base + 1)) { c.fresh();
            const int gw = c.bid * 8 + c.wave, nw = c.G * 8;
            for (int rep = 0; rep < NREP(13); ++rep) if (EN(13)) phase_attention(c, l, last);
            for (int rep = 0; rep < NREP(15); ++rep)
            if (EN(15)) for (int it = c.bid; it < (last ? 128 : 136); it += c.G) sgu_item(c, l, it);
            __syncthreads();
            for (int rep = 0; rep < NREP(16); ++rep)
            if (EN(16)) phase_s5_pass1(c, l);
            SEAM(base + 1);
        }
        if (EN(5) && IN_PH(base + 2)) { c.fresh();
            for (int rep = 0; rep < NREP(5); ++rep) phase_s5_pass3(c, l, last);
            SEAM(base + 2);
        }
        if (EN(6) && IN_PH(base + 3)) { c.fresh();
            for (int rep = 0; rep < NREP(6); ++rep) {
            pg8::Gemm g{c.S5Y, (const u16*)(W + WL_GLU), mrows, 512, 512, nullptr, nullptr}; pg8::StaticOrder S; S.init(mrows, 512, c.G, c.bid);
            EpiGlu E{c.S5Y, c.S5O, c.in[I_GLUB] + (size_t)l * 512};
            pg8::gemm_phase<EpiGlu, pg8::StaticOrder>(c.lds, g, S, E, nullptr);
            }
            if (!last && c.G == 256) peer_convert_u(c, l + 1, (MROWS / 256) * 2, c.G - (MROWS / 256) * 2);
            SEAM(base + 3);
        }
        if (EN(7) && IN_PH(base + 4)) { c.fresh(); for (int rep = 0; rep < NREP(7); ++rep) phase_merge(c, l, mrows); SEAM(base + 4); }
        constexpr int NCU = 32;
        const bool split = !last && c.G > 2 * NCU;
        if (EN(8) && IN_PH(base + 5)) { c.fresh();
            const int m5 = split ? NLAT : mrows;
            pg8::Gemm g{c.YIN, (const u16*)(W + WL_OUT), m5, DM, DM, nullptr, nullptr}; pg8::StaticOrder S; S.init(m5, DM, c.G, c.bid);
            EpiResid E{c.X, c.MOD + (size_t)l * 5 * 6 * DM, 0};
            pg8::gemm_phase<EpiResid, pg8::StaticOrder>(c.lds, g, S, E, nullptr);
            SEAM(base + 5);
        }
        if (EN(9) && IN_PH(base + 6)) { c.fresh();
            if (!split) phase_normmod(c, l, 1, mrows);
            else if (c.bid < NCU) {
                pg8::Gemm g{c.YIN + (size_t)NLAT * DM, (const u16*)(W + WL_OUT), NCTX, DM, DM, nullptr, nullptr}; pg8::StaticOrder S; S.init(NCTX, DM, NCU, c.bid);
                EpiResid E{c.X + (size_t)NLAT * DM, c.MOD + (size_t)l * 5 * 6 * DM, NLAT};
                pg8::gemm_phase<EpiResid, pg8::StaticOrder>(c.lds, g, S, E, nullptr);
            } else phase_normmod(c, l, 1, NLAT, 0, NCU, c.G - NCU);
            SEAM(base + 6);
        }
        if (EN(10) && IN_PH(base + 7)) { c.fresh();
            const int m7 = split ? NLAT : mrows;
            pg8::Gemm g{c.H, (const u16*)(W + WL_Q), m7, DM, DM, nullptr, nullptr}; pg8::StaticOrder S; S.init(m7, DM, c.G, c.bid);
            pg8::EpiBf16<0> E{c.PQ, DM, nullptr, 0, 0};
            pg8::gemm_phase<pg8::EpiBf16<0>, pg8::StaticOrder>(c.lds, g, S, E, nullptr);
            if (split) phase_normmod(c, l, 1, NCTX, NLAT);
            SEAM(base + 7);
        }
        if (EN(11) && IN_PH(base + 8)) { c.fresh();
            if (!split) { for (int it = c.bid * 8 + c.wave; it < (mrows / 32) * 8; it += c.G * 8) topk_wave_item(c, l, it >> 3, it & 7); }
            else if (c.bid < NCU) {
                pg8::Gemm g{c.H + (size_t)NLAT * DM, (const u16*)(W + WL_Q), NCTX, DM, DM, nullptr, nullptr}; pg8::StaticOrder S; S.init(NCTX, DM, NCU, c.bid);
                pg8::EpiBf16<0> E{c.PQ + (size_t)NLAT * DM, DM, nullptr, 0, 0};
                pg8::gemm_phase<pg8::EpiBf16<0>, pg8::StaticOrder>(c.lds, g, S, E, nullptr);
                pg8::Unit u; S.next(0, u);
                asm volatile("s_waitcnt vmcnt(0)" ::: "memory"); __syncthreads();
                topk_wave_item(c, l, (NLAT + 256 * u.pm) / 32 + c.wave, u.pn);
            } else { for (int it = (c.bid - NCU) * 8 + c.wave; it < (NLAT / 32) * 8; it += (c.G - NCU) * 8) topk_wave_item(c, l, it >> 3, it & 7);
                if (c.G == 256) peer_convert_v(c, l + 1, 96, c.G - 96); }
            SEAM(base + 8);
        }
        if (EN(12) && IN_PH(base + 9)) { c.fresh(); for (int rep = 0; rep < NREP(17); ++rep) phase_peer_u(c, l, mrows); SEAM(base + 9); }
        if (EN(12) && IN_PH(base + 10)) { c.fresh(); for (int rep = 0; rep < NREP(18); ++rep) phase_peer_reduce(c, mrows); SEAM(base + 10); }
        if (EN(12) && IN_PH(base + 11)) { c.fresh(); phase_peer_v(c, l, mrows, c.X); SEAM(base + 11); }
        if (EN(12) && IN_PH(base + 12)) { c.fresh();
            for (int rep = 0; rep < NREP(20); ++rep)
            if (!last) phase_normmod(c, l + 1, 0, MROWS); else phase_final(c);
            SEAM(base + 12);
        }
    }
}

#ifndef N_LAUNCH_MODE
#define N_LAUNCH_MODE 1
#endif
extern "C" void kernel_launch(void* const* d_in, const int* in_sizes, int n_in, void* d_out, int out_size, void* d_ws, size_t ws_size, hipStream_t stream) {
    static int grid = 0;
    if (grid == 0) {
        if (n_in != N_IN || ws_size < WS_END) { fprintf(stderr, "kernel_launch: unexpected n_in %d or ws %zu < %zu\n", n_in, ws_size, (size_t)WS_END); grid = -1; return; }
        int dev = 0, cus = 0, per_cu = 0;
        hipGetDevice(&dev); hipDeviceGetAttribute(&cus, hipDeviceAttributeMultiprocessorCount, dev);
        if (hipFuncSetAttribute((const void*)fwd_kernel, hipFuncAttributeMaxDynamicSharedMemorySize, LDS_BYTES) != hipSuccess) { fprintf(stderr, "kernel_launch: hipFuncSetAttribute failed\n"); grid = -1; return; }
        if (hipOccupancyMaxActiveBlocksPerMultiprocessor(&per_cu, (const void*)fwd_kernel, 512, LDS_BYTES) != hipSuccess || per_cu < 1) fprintf(stderr, "kernel_launch: occupancy query says %d\n", per_cu);
        (void)hipGetLastError();
        grid = cus > 0 ? cus : 256;
    }
    if (grid < 0) return;
    hipMemsetAsync((char*)d_ws + WS_BAR, 0, 16384, stream);
    Args a{};
    for (int i = 0; i < N_IN; ++i) a.in[i] = (const float*)d_in[i];
    a.out = (float*)d_out; a.ws = (unsigned char*)d_ws;
#if N_LAUNCH_MODE == 1
    a.ph_lo = 0; a.ph_hi = N_PHASES;
    hipLaunchKernelGGL(fwd_kernel, dim3(grid), dim3(512), LDS_BYTES, stream, a);
#else
    for (int p = 0; p < N_PHASES; ++p) { a.ph_lo = p; a.ph_hi = p + 1; hipLaunchKernelGGL(fwd_kernel, dim3(grid), dim3(512), LDS_BYTES, stream, a); }
#endif
}
```

```cpp
#include <hip/hip_runtime.h>
#include <cstdio>
namespace pg8 {
#define PG8_LAS __attribute__((address_space(3)))
typedef unsigned short bf16_t;
typedef short bf16x8 __attribute__((ext_vector_type(8)));
typedef float f32x4 __attribute__((ext_vector_type(4)));
typedef unsigned u32x4 __attribute__((ext_vector_type(4)));
constexpr int BM = 256, BK = 64, HALF = 128, HTB = HALF * BK * 2  , STAGE_BYTES = 8 * HTB, NXCD = 8, WGM = 8;

__host__ __device__ __forceinline__ int lds_byte(int r, int c) { const int st = (r >> 4) * 2 + (c >> 5), rr = r & 15, cc = c & 31, ob = rr * 64 + cc * 2; return st * 1024 + (ob ^ (((ob >> 9) & 1) << 5)); }
__host__ __device__ __forceinline__ void stage_rc(int b, int& R, int& C) { const int st = b / 1024, sb = b % 1024, swz = sb ^ (((sb >> 9) & 1) << 5); R = (st >> 1) * 16 + swz / 64; C = (st & 1) * 32 + (swz % 64) / 2; }
__host__ __device__ __forceinline__ int perm32(int rho) { const int n = rho >> 4, i = rho & 15; return 8 * (i >> 2) + 4 * n + (i & 3); }

struct Unit { int pm, pn, w; };
struct Gemm { const bf16_t* A; const bf16_t* Bt; int M, N, K; const bf16_t* A2; const bf16_t* Bt2; };

struct StaticOrder {
    int nM, nN, nwg, G, c;
    __host__ __device__ void init(int M, int N, int G_, int c_) { nM = M / BM; nN = N / BM; nwg = nM * nN; G = G_; c = c_; }
    __host__ __device__ bool next(int i, Unit& u) const {
        const long L = (long)i * G + c; if (L >= nwg) return false;
        int wgid = (int)L; { const int q = nwg / NXCD, r = nwg % NXCD, xcd = wgid % NXCD, off = wgid / NXCD; wgid = (xcd < r ? xcd * (q + 1) : r * (q + 1) + (xcd - r) * q) + off; }
        const int nig = WGM * nN, gid = wgid / nig, fm = gid * WGM, gsz = (nM - fm) < WGM ? (nM - fm) : WGM;
        u.pm = fm + ((wgid % nig) % gsz); u.pn = (wgid % nig) / gsz; u.w = 0; return true;
    }
    __device__ __forceinline__ void a_ready(const Unit&) const {}
    __device__ __forceinline__ void done(const Unit&) const {}
};
struct DualOrder {
    StaticOrder s0, s1; int G, c;
    __host__ __device__ void init(int M0, int N0, int M1, int N1, int G_, int c_) { s0.init(M0, N0, 1, 0); s1.init(M1, N1, 1, 0); G = G_; c = c_; }
    __host__ __device__ bool next(int i, Unit& u) const {
        const long L = (long)i * G + c;
        if (L < s0.nwg) { s0.next((int)L, u); u.w = 0; return true; }
        if (L < s0.nwg + s1.nwg) { s1.next((int)(L - s0.nwg), u); u.w = 1; return true; }
        return false;
    }
    __device__ __forceinline__ void a_ready(const Unit&) const {}
    __device__ __forceinline__ void done(const Unit&) const {}
};
__device__ __forceinline__ unsigned cvt_pk_bf16(float lo, float hi) { unsigned r; asm volatile("v_cvt_pk_bf16_f32 %0, %1, %2" : "=v"(r) : "v"(lo), "v"(hi)); return r; }
typedef float f32x2 __attribute__((ext_vector_type(2)));
__device__ __forceinline__ f32x2 gelu_pk(f32x2 v) {
    const f32x2 av = __builtin_elementwise_abs(v), d = av * 0.2316418882f + 1.0f;
    f32x2 t; t.x = __builtin_amdgcn_rcpf(d.x); t.y = __builtin_amdgcn_rcpf(d.y);
    f32x2 q = t * 0.5307027145f + (-0.7265760135f); q = q * t + 0.7107068705f; q = q * t + (-0.142248368f); q = q * t + 0.127414796f; q = q * t;
    const f32x2 s = (v * v) * (-0.72134752044f);
    f32x2 e; e.x = __builtin_amdgcn_exp2f(s.x); e.y = __builtin_amdgcn_exp2f(s.y);
    const f32x2 m = v * (q * e), r = v - m;
    f32x2 o; o.x = v.x < 0.f ? m.x : r.x; o.y = v.y < 0.f ? m.y : r.y; return o;
}
template <int ACT  > struct EpiBf16 {
    static constexpr bool PERM = true, AFTER_DRAIN = false;
    bf16_t* O; int ldc; const float* bias; int split_cols; size_t split_stride;
    __device__ __forceinline__ void operator()(const f32x4 (&acc)[2][2][4][2], const Unit& u, int wr, int wc, int fr, int fq) const {
        const int row0 = u.pm * BM + wr * 64 + fr; int colt = u.pn * BM; bf16_t* base = O;
        if (split_cols) { const int t = colt / split_cols; base += (size_t)t * split_stride; colt -= t * split_cols; }
        const int col0 = colt + wc * 32 + 8 * fq, bcol0 = u.pn * BM + wc * 32 + 8 * fq;
        f32x4 bv[2][2];
#pragma unroll
        for (int bj = 0; bj < 2; ++bj)
#pragma unroll
            for (int n = 0; n < 2; ++n) bv[bj][n] = bias ? *(const f32x4*)(bias + bcol0 + bj * HALF + 4 * n) : (f32x4){0.f, 0.f, 0.f, 0.f};
#pragma unroll
        for (int ai = 0; ai < 2; ++ai)
#pragma unroll
            for (int m = 0; m < 4; ++m) { bf16_t* rowp = base + (size_t)(row0 + ai * HALF + m * 16) * ldc + col0;
#pragma unroll
                for (int bj = 0; bj < 2; ++bj) { f32x4 v0 = acc[ai][bj][m][0] + bv[bj][0], v1 = acc[ai][bj][m][1] + bv[bj][1];
                    if (ACT == 1) { f32x2 a = gelu_pk((f32x2){v0[0], v0[1]}), b = gelu_pk((f32x2){v0[2], v0[3]}), c = gelu_pk((f32x2){v1[0], v1[1]}), d = gelu_pk((f32x2){v1[2], v1[3]});
                        v0 = (f32x4){a.x, a.y, b.x, b.y}; v1 = (f32x4){c.x, c.y, d.x, d.y}; }
                    if (ACT == 2) {
#pragma unroll
                        for (int j = 0; j < 4; ++j) { v0[j] = 0.5f * v0[j] * (1.0f + erff(v0[j] * 0.70710678f)); v1[j] = 0.5f * v1[j] * (1.0f + erff(v1[j] * 0.70710678f)); } }
                    u32x4 w; w.x = cvt_pk_bf16(v0[0], v0[1]); w.y = cvt_pk_bf16(v0[2], v0[3]); w.z = cvt_pk_bf16(v1[0], v1[1]); w.w = cvt_pk_bf16(v1[2], v1[3]);
                    *(u32x4*)(rowp + bj * HALF) = w; } }
    }
};
template <class Epi, class Sched, bool STAMP = false>
__device__ __forceinline__ void gemm_phase(PG8_LAS unsigned char* lds, const Gemm g, const Sched& S, const Epi& E, unsigned long long* stamps) {
    int tid = threadIdx.x; asm volatile("" : "+v"(tid)); const int wid = __builtin_amdgcn_readfirstlane(tid >> 6), lane = tid & 63, wr = wid >> 2, wc = wid & 3, fr = lane & 15, fq = lane >> 4;
    const int K = g.K, nt = K / BK;
    int ts_lo = 0, ts_hi = 0, nts = 0; const unsigned long long rt_entry = STAMP ? (unsigned long long)wall_clock64() : 0ull;
#define PG8_STAMP() do { if (STAMP && wid == 0 && nts < 64) { const unsigned long long _c = (unsigned long long)clock64(); \
        ts_lo = (lane == nts) ? (int)(unsigned)_c : ts_lo; ts_hi = (lane == nts) ? (int)(unsigned)(_c >> 32) : ts_hi; ++nts; } } while (0)
    PG8_STAMP();
    unsigned voffA[2], voffB[2];
#pragma unroll
    for (int i = 0; i < 2; ++i) { int R, C; stage_rc(tid * 16 + i * 8192, R, C); const int Rb = Epi::PERM ? ((R & ~31) + perm32(R & 31)) : R;
        voffA[i] = (unsigned)(R * K + C) * 2u; voffB[i] = (unsigned)(Rb * K + C) * 2u; }
    const size_t kstep = (size_t)(BK * 2);
    const size_t hstep = (size_t)HALF * K * 2;
    const size_t tstep = 2 * hstep;
    const unsigned ldsw = (unsigned)wid * 1024u;
    const int aoff = lds_byte(wr * 64 + fr, fq * 8), boff = lds_byte(wc * 32 + fr, fq * 8);
#define PG8_SA(b, h) (((b) * 2 + (h)) * HTB)
#define PG8_SB(b, h) ((4 + (b) * 2 + (h)) * HTB)
#define PG8_STAGE(bufoff, gbase, voff) do { _Pragma("unroll") for (int _i = 0; _i < 2; ++_i) \
        __builtin_amdgcn_global_load_lds((const unsigned*)((const char*)(gbase) + (voff)[_i]), (PG8_LAS unsigned*)(lds + (bufoff) + ldsw + _i * 8192), 16, 0, 0); } while (0)
#define PG8_LDA(dst, b, h) do { _Pragma("unroll") for (int m = 0; m < 4; ++m) _Pragma("unroll") for (int k = 0; k < 2; ++k) dst[m][k] = *(const PG8_LAS bf16x8*)(lds + PG8_SA(b, h) + aoff + m * 2048 + k * 1024); } while (0)
#define PG8_LDB(dst, b, h) do { _Pragma("unroll") for (int n = 0; n < 2; ++n) _Pragma("unroll") for (int k = 0; k < 2; ++k) dst[n][k] = *(const PG8_LAS bf16x8*)(lds + PG8_SB(b, h) + boff + n * 2048 + k * 1024); } while (0)
#define PG8_MMA(ai, bj, At, Bt) do { __builtin_amdgcn_s_setprio(1); _Pragma("unroll") for (int m = 0; m < 4; ++m) _Pragma("unroll") for (int n = 0; n < 2; ++n) _Pragma("unroll") for (int k = 0; k < 2; ++k) \
        acc[ai][bj][m][n] = __builtin_amdgcn_mfma_f32_16x16x32_bf16(Bt[n][k], At[m][k], acc[ai][bj][m][n], 0, 0, 0); __builtin_amdgcn_s_setprio(0); } while (0)
#define PG8_WAIT_V(n) asm volatile("s_waitcnt vmcnt(" #n ")" ::: "memory")
#define PG8_WAIT_L(n) asm volatile("s_waitcnt lgkmcnt(" #n ")" ::: "memory")
#define PG8_BAR __builtin_amdgcn_s_barrier()
#define PG8_SCHED __builtin_amdgcn_sched_barrier(0)
    Unit cur, nxt; int ui = 0;
    if (!S.next(0, cur)) return;
    f32x4 acc[2][2][4][2];
#pragma unroll
    for (int a = 0; a < 2; ++a)
#pragma unroll
        for (int b = 0; b < 2; ++b)
#pragma unroll
            for (int m = 0; m < 4; ++m)
#pragma unroll
                for (int n = 0; n < 2; ++n) acc[a][b][m][n] = (f32x4){0.f, 0.f, 0.f, 0.f};
    bf16x8 At[4][2], B0[2][2], B1[2][2];
    const char* cA = (const char*)(cur.w ? g.A2 : g.A) + (size_t)cur.pm * tstep; const char* cB = (const char*)(cur.w ? g.Bt2 : g.Bt) + (size_t)cur.pn * tstep;
    S.a_ready(cur);
    PG8_STAGE(PG8_SB(0, 0), cB, voffB); PG8_STAGE(PG8_SA(0, 0), cA, voffA); PG8_STAGE(PG8_SB(0, 1), cB + hstep, voffB); PG8_STAGE(PG8_SA(0, 1), cA + hstep, voffA);
    if (wr == 1) PG8_BAR;
    PG8_WAIT_V(4); PG8_BAR;
    PG8_STAGE(PG8_SB(1, 0), cB + kstep, voffB); PG8_STAGE(PG8_SA(1, 0), cA + kstep, voffA); PG8_STAGE(PG8_SB(1, 1), cB + hstep + kstep, voffB);
    PG8_WAIT_V(6); PG8_BAR;
    PG8_STAMP();
    for (;;) {
        const bool has_next = S.next(ui + 1, nxt);
        const char* nA = has_next ? (const char*)(nxt.w ? g.A2 : g.A) + (size_t)nxt.pm * tstep : cA; const char* nB = has_next ? (const char*)(nxt.w ? g.Bt2 : g.Bt) + (size_t)nxt.pn * tstep : cB;
        for (int t = 0; t < nt; t += 2) {
            const bool last = (t == nt - 2);
            const char* a1 = cA + (size_t)(t + 1) * kstep;
            const char* a2 = last ? nA : cA + (size_t)(t + 2) * kstep; const char* b2 = last ? nB : cB + (size_t)(t + 2) * kstep;
            const char* a3 = a2 + kstep; const char* b3 = b2 + kstep;
            if (last && has_next) S.a_ready(nxt);
            PG8_LDB(B0, 0, 0); PG8_SCHED; PG8_LDA(At, 0, 0); PG8_STAGE(PG8_SA(1, 1), a1 + hstep, voffA);
            PG8_WAIT_L(8); PG8_BAR; PG8_WAIT_L(0); PG8_MMA(0, 0, At, B0); PG8_BAR; PG8_SCHED;
            PG8_LDB(B1, 0, 1); PG8_STAGE(PG8_SB(0, 0), b2, voffB);
            PG8_BAR; PG8_WAIT_L(0); PG8_MMA(0, 1, At, B1); PG8_BAR;
            PG8_LDA(At, 0, 1); PG8_STAGE(PG8_SA(0, 0), a2, voffA);
            PG8_BAR; PG8_WAIT_L(0); PG8_MMA(1, 0, At, B0); PG8_BAR; PG8_SCHED;
            PG8_STAGE(PG8_SB(0, 1), b2 + hstep, voffB);
            PG8_WAIT_V(6); PG8_BAR; PG8_MMA(1, 1, At, B1); PG8_BAR;
            PG8_LDB(B0, 1, 0); PG8_SCHED; PG8_LDA(At, 1, 0); PG8_STAGE(PG8_SA(0, 1), a2 + hstep, voffA);
            PG8_WAIT_L(8); PG8_BAR; PG8_WAIT_L(0); PG8_MMA(0, 0, At, B0); PG8_BAR; PG8_SCHED;
            PG8_LDB(B1, 1, 1); PG8_STAGE(PG8_SB(1, 0), b3, voffB);
            PG8_BAR; PG8_WAIT_L(0); PG8_MMA(0, 1, At, B1); PG8_BAR;
            PG8_LDA(At, 1, 1); PG8_STAGE(PG8_SA(1, 0), a3, voffA);
            PG8_BAR; PG8_WAIT_L(0); PG8_MMA(1, 0, At, B0); PG8_BAR; PG8_SCHED;
            PG8_STAGE(PG8_SB(1, 1), b3 + hstep, voffB);
            PG8_WAIT_V(6); PG8_BAR; PG8_MMA(1, 1, At, B1); PG8_BAR;
        }
        PG8_STAMP();
        if constexpr (!Epi::AFTER_DRAIN) { E(acc, cur, wr, wc, fr, fq); S.done(cur); }
        PG8_STAMP();
        if (!has_next) break;
#pragma unroll
        for (int a = 0; a < 2; ++a)
#pragma unroll
            for (int b = 0; b < 2; ++b)
#pragma unroll
                for (int m = 0; m < 4; ++m)
#pragma unroll
                    for (int n = 0; n < 2; ++n) acc[a][b][m][n] = (f32x4){0.f, 0.f, 0.f, 0.f};
        cur = nxt; cA = nA; cB = nB; ++ui;
    }
    PG8_WAIT_V(0);
    if (wr == 0) PG8_BAR;
    PG8_BAR;
    if constexpr (Epi::AFTER_DRAIN) { E.fused(acc, cur, wr, wc, fr, fq, lds, wid, lane); S.done(cur); }
    PG8_STAMP();
    if (STAMP && wid == 0) { stamps[lane] = lane < nts ? (((unsigned long long)(unsigned)ts_hi << 32) | (unsigned)ts_lo) : 0ull;
        if (lane == 62) stamps[62] = rt_entry; if (lane == 63) stamps[63] = (unsigned long long)wall_clock64(); }
#undef PG8_STAMP
#undef PG8_SA
#undef PG8_SB
#undef PG8_STAGE
#undef PG8_LDA
#undef PG8_LDB
#undef PG8_MMA
#undef PG8_WAIT_V
#undef PG8_WAIT_L
#undef PG8_BAR
#undef PG8_SCHED
}
}

#define XB_TMO      128
#define XB_XCNT(j)  (256  + 64 * (j))
#define XB_XSUB(j)  (1280 + 64 * (j))
#define XB_XGEN(j)  (2304 + 64 * (j))
#define XB_TOP      3328
#define XB_TOPGEN   3392
#define XCD_BAR_WORDS 3456
#define XB_SPIN_CAP (1u << 22)
#define LAS __attribute__((address_space(3)))

__device__ __forceinline__ unsigned xb_ld(unsigned* p)              { return __hip_atomic_load(p, __ATOMIC_RELAXED, __HIP_MEMORY_SCOPE_AGENT); }
__device__ __forceinline__ unsigned xb_add(unsigned* p, unsigned v) { return __hip_atomic_fetch_add(p, v, __ATOMIC_RELAXED, __HIP_MEMORY_SCOPE_AGENT); }
__device__ __forceinline__ unsigned xb_xcc_id() { return (unsigned)__builtin_amdgcn_s_getreg((3 << 11) | 20) & 0xFu; }
#define XB_SPIN(cond, bar) do { unsigned _sp = 0; while (cond) { __builtin_amdgcn_s_sleep(1); \
    if ((++_sp & 255u) == 0u) { if (xb_ld(&(bar)[XB_TMO])) break; if (_sp > XB_SPIN_CAP) { atomicAdd(&(bar)[XB_TMO], 1u); break; } } } } while (0)

struct XcdBarrier { unsigned* bar; unsigned x; volatile LAS unsigned* st; };

__device__ __forceinline__ XcdBarrier xcd_barrier_post(unsigned* bar, volatile LAS unsigned* st) {
    XcdBarrier b; b.bar = bar; b.x = xb_xcc_id(); b.st = st;
    if (threadIdx.x == 0) st[2] = xb_add(&bar[XB_XCNT(b.x)], 1u);
    return b;
}
__device__ __forceinline__ void xcd_barrier_complete(unsigned* bar, unsigned x, unsigned& nloc, unsigned& nx) {
    const unsigned G = gridDim.x * gridDim.y * gridDim.z;
    unsigned sum, cnt, mine, sp = 0u;
    for (;;) {
        sum = 0u; cnt = 0u; mine = 0u;
#pragma unroll
        for (unsigned j = 0; j < 16; ++j) { const unsigned c = xb_ld(&bar[XB_XCNT(j)]); sum += c; cnt += (c > 0u) ? 1u : 0u; mine = (j == x) ? c : mine; }
        if (sum == G) break;
        __builtin_amdgcn_s_sleep(1);
        if ((++sp & 255u) == 0u) { if (xb_ld(&bar[XB_TMO])) break; if (sp > XB_SPIN_CAP) { atomicAdd(&bar[XB_TMO], 1u); break; } }
    }
    nloc = mine > 0u ? mine : 1u; nx = cnt > 0u ? cnt : 1u;
}
__device__ __forceinline__ void xcd_barrier(const XcdBarrier& b) {
    asm volatile("s_waitcnt vmcnt(0)" ::: "memory");
    __syncthreads();
    if (threadIdx.x == 0) {
        unsigned* bar = b.bar;
        __builtin_amdgcn_s_waitcnt(0);
        unsigned nloc = b.st[0], nx = b.st[1];
        if (nloc == 0u) { xcd_barrier_complete(bar, b.x, nloc, nx); b.st[0] = nloc; b.st[1] = nx; }
        const unsigned old = xb_add(&bar[XB_XSUB(b.x)], 1u);
        const unsigned gen = old / nloc;
        if (old + 1u == (gen + 1u) * nloc) {
            __builtin_amdgcn_fence(__ATOMIC_RELEASE, "agent");
            asm volatile("s_waitcnt vmcnt(0)" ::: "memory");
            const unsigned og = xb_add(&bar[XB_TOP], 1u);
            const unsigned tg = og / nx;
            if (og + 1u == (tg + 1u) * nx) xb_add(&bar[XB_TOPGEN], 1u);
            else XB_SPIN(xb_ld(&bar[XB_TOPGEN]) == tg, bar);
            __builtin_amdgcn_fence(__ATOMIC_ACQUIRE, "agent");
            xb_add(&bar[XB_XGEN(b.x)], 1u);
            asm volatile("s_waitcnt vmcnt(0)" ::: "memory");
        } else {
            XB_SPIN(xb_ld(&bar[XB_XGEN(b.x)]) == gen, bar);
            __builtin_amdgcn_fence(__ATOMIC_ACQUIRE, "agent");
            asm volatile("s_waitcnt vmcnt(0)" ::: "memory");
        }
    }
    __syncthreads();
}

typedef unsigned short u16;
using pg8::bf16x8; using pg8::f32x4; using pg8::u32x4;
typedef float f32x2v __attribute__((ext_vector_type(2)));
typedef unsigned u32x2 __attribute__((ext_vector_type(2)));

constexpr int DM = 2048, NB = 4, SEQL = 4096, CTXL = 256, NLAT = NB * SEQL, NCTX = NB * CTXL, MROWS = NLAT + NCTX;
constexpr int DEPTH = 4, NMAIN = 3072, NTR = 1536;
constexpr int PJ_Q = 0, PJ_K = 1024, PJ_SU = 2048, PJ_SIN = 2560;
constexpr int TR_V = 0, TR_SV = 1024;
constexpr int NCHK = 68;
constexpr float EPSN = 1e-6f;

constexpr size_t al256(size_t x) { return (x + 255) & ~(size_t)255; }
constexpr size_t WS_BAR   = 0;
constexpr size_t WS_MOD   = 16384;
constexpr size_t WS_MODP  = al256(WS_MOD + (size_t)DEPTH * 5 * 6 * DM * 4);
constexpr size_t WS_X     = al256(WS_MODP + (size_t)64 * DEPTH * 5 * 6 * DM * 4);
constexpr size_t WS_H     = al256(WS_X + (size_t)MROWS * DM * 4);
constexpr size_t WS_PROJ  = al256(WS_H + (size_t)MROWS * DM * 2);
constexpr size_t WS_TR    = al256(WS_PROJ + (size_t)MROWS * NMAIN * 2);
constexpr size_t WS_ATT   = al256(WS_TR + (size_t)NTR * MROWS * 2);
constexpr size_t WS_SGU   = al256(WS_ATT + (size_t)MROWS * 1024 * 2);
constexpr size_t WS_S5Y   = al256(WS_SGU + (size_t)MROWS * 512 * 2);
constexpr size_t WS_S5O   = al256(WS_S5Y + (size_t)MROWS * 512 * 2);
constexpr size_t WS_YIN   = al256(WS_S5O + (size_t)MROWS * 512 * 2);
constexpr size_t WS_PQ    = al256(WS_YIN + (size_t)MROWS * DM * 2);
constexpr size_t PAIRS_MAX = (size_t)MROWS * 128;
constexpr size_t WS_ET    = al256(WS_PQ + (size_t)MROWS * DM * 2);
constexpr size_t WS_GT    = al256(WS_ET + PAIRS_MAX * 2);
constexpr size_t WS_PART  = al256(WS_GT + PAIRS_MAX * 4);
constexpr size_t WS_WT    = al256(WS_PART + 8 * PAIRS_MAX * 2);
constexpr size_t WS_H8    = al256(WS_WT + PAIRS_MAX * 2);
constexpr size_t WS_HSC   = al256(WS_H8 + (size_t)MROWS * DM);
constexpr size_t WS_SLOC  = al256(WS_HSC + (size_t)MROWS * 4);
constexpr size_t WS_WTS   = al256(WS_SLOC + (size_t)NB * 32 * 2 * NCHK * 64 * 8);
constexpr size_t WL_MAIN = 0;
constexpr size_t WL_TR   = WL_MAIN + (size_t)NMAIN * DM * 2;
constexpr size_t WL_OUT  = WL_TR + (size_t)NTR * DM * 2;
constexpr size_t WL_Q    = WL_OUT + (size_t)DM * DM * 2;
constexpr size_t WL_GLU  = WL_Q + (size_t)DM * DM * 2;
constexpr size_t WL_K12  = WL_GLU + (size_t)512 * 512 * 2;
constexpr size_t WL_U    = WL_K12 + (size_t)2 * 8 * 128 * 128 * 2;
constexpr size_t WL_V    = WL_U + (size_t)16384 * DM / 2;
constexpr size_t WL_SGUW = WL_V + (size_t)16384 * DM / 2;
constexpr size_t WL_SIZE = al256(WL_SGUW + (size_t)4 * 128 * 128 * 2);
constexpr float VSCALE = 5.5f, USCALE = 135.0f;
constexpr int PEER_NSL = 8, PEER_ROWB = 128;
constexpr size_t PEER_SLB = (size_t)16384 * 128;
constexpr size_t WS_END  = WS_WTS + DEPTH * WL_SIZE;

constexpr int LDS_BYTES = 147456;
constexpr int LDS_BARW  = LDS_BYTES - 32;

enum { I_X = 0, I_C, I_CTX, I_CCTX, I_ADAW, I_ADAB, I_NMIX, I_NFFN, I_WIN, I_WOUT, I_ONORM, I_RPB, I_SGUW, I_SGUB, I_SGUN, I_ARE, I_AIM, I_LOGDT, I_BRE, I_BIM, I_CRE, I_CIM, I_S5D, I_GLUW, I_GLUB,
       I_WQ, I_K1, I_K2, I_PU, I_PV, I_FNORM, N_IN };

struct Args { const float* in[N_IN]; float* out; unsigned char* ws; int ph_lo, ph_hi; };

struct Ctx {
    const float* in[N_IN]; float* out; unsigned char* ws; LAS unsigned char* lds;
    int tid, lane, wave, G, bid;
    float* MOD; float* MODP; u16* X; u16* H; u16* PROJ; u16* TR; u16* ATT; u16* SGU; u16* S5Y; u16* S5O; u16* YIN; u16* PQ; u16* ET; float* GT; u16* PART; u16* WT; unsigned char* H8; float* HSC; f32x2v* SLOC;
    int xi, nx, xr, xn;
    __device__ __forceinline__ unsigned char* wl(int l) const { return ws + WS_WTS + (size_t)l * WL_SIZE; }
    __device__ __forceinline__ void fresh() { int t = threadIdx.x; asm volatile("" : "+v"(t)); tid = t; lane = t & 63; wave = __builtin_amdgcn_readfirstlane(t >> 6); }
};

__device__ __forceinline__ float bf2f(u16 v) { return __uint_as_float(((unsigned)v) << 16); }
__device__ __forceinline__ float bflo(unsigned v) { return __uint_as_float(v << 16); }
__device__ __forceinline__ float bfhi(unsigned v) { return __uint_as_float(v & 0xffff0000u); }
__device__ __forceinline__ u16 f2bf(float f) { unsigned u = __float_as_uint(f); u += 0x7FFFu + ((u >> 16) & 1u); return (u16)(u >> 16); }
__device__ __forceinline__ unsigned pk2(float lo, float hi) { return pg8::cvt_pk_bf16(lo, hi); }
__device__ __forceinline__ float gelu_f(float v) {
    const float av = fabsf(v), t = __builtin_amdgcn_rcpf(av * 0.2316418882f + 1.0f);
    float q = t * 0.5307027145f + (-0.7265760135f); q = q * t + 0.7107068705f; q = q * t + (-0.142248368f); q = q * t + 0.127414796f; q = q * t;
    const float e = __builtin_amdgcn_exp2f((v * v) * (-0.72134752044f));
    const float m = v * (q * e);
    return v < 0.f ? m : v - m;
}
__device__ __forceinline__ float wave_sum(float v) {
    v += __shfl_xor(v, 32); v += __shfl_xor(v, 16); v += __shfl_xor(v, 8); v += __shfl_xor(v, 4); v += __shfl_xor(v, 2); v += __shfl_xor(v, 1); return v;
}
__device__ __forceinline__ int row_bidx(int row) { return row < NLAT ? (row >> 12) : 4; }
__device__ __forceinline__ void lds_fence() { asm volatile("s_waitcnt lgkmcnt(0)" ::: "memory"); }

__device__ __forceinline__ void tr_tile(const Ctx& c, const float* src, int ld, int k0, int n0, u16* dst, int drow0) {
    LAS float* T = (LAS float*)c.lds;
    const int t = c.tid, cq = t & 63, r0 = t >> 6;
    f32x4 v[8];
#pragma unroll
    for (int i = 0; i < 8; ++i) v[i] = *(const f32x4*)(src + (size_t)(k0 + r0 + 8 * i) * ld + n0 + 4 * cq);
#pragma unroll
    for (int i = 0; i < 8; ++i) *(LAS f32x4*)(T + (r0 + 8 * i) * 260 + 4 * cq) = v[i];
    __syncthreads();
#pragma unroll
    for (int i = 0; i < 4; ++i) {
        const int idx = t + 512 * i, n = idx >> 3, kc = idx & 7;
        float e[8];
#pragma unroll
        for (int q = 0; q < 8; ++q) e[q] = T[(8 * kc + q) * 260 + n];
        u32x4 o; o.x = pk2(e[0], e[1]); o.y = pk2(e[2], e[3]); o.z = pk2(e[4], e[5]); o.w = pk2(e[6], e[7]);
        *(u32x4*)(dst + (size_t)(drow0 + n) * DM + k0 + 8 * kc) = o;
    }
    __syncthreads();
}

__device__ __forceinline__ unsigned pack_i4(const float4& a, const float4& b) {
    const float ev[8] = {a.x, a.y, a.z, a.w, b.x, b.y, b.z, b.w};
    unsigned nb[8];
#pragma unroll
    for (int k2 = 0; k2 < 8; ++k2) { const int qv = (int)rintf(ev[k2] * USCALE); nb[k2] = (unsigned)(min(max(qv, -8), 7) + 8); }
    return nb[0] | (nb[4] << 4) | (nb[1] << 8) | (nb[5] << 12) | (nb[2] << 16) | (nb[6] << 20) | (nb[3] << 24) | (nb[7] << 28);
}
__device__ __forceinline__ unsigned pack_fp4(const float4& a, const float4& b) {
    unsigned w = 0u;
    w = __builtin_amdgcn_cvt_scalef32_pk_fp4_f32(w, a.x * VSCALE, a.y * VSCALE, 1.0f, 0); w = __builtin_amdgcn_cvt_scalef32_pk_fp4_f32(w, a.z * VSCALE, a.w * VSCALE, 1.0f, 1);
    w = __builtin_amdgcn_cvt_scalef32_pk_fp4_f32(w, b.x * VSCALE, b.y * VSCALE, 1.0f, 2); w = __builtin_amdgcn_cvt_scalef32_pk_fp4_f32(w, b.z * VSCALE, b.w * VSCALE, 1.0f, 3);
    return w;
}
template <bool IS_U>
__device__ __forceinline__ void peer_convert(const Ctx& c, int l, int b0, int nb) {
    if (c.bid < b0 || c.bid >= b0 + nb) return;
    const size_t n32 = (size_t)16384 * DM / 32, stride = (size_t)nb * 512;
    const float4* src = (const float4*)((IS_U ? c.in[I_PU] : c.in[I_PV]) + (size_t)l * 16384 * DM);
    u32x4* dst = (u32x4*)(c.wl(l) + (IS_U ? WL_U : WL_V));
    for (size_t i = (size_t)(c.bid - b0) * 512 + c.tid; i < n32; i += 2 * stride) {
        const size_t i2 = i + stride; const bool two = i2 < n32; const size_t j2 = two ? i2 : i;
        float4 a[8], b[8];
#pragma unroll
        for (int q = 0; q < 8; ++q) { a[q] = src[8 * i + q]; b[q] = src[8 * j2 + q]; }
        u32x4 o, p;
        if (IS_U) { o = (u32x4){pack_i4(a[0], a[1]), pack_i4(a[2], a[3]), pack_i4(a[4], a[5]), pack_i4(a[6], a[7])}; p = (u32x4){pack_i4(b[0], b[1]), pack_i4(b[2], b[3]), pack_i4(b[4], b[5]), pack_i4(b[6], b[7])}; }
        else      { o = (u32x4){pack_fp4(a[0], a[1]), pack_fp4(a[2], a[3]), pack_fp4(a[4], a[5]), pack_fp4(a[6], a[7])}; p = (u32x4){pack_fp4(b[0], b[1]), pack_fp4(b[2], b[3]), pack_fp4(b[4], b[5]), pack_fp4(b[6], b[7])}; }
        dst[((i & 63) >> 3) * 131072 + (i >> 6) * 8 + (i & 7)] = o; if (two) dst[((i2 & 63) >> 3) * 131072 + (i2 >> 6) * 8 + (i2 & 7)] = p;
    }
}
__device__ __forceinline__ void peer_convert_u(const Ctx& c, int l, int b0, int nb) { peer_convert<true>(c, l, b0, nb); }
__device__ __forceinline__ void peer_convert_v(const Ctx& c, int l, int b0, int nb) { peer_convert<false>(c, l, b0, nb); }

__device__ __forceinline__ void phase_prologue(const Ctx& c) {
    const int G = c.G, bid = c.bid, tid = c.tid;
    {
        const size_t n8 = (size_t)MROWS * DM / 8, nl8 = (size_t)NLAT * DM / 8;
        const float4* sx = (const float4*)c.in[I_X]; const float4* sc = (const float4*)c.in[I_CTX]; u32x4* dx = (u32x4*)c.X;
        for (size_t i = (size_t)bid * 512 + tid; i < n8; i += (size_t)G * 512) {
            const float4* s = i < nl8 ? sx + 2 * i : sc + 2 * (i - nl8);
            const float4 a = s[0], b = s[1];
            dx[i] = (u32x4){pk2(a.x, a.y), pk2(a.z, a.w), pk2(b.x, b.y), pk2(b.z, b.w)};
        }
    }
    for (int l = 0; l < DEPTH; ++l) {
        unsigned char* W = c.wl(l);
        const float* win = c.in[I_WIN] + (size_t)l * DM * 4608;
        for (int it = bid; it < 32 * 18; it += G) {
            const int kt = it & 31, nt = it >> 5, n0 = nt * 256;
            u16* dst; int drow;
            if (n0 < 2048) { dst = (u16*)(W + WL_MAIN); drow = n0; }
            else if (n0 < 3072) { dst = (u16*)(W + WL_TR); drow = n0 - 2048; }
            else if (n0 < 3584) { dst = (u16*)(W + WL_MAIN); drow = 2048 + (n0 - 3072); }
            else if (n0 < 4096) { dst = (u16*)(W + WL_TR); drow = 1024 + (n0 - 3584); }
            else { dst = (u16*)(W + WL_MAIN); drow = 2560 + (n0 - 4096); }
            tr_tile(c, win, 4608, kt * 64, n0, dst, drow);
        }
        const float* wout = c.in[I_WOUT] + (size_t)l * DM * DM;
        for (int it = bid; it < 32 * 8; it += G) tr_tile(c, wout, DM, (it & 31) * 64, (it >> 5) * 256, (u16*)(W + WL_OUT), (it >> 5) * 256);
        const float* wq = c.in[I_WQ] + (size_t)l * DM * DM;
        for (int it = bid; it < 32 * 8; it += G) tr_tile(c, wq, DM, (it & 31) * 64, (it >> 5) * 256, (u16*)(W + WL_Q), (it >> 5) * 256);
        {
            const float* gw = c.in[I_GLUW] + (size_t)l * 512 * 512; u16* dst = (u16*)(W + WL_GLU);
            LAS float* T = (LAS float*)c.lds;
            for (int it = bid; it < 8 * 8; it += G) {
                const int k0 = (it & 7) * 64, n0 = (it >> 3) * 64, t = tid;
#pragma unroll
                for (int i = 0; i < 8; ++i) { const int r = (t >> 6) + 8 * i; T[r * 65 + (t & 63)] = gw[(size_t)(k0 + r) * 512 + n0 + (t & 63)]; }
                __syncthreads();
#pragma unroll
                for (int i = 0; i < 4; ++i) { const int n = (t >> 5) + 16 * i, kp = t & 31;
                    *(unsigned*)(dst + (size_t)(n0 + n) * 512 + k0 + 2 * kp) = pk2(T[(2 * kp) * 65 + n], T[(2 * kp + 1) * 65 + n]); }
                __syncthreads();
            }
        }
        {
            const float* sw = c.in[I_SGUW] + (size_t)l * 4 * 128 * 128; u16* dst = (u16*)(W + WL_SGUW);
            for (int i = bid * 512 + tid; i < 4 * 128 * 128 / 2; i += G * 512) *(unsigned*)(dst + 2 * i) = pk2(sw[2 * i], sw[2 * i + 1]);
        }
        {
            u16* dst = (u16*)(W + WL_K12);
            const float* k1 = c.in[I_K1] + (size_t)l * 8 * 128 * 128; const float* k2 = c.in[I_K2] + (size_t)l * 8 * 128 * 128;
            for (int i = bid * 512 + tid; i < 2 * 131072 / 2; i += G * 512) {
                const int e = 2 * i; const float* s = e < 131072 ? k1 + e : k2 + (e - 131072);
                *(unsigned*)(dst + e) = pk2(s[0], s[1]);
            }
        }
    }
    { const int nl = (G == 256) ? 1 : DEPTH;
      for (int l = 0; l < nl; ++l) { peer_convert_u(c, l, 0, G); peer_convert_v(c, l, 0, G); } }
    {
        LAS float* S = (LAS float*)c.lds;
        for (int it = bid; it < DEPTH * 24 * 16; it += G) {
            const int kc = it & 15, nb = (it >> 4) % 24, l = it / (16 * 24);
            __syncthreads();
            for (int i = tid; i < 640; i += 512) { const int r = i >> 7, kk = i & 127; const float v = r < 4 ? c.in[I_C][r * DM + kc * 128 + kk] : c.in[I_CCTX][kc * 128 + kk]; S[i] = v / (1.0f + __expf(-v)); }
            __syncthreads();
            const int cq = tid & 127, kq = tid >> 7, n = nb * 512 + 4 * cq;
            const float* w = c.in[I_ADAW] + ((size_t)l * DM + kc * 128 + kq * 32) * 12288 + n;
            float4 a[5];
#pragma unroll
            for (int r = 0; r < 5; ++r) a[r] = make_float4(0.f, 0.f, 0.f, 0.f);
#pragma unroll 16
            for (int kk = 0; kk < 32; ++kk) {
                const float4 wv = *(const float4*)(w + (size_t)kk * 12288);
#pragma unroll
                for (int r = 0; r < 5; ++r) { const float sv = S[r * 128 + kq * 32 + kk]; a[r].x += sv * wv.x; a[r].y += sv * wv.y; a[r].z += sv * wv.z; a[r].w += sv * wv.w; }
            }
            float* o = c.MODP + ((size_t)((kc * 4 + kq) * DEPTH + l) * 5) * 12288 + n;
#pragma unroll
            for (int r = 0; r < 5; ++r) *(float4*)(o + (size_t)r * 12288) = a[r];
        }
        __syncthreads();
    }
}

__device__ __forceinline__ void phase_modfin(const Ctx& c) {
    const int total = DEPTH * 5 * 12288;
    for (int i = c.bid * 512 + c.tid; i < total; i += c.G * 512) {
        const int n = i % 12288, l = i / (5 * 12288);
        float s = c.in[I_ADAB][l * 12288 + n];
#pragma unroll
        for (int kc = 0; kc < 64; ++kc) s += c.MODP[(size_t)kc * total + i];
        const int mi = n >> 11, col = n & 2047;
        if (mi == 1) s = c.in[I_NMIX][l * DM + col] * (1.0f + s);
        if (mi == 4) s = c.in[I_NFFN][l * DM + col] * (1.0f + s);
        c.MOD[i] = s;
    }
}

__device__ __forceinline__ void phase_normmod(const Ctx& c, int l, int which, int nrows, int row0 = 0, int b0 = 0, int nb = 0) {
    if (nb == 0) nb = c.G;
    if (c.bid < b0 || c.bid >= b0 + nb) return;
    int row = row0 + (c.bid - b0) * 8 + c.wave;
    if (row >= row0 + nrows) return;
    u32x2 xn[8];
    { const u32x2* xp = (const u32x2*)(c.X + (size_t)row * DM);
#pragma unroll
      for (int i = 0; i < 8; ++i) xn[i] = xp[c.lane + 64 * i]; }
    for (; row < row0 + nrows; row += nb * 8) {
        const int bi = row_bidx(row);
        const float* sh = c.MOD + ((size_t)(l * 5 + bi) * 6 + (which ? 3 : 0)) * DM; const float* sc = sh + DM;
        float4 v[8]; float ss = 0.f;
#pragma unroll
        for (int i = 0; i < 8; ++i) { const u32x2 xw = xn[i]; v[i] = make_float4(bflo(xw.x), bfhi(xw.x), bflo(xw.y), bfhi(xw.y)); ss += v[i].x * v[i].x + v[i].y * v[i].y + v[i].z * v[i].z + v[i].w * v[i].w; }
        float4 s1v[8], s0v[8];
#pragma unroll
        for (int i = 0; i < 8; ++i) { const int e = 4 * (c.lane + 64 * i); s1v[i] = *(const float4*)(sc + e); s0v[i] = *(const float4*)(sh + e); }
        asm volatile("" ::: "memory");
        { const u32x2* xp = (const u32x2*)(c.X + (size_t)min(row + nb * 8, row0 + nrows - 1) * DM);
#pragma unroll
          for (int i = 0; i < 8; ++i) xn[i] = xp[c.lane + 64 * i]; }
        asm volatile("" ::: "memory");
        ss = wave_sum(ss);
        const float rstd = rsqrtf(ss * (1.0f / DM) + EPSN);
        uint2* hp = (uint2*)(c.H + (size_t)row * DM);
        float amax = 0.f;
#pragma unroll
        for (int i = 0; i < 8; ++i) {
            const float4 s1 = s1v[i], s0 = s0v[i];
            const float y0 = v[i].x * rstd * s1.x + s0.x, y1 = v[i].y * rstd * s1.y + s0.y;
            const float y2 = v[i].z * rstd * s1.z + s0.z, y3 = v[i].w * rstd * s1.w + s0.w;
            uint2 o; o.x = pk2(y0, y1); o.y = pk2(y2, y3); hp[c.lane + 64 * i] = o;
            if (which) { v[i] = make_float4(y0, y1, y2, y3); amax = fmaxf(fmaxf(amax, fmaxf(fabsf(y0), fabsf(y1))), fmaxf(fabsf(y2), fabsf(y3))); }
        }
        if (which) {
            amax = fmaxf(amax, __shfl_xor(amax, 32)); amax = fmaxf(amax, __shfl_xor(amax, 16)); amax = fmaxf(amax, __shfl_xor(amax, 8));
            amax = fmaxf(amax, __shfl_xor(amax, 4)); amax = fmaxf(amax, __shfl_xor(amax, 2)); amax = fmaxf(amax, __shfl_xor(amax, 1));
            const float qs = amax > 0.f ? 127.0f / amax : 0.f;
            unsigned* qp = (unsigned*)(c.H8 + (size_t)row * DM);
#pragma unroll
            for (int i = 0; i < 8; ++i) {
                const int q0 = (int)rintf(v[i].x * qs), q1 = (int)rintf(v[i].y * qs), q2 = (int)rintf(v[i].z * qs), q3 = (int)rintf(v[i].w * qs);
                qp[c.lane + 64 * i] = (unsigned)(q0 & 0xFF) | ((unsigned)(q1 & 0xFF) << 8) | ((unsigned)(q2 & 0xFF) << 16) | ((unsigned)(q3 & 0xFF) << 24);
            }
            if (c.lane == 0) c.HSC[row] = amax * (1.0f / 127.0f);
        }
    }
}

struct EpiProj {
    static constexpr bool PERM = true, AFTER_DRAIN = false;
    u16* P; u16* T;
    __device__ __forceinline__ void operator()(const f32x4 (&acc)[2][2][4][2], const pg8::Unit& u, int wr, int wc, int fr, int fq) const {
        u16* base = u.w ? T : P; const int ldc = u.w ? MROWS : NMAIN;
        const int row0 = u.pm * 256 + wr * 64 + fr, col0 = u.pn * 256 + wc * 32 + 8 * fq;
#pragma unroll
        for (int ai = 0; ai < 2; ++ai)
#pragma unroll
            for (int m = 0; m < 4; ++m) { u16* rowp = base + (size_t)(row0 + ai * 128 + m * 16) * ldc + col0;
#pragma unroll
                for (int bj = 0; bj < 2; ++bj) { const f32x4 v0 = acc[ai][bj][m][0], v1 = acc[ai][bj][m][1];
                    u32x4 w; w.x = pk2(v0[0], v0[1]); w.y = pk2(v0[2], v0[3]); w.z = pk2(v1[0], v1[1]); w.w = pk2(v1[2], v1[3]);
                    *(u32x4*)(rowp + bj * 128) = w; } }
    }
};
struct EpiResid {
    static constexpr bool PERM = false, AFTER_DRAIN = false;
    u16* X; const float* modl; int row_off;
    __device__ __forceinline__ void operator()(const f32x4 (&acc)[2][2][4][2], const pg8::Unit& u, int wr, int wc, int fr, int fq) const {
        const int row0 = u.pm * 256 + wr * 64 + fr, col0 = u.pn * 256 + wc * 32 + 4 * fq;
        const int bi = row_bidx(u.pm * 256 + row_off);
        const float* gp = modl + ((size_t)bi * 6 + 2) * DM + col0;
        f32x4 gv[2][2];
#pragma unroll
        for (int bj = 0; bj < 2; ++bj)
#pragma unroll
            for (int n = 0; n < 2; ++n) gv[bj][n] = *(const f32x4*)(gp + bj * 128 + n * 16);
#pragma unroll
        for (int ai = 0; ai < 2; ++ai) {
            u32x2 xv[4][2][2];
#pragma unroll
            for (int m = 0; m < 4; ++m)
#pragma unroll
                for (int bj = 0; bj < 2; ++bj)
#pragma unroll
                    for (int n = 0; n < 2; ++n) xv[m][bj][n] = *(const u32x2*)(X + (size_t)(row0 + ai * 128 + m * 16) * DM + col0 + bj * 128 + n * 16);
            __builtin_amdgcn_sched_barrier(0);
#pragma unroll
            for (int m = 0; m < 4; ++m) { u16* rowp = X + (size_t)(row0 + ai * 128 + m * 16) * DM + col0;
#pragma unroll
                for (int bj = 0; bj < 2; ++bj)
#pragma unroll
                    for (int n = 0; n < 2; ++n) { u32x2* p = (u32x2*)(rowp + bj * 128 + n * 16); const u32x2 xw = xv[m][bj][n]; const f32x4 r = (f32x4){bflo(xw.x), bfhi(xw.x), bflo(xw.y), bfhi(xw.y)} + gv[bj][n] * acc[ai][bj][m][n];
                        *p = (u32x2){pk2(r[0], r[1]), pk2(r[2], r[3])}; } }
            __builtin_amdgcn_sched_barrier(0);
        }
    }
};
struct EpiGlu {
    static constexpr bool PERM = true, AFTER_DRAIN = false;
    const u16* Y; u16* O; const float* bias;
    __device__ __forceinline__ void operator()(const f32x4 (&acc)[2][2][4][2], const pg8::Unit& u, int wr, int wc, int fr, int fq) const {
        const int row0 = u.pm * 256 + wr * 64 + fr, col0 = u.pn * 256 + wc * 32 + 8 * fq;
        f32x4 bv[2][2];
#pragma unroll
        for (int bj = 0; bj < 2; ++bj)
#pragma unroll
            for (int n = 0; n < 2; ++n) bv[bj][n] = *(const f32x4*)(bias + col0 + bj * 128 + 4 * n);
#pragma unroll
        for (int ai = 0; ai < 2; ++ai) {
            u32x4 yq[4][2];
#pragma unroll
            for (int m = 0; m < 4; ++m)
#pragma unroll
                for (int bj = 0; bj < 2; ++bj) yq[m][bj] = *(const u32x4*)(Y + (size_t)(row0 + ai * 128 + m * 16) * 512 + col0 + bj * 128);
            __builtin_amdgcn_sched_barrier(0);
#pragma unroll
            for (int m = 0; m < 4; ++m) { const size_t off = (size_t)(row0 + ai * 128 + m * 16) * 512 + col0;
#pragma unroll
                for (int bj = 0; bj < 2; ++bj) {
                    const u32x4 yv = yq[m][bj];
                    const f32x4 v0 = acc[ai][bj][m][0] + bv[bj][0], v1 = acc[ai][bj][m][1] + bv[bj][1];
                    float y[8] = {bflo(yv.x), bfhi(yv.x), bflo(yv.y), bfhi(yv.y), bflo(yv.z), bfhi(yv.z), bflo(yv.w), bfhi(yv.w)};
                    float z[8] = {v0[0], v0[1], v0[2], v0[3], v1[0], v1[1], v1[2], v1[3]};
#pragma unroll
                    for (int j = 0; j < 8; ++j) y[j] = y[j] / (1.0f + __expf(-z[j]));
                    u32x4 w; w.x = pk2(y[0], y[1]); w.y = pk2(y[2], y[3]); w.z = pk2(y[4], y[5]); w.w = pk2(y[6], y[7]);
                    *(u32x4*)(O + off + bj * 128) = w; } }
            __builtin_amdgcn_sched_barrier(0);
        }
    }
};

constexpr int AT_KC_STRIDE = 272, AT_VC_STRIDE = 528;
constexpr int AT_KC_OFF = 0, AT_VC_OFF = 256 * AT_KC_STRIDE, AT_BT_OFF = AT_VC_OFF + 128 * AT_VC_STRIDE, AT_END = AT_BT_OFF + 15 * 64 * 4;
static_assert(AT_END <= LDS_BARW, "attention LDS");
__device__ __forceinline__ void attn_block_load(const Ctx& c, int l, int b, int head) {
    const int tid = c.tid;
    __syncthreads();
    u32x4 tk[8], tv[8];
#pragma unroll
    for (int i = 0; i < 8; ++i) { const int e = tid + 512 * i, key = e >> 4, ch = e & 15; tk[i] = *(const u32x4*)(c.PROJ + (size_t)(NLAT + b * CTXL + key) * NMAIN + PJ_K + head * 128 + ch * 8); }
#pragma unroll
    for (int i = 0; i < 8; ++i) { const int e = tid + 512 * i, d = e >> 5, ch = e & 31; tv[i] = *(const u32x4*)(c.TR + (size_t)(TR_V + head * 128 + d) * MROWS + NLAT + b * CTXL + ch * 8); }
#pragma unroll
    for (int i = 0; i < 8; ++i) { const int e = tid + 512 * i, key = e >> 4, ch = e & 15; *(LAS u32x4*)(c.lds + AT_KC_OFF + key * AT_KC_STRIDE + ch * 16) = tk[i]; }
#pragma unroll
    for (int i = 0; i < 8; ++i) { const int e = tid + 512 * i, d = e >> 5, ch = e & 31; *(LAS u32x4*)(c.lds + AT_VC_OFF + d * AT_VC_STRIDE + ch * 16) = tv[i]; }
    LAS float* BT = (LAS float*)(c.lds + AT_BT_OFF);
    const float* src = c.in[I_RPB] + (size_t)(l * 8 + head) * 465;
    for (int i = tid; i < 15 * 64; i += 512) { const int col = (i & 63) - 16, row = i >> 6; BT[i] = (col >= 0 && col < 31) ? src[row * 31 + col] : 0.f; }
    __syncthreads();
}
template <bool WINDOW>
__device__ __forceinline__ void attn_segment(const Ctx& c, int b, int r, int head, int qt, int r_start, int cbase, const bf16x8 (&qf)[4], f32x4 (&O)[8], float& mrun, float& lrun) {
    const int lane = c.lane, n = lane & 15, lg = lane >> 4;
    f32x4 S[8][2];
    if (WINDOW) {
        const u16* kp0 = c.PROJ + (size_t)(b * SEQL + r_start * 64 + cbase + 8 * (n >> 2) + (n & 3)) * NMAIN + PJ_K + head * 128 + 8 * lg;
#pragma unroll
        for (int gi = 0; gi < 8; ++gi) {
            bf16x8 kf[2][4];
#pragma unroll
            for (int t = 0; t < 2; ++t)
#pragma unroll
                for (int kk = 0; kk < 4; ++kk) kf[t][kk] = *(const bf16x8*)(kp0 + (size_t)(gi * 64 + 4 * t) * NMAIN + 32 * kk);
            __builtin_amdgcn_sched_barrier(0);
#pragma unroll
            for (int t = 0; t < 2; ++t) {
                f32x4 acc = {0.f, 0.f, 0.f, 0.f};
#pragma unroll
                for (int kk = 0; kk < 4; ++kk) acc = __builtin_amdgcn_mfma_f32_16x16x32_bf16(kf[t][kk], qf[kk], acc, 0, 0, 0);
                S[gi][t] = acc;
            }
            __builtin_amdgcn_sched_barrier(0);
        }
    } else {
#pragma unroll
        for (int gi = 0; gi < 8; ++gi) {
#pragma unroll
            for (int t = 0; t < 2; ++t) {
                const int ko = 8 * (n >> 2) + 4 * t + (n & 3);
                f32x4 acc = {0.f, 0.f, 0.f, 0.f};
                const LAS unsigned char* kp = c.lds + AT_KC_OFF + (32 * gi + ko) * AT_KC_STRIDE + 16 * lg;
#pragma unroll
                for (int kk = 0; kk < 4; ++kk) { const bf16x8 a = *(const LAS bf16x8*)(kp + 64 * kk); acc = __builtin_amdgcn_mfma_f32_16x16x32_bf16(a, qf[kk], acc, 0, 0, 0); }
                S[gi][t] = acc;
            }
        }
    }
    const float scale = 0.08838834764831845f;
    float mx = -3.0e38f;
    const int qc = 16 * qt + n, cs = min(max(qc - 8, 0), 48);
    const LAS float* BT = (const LAS float*)(c.lds + AT_BT_OFF);
    const int btbase = WINDOW ? (r_start - r + 7) * 64 + (cbase + 8 * lg - qc + 15 + 16) : 0;
#pragma unroll
    for (int gi = 0; gi < 8; ++gi)
#pragma unroll
        for (int t = 0; t < 2; ++t)
#pragma unroll
            for (int rr = 0; rr < 4; ++rr) {
                float s = S[gi][t][rr] * scale;
                if (WINDOW) {
                    const int kc = cbase + 8 * lg + 4 * t + rr;
                    const bool valid = (kc >= cs) && (kc < cs + 16);
                    const float bias = BT[btbase + gi * 64 + 4 * t + rr];
                    s = valid ? s + bias : -INFINITY;
                }
                S[gi][t][rr] = s; mx = fmaxf(mx, s);
            }
    mx = fmaxf(mx, __shfl_xor(mx, 16)); mx = fmaxf(mx, __shfl_xor(mx, 32));
    const float mnew = fmaxf(mrun, mx), resc = exp2f((mrun - mnew) * 1.4426950408889634f);
    float sum = 0.f;
#pragma unroll
    for (int gi = 0; gi < 8; ++gi)
#pragma unroll
        for (int t = 0; t < 2; ++t)
#pragma unroll
            for (int rr = 0; rr < 4; ++rr) { const float p = exp2f((S[gi][t][rr] - mnew) * 1.4426950408889634f); S[gi][t][rr] = p; sum += p; }
    sum += __shfl_xor(sum, 16); sum += __shfl_xor(sum, 32);
    lrun = lrun * resc + sum; mrun = mnew;
#pragma unroll
    for (int dt = 0; dt < 8; ++dt) O[dt] *= resc;
    if (WINDOW) {
        const u16* vp0 = c.TR + (size_t)(TR_V + head * 128 + n) * MROWS + (b * SEQL + r_start * 64 + cbase) + 8 * lg;
#pragma unroll
        for (int gi = 0; gi < 8; ++gi) {
            u32x4 pw; pw.x = pk2(S[gi][0][0], S[gi][0][1]); pw.y = pk2(S[gi][0][2], S[gi][0][3]); pw.z = pk2(S[gi][1][0], S[gi][1][1]); pw.w = pk2(S[gi][1][2], S[gi][1][3]);
            const bf16x8 pb = __builtin_bit_cast(bf16x8, pw);
            bf16x8 vf[8];
#pragma unroll
            for (int dt = 0; dt < 8; ++dt) vf[dt] = *(const bf16x8*)(vp0 + (size_t)(16 * dt) * MROWS + gi * 64);
            __builtin_amdgcn_sched_barrier(0);
#pragma unroll
            for (int dt = 0; dt < 8; ++dt) O[dt] = __builtin_amdgcn_mfma_f32_16x16x32_bf16(vf[dt], pb, O[dt], 0, 0, 0);
            __builtin_amdgcn_sched_barrier(0);
        }
    } else {
#pragma unroll
        for (int gi = 0; gi < 8; ++gi) {
            u32x4 pw; pw.x = pk2(S[gi][0][0], S[gi][0][1]); pw.y = pk2(S[gi][0][2], S[gi][0][3]); pw.z = pk2(S[gi][1][0], S[gi][1][1]); pw.w = pk2(S[gi][1][2], S[gi][1][3]);
            const bf16x8 pb = __builtin_bit_cast(bf16x8, pw);
            const LAS unsigned char* vp = c.lds + AT_VC_OFF + n * AT_VC_STRIDE + (32 * gi + 8 * lg) * 2;
#pragma unroll
            for (int dt = 0; dt < 8; ++dt) { const bf16x8 va = *(const LAS bf16x8*)(vp + 16 * dt * AT_VC_STRIDE); O[dt] = __builtin_amdgcn_mfma_f32_16x16x32_bf16(va, pb, O[dt], 0, 0, 0); }
        }
    }
}
template <bool LOCAL>
__device__ __forceinline__ void attn_item(const Ctx& c, int b, int r, int head, int qt) {
    const int lane = c.lane, n = lane & 15, lg = lane >> 4;
    const int qrow0 = LOCAL ? (b * SEQL + r * 64 + 16 * qt) : (NLAT + b * CTXL + 16 * qt);
    const int r_start = LOCAL ? min(max(r - 4, 0), 56) : 0;
    const int cbase = LOCAL ? (qt == 0 ? 0 : (qt == 1 ? 8 : (qt == 2 ? 24 : 32))) : 0;
    bf16x8 qf[4];
    { const u16* qp = c.PROJ + (size_t)(qrow0 + n) * NMAIN + PJ_Q + head * 128 + 8 * lg;
#pragma unroll
      for (int kk = 0; kk < 4; ++kk) qf[kk] = *(const bf16x8*)(qp + 32 * kk); }
    f32x4 O[8];
#pragma unroll
    for (int dt = 0; dt < 8; ++dt) O[dt] = (f32x4){0.f, 0.f, 0.f, 0.f};
    float mrun = -3.0e38f, lrun = 0.f;
    attn_segment<false>(c, b, r, head, qt, r_start, cbase, qf, O, mrun, lrun);
    if (LOCAL) attn_segment<true>(c, b, r, head, qt, r_start, cbase, qf, O, mrun, lrun);
    const float inv = 1.0f / lrun;
    u16* op = c.ATT + (size_t)(qrow0 + n) * 1024 + head * 128 + 4 * lg;
#pragma unroll
    for (int dt = 0; dt < 8; ++dt) { uint2 o; o.x = pk2(O[dt][0] * inv, O[dt][1] * inv); o.y = pk2(O[dt][2] * inv, O[dt][3] * inv); *(uint2*)(op + 16 * dt) = o; }
}
__device__ __forceinline__ void phase_attention(const Ctx& c, int l, bool last) {
    for (int bh = c.bid; bh < 256; bh += c.G) {
        const int b = bh >> 6, head = (bh >> 3) & 7, sub = bh & 7;
        attn_block_load(c, l, b, head);
#pragma unroll 1
        for (int i = 0; i < 4; ++i) { const int item = c.wave + 8 * i; attn_item<true>(c, b, sub * 8 + (item >> 2), head, item & 3); }
        if (!last && c.wave < 2) attn_item<false>(c, b, 0, head, sub * 2 + c.wave);
    }
    __syncthreads();
}

__device__ __forceinline__ void sgu_item(const Ctx& c, int l, int chunk) {
    const int tid = c.tid, lane = c.lane, n = lane & 15, lg = lane >> 4;
    const int tok0 = chunk < 128 ? chunk * 128 : NLAT + (chunk - 128) * 128;
    LAS float* part = (LAS float*)c.lds;
    LAS float* rstd = part + 32 * 128;
    __syncthreads();
    {
        const int sg = tid & 15, cg = tid >> 4;
        float a[8];
#pragma unroll
        for (int j = 0; j < 8; ++j) a[j] = 0.f;
        u32x4 vv[16];
#pragma unroll
        for (int cc = 0; cc < 16; ++cc) vv[cc] = *(const u32x4*)(c.TR + (size_t)(TR_SV + cg * 16 + cc) * MROWS + tok0 + 8 * sg);
        __builtin_amdgcn_sched_barrier(0);
#pragma unroll
        for (int cc = 0; cc < 16; ++cc) {
            const u32x4 v = vv[cc];
            const float x[8] = {bflo(v.x), bfhi(v.x), bflo(v.y), bfhi(v.y), bflo(v.z), bfhi(v.z), bflo(v.w), bfhi(v.w)};
#pragma unroll
            for (int j = 0; j < 8; ++j) { const float g = gelu_f(x[j]); a[j] += g * g; }
        }
#pragma unroll
        for (int j = 0; j < 8; ++j) part[cg * 128 + 8 * sg + j] = a[j];
    }
    __syncthreads();
    if (tid < 128) { float s = 0.f; for (int cg = 0; cg < 32; ++cg) s += part[cg * 128 + tid]; rstd[tid] = rsqrtf(s * (1.0f / 512.0f) + EPSN); }
    __syncthreads();
    const int hs = c.wave >> 1, th = c.wave & 1;
    const u16* wsp = (const u16*)(c.wl(l) + WL_SGUW) + ((size_t)hs * 128) * 128;
    const float* gn = c.in[I_SGUN] + (size_t)l * 512 + hs * 128;
    const float* bsp = c.in[I_SGUB] + (size_t)(l * 4 + hs) * 128;
#pragma unroll 1
    for (int ch = 0; ch < 2; ++ch) {
        f32x4 acc[4][4];
#pragma unroll
        for (int mt = 0; mt < 4; ++mt)
#pragma unroll
            for (int ct = 0; ct < 4; ++ct) acc[mt][ct] = (f32x4){0.f, 0.f, 0.f, 0.f};
        float gcv[4];
#pragma unroll
        for (int ct = 0; ct < 4; ++ct) gcv[ct] = gn[64 * ch + 16 * ct + n];
        bf16x8 afN[4]; u32x4 vN[4];
#pragma unroll
        for (int mt = 0; mt < 4; ++mt) afN[mt] = *(const bf16x8*)(wsp + (size_t)(64 * th + 16 * mt + n) * 128 + 8 * lg);
#pragma unroll
        for (int ct = 0; ct < 4; ++ct) vN[ct] = *(const u32x4*)(c.TR + (size_t)(TR_SV + hs * 128 + 64 * ch + 16 * ct + n) * MROWS + tok0 + 8 * lg);
#pragma unroll 1
        for (int kk = 0; kk < 4; ++kk) {
            bf16x8 af[4]; u32x4 vq[4];
#pragma unroll
            for (int q = 0; q < 4; ++q) { af[q] = afN[q]; vq[q] = vN[q]; }
            { const int kn = kk < 3 ? kk + 1 : 3;
#pragma unroll
              for (int mt = 0; mt < 4; ++mt) afN[mt] = *(const bf16x8*)(wsp + (size_t)(64 * th + 16 * mt + n) * 128 + 32 * kn + 8 * lg);
#pragma unroll
              for (int ct = 0; ct < 4; ++ct) vN[ct] = *(const u32x4*)(c.TR + (size_t)(TR_SV + hs * 128 + 64 * ch + 16 * ct + n) * MROWS + tok0 + 32 * kn + 8 * lg); }
            __builtin_amdgcn_sched_barrier(0);
            const f32x4 r0 = *(const LAS f32x4*)(rstd + 32 * kk + 8 * lg), r1 = *(const LAS f32x4*)(rstd + 32 * kk + 8 * lg + 4);
#pragma unroll
            for (int ct = 0; ct < 4; ++ct) {
                const u32x4 v = vq[ct];
                const float gc = gcv[ct];
                const float x0 = gelu_f(bflo(v.x)) * r0[0] * gc, x1 = gelu_f(bfhi(v.x)) * r0[1] * gc, x2 = gelu_f(bflo(v.y)) * r0[2] * gc, x3 = gelu_f(bfhi(v.y)) * r0[3] * gc;
                const float x4 = gelu_f(bflo(v.z)) * r1[0] * gc, x5 = gelu_f(bfhi(v.z)) * r1[1] * gc, x6 = gelu_f(bflo(v.w)) * r1[2] * gc, x7 = gelu_f(bfhi(v.w)) * r1[3] * gc;
                u32x4 pw; pw.x = pk2(x0, x1); pw.y = pk2(x2, x3); pw.z = pk2(x4, x5); pw.w = pk2(x6, x7);
                const bf16x8 bfr = __builtin_bit_cast(bf16x8, pw);
#pragma unroll
                for (int mt = 0; mt < 4; ++mt) acc[mt][ct] = __builtin_amdgcn_mfma_f32_16x16x32_bf16(bfr, af[mt], acc[mt][ct], 0, 0, 0);
            }
        }
        float bsv[4]; u32x2 swv[4][4];
#pragma unroll
        for (int mt = 0; mt < 4; ++mt) {
            bsv[mt] = bsp[64 * th + 16 * mt + n];
#pragma unroll
            for (int ct = 0; ct < 4; ++ct) swv[mt][ct] = *(const u32x2*)(c.PROJ + (size_t)(tok0 + 64 * th + 16 * mt + n) * NMAIN + PJ_SU + hs * 128 + 64 * ch + 16 * ct + 4 * lg);
        }
        __builtin_amdgcn_sched_barrier(0);
#pragma unroll
        for (int mt = 0; mt < 4; ++mt) {
            const int t = 64 * th + 16 * mt + n; const float bs = bsv[mt];
            const size_t row = (size_t)(tok0 + t);
#pragma unroll
            for (int ct = 0; ct < 4; ++ct) {
                const int col = hs * 128 + 64 * ch + 16 * ct + 4 * lg;
                const u32x2 sw = swv[mt][ct];
                const f32x4 a = acc[mt][ct];
                *(u32x2*)(c.SGU + row * 512 + col) = (u32x2){pk2(gelu_f(bflo(sw.x)) * (a[0] + bs), gelu_f(bfhi(sw.x)) * (a[1] + bs)), pk2(gelu_f(bflo(sw.y)) * (a[2] + bs), gelu_f(bfhi(sw.y)) * (a[3] + bs))};
            }
        }
    }
}

__device__ __forceinline__ int s5_row(int dir, int b, int q) {
    if (dir == 0) return q < CTXL ? NLAT + b * CTXL + q : b * SEQL + (q - CTXL);
    return q < CTXL ? NLAT + b * CTXL + (CTXL - 1 - q) : b * SEQL + (SEQL - 1 - (q - CTXL));
}
__device__ __forceinline__ void s5_disc(const Ctx& c, int l, int dir, int grp, int p, float& lr, float& li, float (&bbr)[16], float (&bbi)[16]) {
    const size_t gp = ((size_t)(l * 2 + dir) * 32 + grp) * 64 + p;
    const float are = fminf(c.in[I_ARE][gp], -1e-4f), aim = c.in[I_AIM][gp];
    const float dt = expf(c.in[I_LOGDT][(size_t)(l * 2 + dir) * 32 + grp]);
    const float mag = expf(are * dt); float sn, cs; sincosf(aim * dt, &sn, &cs);
    lr = mag * cs; li = mag * sn;
    const float den = 1.0f / (are * are + aim * aim), nr = lr - 1.0f;
    const float cr = (nr * are + li * aim) * den, ci = (li * are - nr * aim) * den;
    const float* br = c.in[I_BRE] + gp * 16; const float* bi = c.in[I_BIM] + gp * 16;
#pragma unroll
    for (int q4 = 0; q4 < 4; ++q4) {
        const float4 a = *(const float4*)(br + 4 * q4), b = *(const float4*)(bi + 4 * q4);
        bbr[4 * q4 + 0] = cr * a.x - ci * b.x; bbi[4 * q4 + 0] = cr * b.x + ci * a.x;
        bbr[4 * q4 + 1] = cr * a.y - ci * b.y; bbi[4 * q4 + 1] = cr * b.y + ci * a.y;
        bbr[4 * q4 + 2] = cr * a.z - ci * b.z; bbi[4 * q4 + 2] = cr * b.z + ci * a.z;
        bbr[4 * q4 + 3] = cr * a.w - ci * b.w; bbi[4 * q4 + 3] = cr * b.w + ci * a.w;
    }
}
__device__ __forceinline__ void s5_load_u(const Ctx& c, LAS float* U, int row, int grp) {
    const u32x4* sp = (const u32x4*)(c.PROJ + (size_t)row * NMAIN + PJ_SIN + 16 * grp);
    const u32x4 a = sp[0], b = sp[1];
    LAS u32x4* up = (LAS u32x4*)(U + c.lane * 8);
    up[0] = a; up[1] = b;
    lds_fence();
}
__device__ __forceinline__ float s5_u(LAS const float* U, int tok, int ch) { const unsigned w = ((const LAS unsigned*)U)[tok * 8 + (ch >> 1)]; return (ch & 1) ? bfhi(w) : bflo(w); }
typedef float f2s __attribute__((ext_vector_type(2)));
typedef __bf16 bf2s __attribute__((ext_vector_type(2)));
__device__ __forceinline__ float dot2s(unsigned a, unsigned b, float c) { return __builtin_amdgcn_fdot2_f32_bf16(__builtin_bit_cast(bf2s, a), __builtin_bit_cast(bf2s, b), c, false); }
__device__ __forceinline__ void s5_drive4(LAS const float* U, int tok0, int dt, const unsigned (&pr)[8], const unsigned (&pi)[8], f2s (&d)[4]) {
    u32x4 u[4][2];
#pragma unroll
    for (int k = 0; k < 4; ++k) { const LAS u32x4* up = (const LAS u32x4*)(U + (tok0 + dt * k) * 8); u[k][0] = up[0]; u[k][1] = up[1]; }
    asm volatile("" ::: "memory");
#pragma unroll
    for (int k = 0; k < 4; ++k) {
        const unsigned w[8] = {u[k][0].x, u[k][0].y, u[k][0].z, u[k][0].w, u[k][1].x, u[k][1].y, u[k][1].z, u[k][1].w};
        float r0 = 0.f, r1 = 0.f, i0 = 0.f, i1 = 0.f;
#pragma unroll
        for (int q = 0; q < 4; ++q) { r0 = dot2s(pr[q], w[q], r0); r1 = dot2s(pr[4 + q], w[4 + q], r1); i0 = dot2s(pi[q], w[q], i0); i1 = dot2s(pi[4 + q], w[4 + q], i1); }
        d[k] = (f2s){r0 + r1, i0 + i1};
    }
}
constexpr int S5P1_X = 7;
__device__ __forceinline__ void phase_s5_pass1(const Ctx& c, int l) {
    const int gw = c.bid * 8 + c.wave, nw = c.G * 8;
    LAS float* U = (LAS float*)(c.lds + c.wave * 4096);
    const int nslot = nw >> 6;
    if (nslot < 1 || (gw >> 6) >= nslot) return;
    const int gd = gw & 63, grp = gd >> 1, dir = gd & 1, slot = gw >> 6;
    float lr, li, bbr[16], bbi[16];
    s5_disc(c, l, dir, grp, c.lane, lr, li, bbr, bbi);
    unsigned pr[8], pi[8];
#pragma unroll
    for (int k = 0; k < 8; ++k) { pr[k] = pk2(bbr[2 * k], bbr[2 * k + 1]); pi[k] = pk2(bbi[2 * k], bbi[2 * k + 1]); }
    int i0, i1;
    if (nslot == 32) { constexpr int X = S5P1_X, REM = 272 - 17 * X, Q = REM / 15, R = REM % 15;
        if (slot < 17) { i0 = X * slot; i1 = i0 + X; } else { const int f = slot - 17; i0 = 17 * X + f * Q + min(f, R); i1 = i0 + Q + (f < R ? 1 : 0); } }
    else { const int per = (NB * NCHK + nslot - 1) / nslot; i0 = min(slot * per, NB * NCHK); i1 = min(i0 + per, NB * NCHK); }
    if (i0 >= i1) return;
    u32x4 na, nb;
    { const u32x4* sp = (const u32x4*)(c.PROJ + (size_t)s5_row(dir, i0 / NCHK, 64 * (i0 % NCHK) + c.lane) * NMAIN + PJ_SIN + 16 * grp); na = sp[0]; nb = sp[1]; }
#pragma unroll 1
    for (int bn = i0; bn < i1; ++bn) {
        const u32x4 a = na, b = nb;
        { const int bq = min(bn + 1, NB * NCHK - 1);
          const u32x4* sp = (const u32x4*)(c.PROJ + (size_t)s5_row(dir, bq / NCHK, 64 * (bq % NCHK) + c.lane) * NMAIN + PJ_SIN + 16 * grp); na = sp[0]; nb = sp[1]; }
        lds_fence();
        { LAS u32x4* up = (LAS u32x4*)(U + c.lane * 8); up[0] = a; up[1] = b; }
        lds_fence();
        float hr = 0.f, hi = 0.f;
#pragma unroll 1
        for (int j = 0; j < 64; j += 4) {
            f2s d[4]; s5_drive4(U, j, 1, pr, pi, d);
#pragma unroll
            for (int k = 0; k < 4; ++k) { const float nr = lr * hr - li * hi + d[k].x, ni = lr * hi + li * hr + d[k].y; hr = nr; hi = ni; }
        }
        c.SLOC[((size_t)(((bn / NCHK) * 32 + grp) * 2 + dir) * NCHK + (bn % NCHK)) * 64 + c.lane] = (f32x2v){hr, hi};
    }
}
constexpr int S5_HS = 272;
template <int DIR, int HALF>
__device__ __forceinline__ void s5_half(LAS const float* U, LAS unsigned char* Hb, float lr, float li, const unsigned (&pr)[8], const unsigned (&pi)[8], float& hr, float& hi,
                                        const bf16x8 (&cf)[4], f32x4 (&acc)[4], int lane, int n, int lg) {
#pragma unroll 1
    for (int jj = 0; jj < 32; jj += 4) {
        const int j = 32 * HALF + jj, tok0 = DIR ? 63 - j : j;
        f2s d[4]; s5_drive4(U, tok0, DIR ? -1 : 1, pr, pi, d);
#pragma unroll
        for (int k = 0; k < 4; ++k) {
            const float nr = lr * hr - li * hi + d[k].x, ni = lr * hi + li * hr + d[k].y; hr = nr; hi = ni;
            const int tok = DIR ? tok0 - k : tok0 + k;
            *(LAS unsigned*)(Hb + (tok & 31) * S5_HS + 4 * lane) = pk2(hr, hi);
        }
    }
    lds_fence();
    constexpr int MTB = DIR ? (2 - 2 * HALF) : (2 * HALF);
#pragma unroll
    for (int mi = 0; mi < 2; ++mi)
#pragma unroll
        for (int kk = 0; kk < 4; ++kk) {
            const bf16x8 a = *(const LAS bf16x8*)(Hb + (16 * mi + n) * S5_HS + (32 * kk + 8 * lg) * 2);
            acc[MTB + mi] = __builtin_amdgcn_mfma_f32_16x16x32_bf16(a, cf[kk], acc[MTB + mi], 0, 0, 0);
        }
    lds_fence();
}
template <int DIR>
__device__ __forceinline__ void s5_pass3_dir(const Ctx& c, int l, bool last, int grp, int slot, int nslot, LAS float* U, LAS unsigned char* Hb, float* scratch) {
    const int lane = c.lane, n = lane & 15, lg = lane >> 4;
    float lr, li, bbr[16], bbi[16];
    s5_disc(c, l, DIR, grp, lane, lr, li, bbr, bbi);
    unsigned pr[8], pi[8];
#pragma unroll
    for (int k = 0; k < 8; ++k) { pr[k] = pk2(bbr[2 * k], bbr[2 * k + 1]); pi[k] = pk2(bbi[2 * k], bbi[2 * k + 1]); }
    bf16x8 cf[4];
    {
        const size_t cb = (((size_t)(l * 2 + DIR) * 32 + grp) * 16 + n) * 64;
#pragma unroll
        for (int kk = 0; kk < 4; ++kk) {
            const float4 re = *(const float4*)(c.in[I_CRE] + cb + 16 * kk + 4 * lg), im = *(const float4*)(c.in[I_CIM] + cb + 16 * kk + 4 * lg);
            u32x4 pw; pw.x = pk2(re.x, -im.x); pw.y = pk2(re.y, -im.y); pw.z = pk2(re.z, -im.z); pw.w = pk2(re.w, -im.w);
            cf[kk] = __builtin_bit_cast(bf16x8, pw);
        }
    }
    float tr = lr, ti = li;
#pragma unroll
    for (int s = 0; s < 6; ++s) { const float a = tr * tr - ti * ti, bq = 2.0f * tr * ti; tr = a; ti = bq; }
    const float dv = c.in[I_S5D][(size_t)l * 512 + 16 * grp + n];
    const int nitems = last ? NB * 64 : NB * NCHK;
#pragma unroll 1
    for (int idx = slot; idx < nitems; idx += nslot) {
        const int b = last ? (idx >> 6) : idx / NCHK, tc = last ? (idx & 63) : idx % NCHK;
        const int rowbase = tc < 64 ? b * SEQL + 64 * tc : NLAT + b * CTXL + 64 * (tc - 64);
        lds_fence();
        s5_load_u(c, U, rowbase + lane, grp);
        const int nchunk = tc < 64 ? (DIR == 0 ? 4 + tc : 4 + 63 - tc) : (DIR == 0 ? tc - 64 : 3 - (tc - 64));
        float hr = 0.f, hi = 0.f;
        {
            const f32x2v* sp = c.SLOC + ((size_t)((b * 32 + grp) * 2 + DIR) * NCHK) * 64 + lane;
#pragma unroll 1
            for (int m0 = 0; m0 < nchunk; m0 += 8) {
                f32x2v sv[8];
#pragma unroll
                for (int q = 0; q < 8; ++q) sv[q] = sp[(size_t)min(m0 + q, nchunk - 1) * 64];
#pragma unroll
                for (int q = 0; q < 8; ++q) if (m0 + q < nchunk) { const float nr = hr * tr - hi * ti + sv[q].x, ni = hr * ti + hi * tr + sv[q].y; hr = nr; hi = ni; }
            }
        }
        f32x4 acc[4];
#pragma unroll
        for (int i = 0; i < 4; ++i) acc[i] = (f32x4){0.f, 0.f, 0.f, 0.f};
        s5_half<DIR, 0>(U, Hb, lr, li, pr, pi, hr, hi, cf, acc, lane, n, lg);
        s5_half<DIR, 1>(U, Hb, lr, li, pr, pi, hr, hi, cf, acc, lane, n, lg);
        f32x4* sc = (f32x4*)(scratch + ((size_t)(grp * NB * NCHK + idx) * 64 + lane) * 16);
        if (DIR == 0) {
#pragma unroll
            for (int i = 0; i < 4; ++i) sc[i] = acc[i];
        } else {
#pragma unroll
            for (int mt = 0; mt < 4; ++mt) {
                const f32x4 p0 = sc[mt];
#pragma unroll
                for (int rr = 0; rr < 4; ++rr) {
                    const int tok = 16 * mt + 4 * lg + rr;
                    const float y = acc[mt][rr] + p0[rr] + dv * s5_u(U, tok, n);
                    c.S5Y[(size_t)(rowbase + tok) * 512 + 16 * grp + n] = f2bf(gelu_f(y));
                }
            }
        }
    }
}
__device__ __forceinline__ void phase_s5_pass3(const Ctx& c, int l, bool last) {
    const int gw = c.bid * 8 + c.wave, nw = c.G * 8;
    LAS float* U = (LAS float*)(c.lds + c.wave * 4096); LAS unsigned char* Hb = c.lds + 32768 + c.wave * (32 * S5_HS);
    const int nslot = nw >> 5;
    if (nslot < 1 || (gw >> 5) >= nslot) return;
    const int grp = gw & 31, slot = gw >> 5;
    float* scratch = (float*)c.PART;
    s5_pass3_dir<0>(c, l, last, grp, slot, nslot, U, Hb, scratch);
    asm volatile("s_waitcnt vmcnt(0)" ::: "memory");
    s5_pass3_dir<1>(c, l, last, grp, slot, nslot, U, Hb, scratch);
}

__device__ __forceinline__ void phase_merge(const Ctx& c, int l, int nrows) {
    const float* gn = c.in[I_ONORM] + (size_t)l * DM;
    const int lane = c.lane;
    int row = c.bid * 8 + c.wave;
    if (row >= nrows) return;
    u32x4 na0 = *(const u32x4*)(c.ATT + (size_t)row * 1024 + 8 * lane), na1 = *(const u32x4*)(c.ATT + (size_t)row * 1024 + 512 + 8 * lane);
    u32x4 ns0 = *(const u32x4*)(c.SGU + (size_t)row * 512 + 8 * lane), nz0 = *(const u32x4*)(c.S5O + (size_t)row * 512 + 8 * lane);
    f32x4 gv[8];
#pragma unroll
    for (int q = 0; q < 4; ++q) { gv[2 * q] = *(const f32x4*)(gn + 512 * q + 8 * lane); gv[2 * q + 1] = *(const f32x4*)(gn + 512 * q + 8 * lane + 4); }
    for (; row < nrows; row += c.G * 8) {
        const u32x4 a0 = na0, a1 = na1, s0 = ns0, z0 = nz0;
        { const size_t rn = (size_t)min(row + c.G * 8, nrows - 1);
          na0 = *(const u32x4*)(c.ATT + rn * 1024 + 8 * lane); na1 = *(const u32x4*)(c.ATT + rn * 1024 + 512 + 8 * lane);
          ns0 = *(const u32x4*)(c.SGU + rn * 512 + 8 * lane); nz0 = *(const u32x4*)(c.S5O + rn * 512 + 8 * lane); }
        float va[16] = {bflo(a0.x), bfhi(a0.x), bflo(a0.y), bfhi(a0.y), bflo(a0.z), bfhi(a0.z), bflo(a0.w), bfhi(a0.w), bflo(a1.x), bfhi(a1.x), bflo(a1.y), bfhi(a1.y), bflo(a1.z), bfhi(a1.z), bflo(a1.w), bfhi(a1.w)};
        float vs[8] = {bflo(s0.x), bfhi(s0.x), bflo(s0.y), bfhi(s0.y), bflo(s0.z), bfhi(s0.z), bflo(s0.w), bfhi(s0.w)};
        float vz[8] = {bflo(z0.x), bfhi(z0.x), bflo(z0.y), bfhi(z0.y), bflo(z0.z), bfhi(z0.z), bflo(z0.w), bfhi(z0.w)};
        float sa = 0.f, ss = 0.f, sz = 0.f;
#pragma unroll
        for (int j = 0; j < 16; ++j) sa += va[j] * va[j];
#pragma unroll
        for (int j = 0; j < 8; ++j) { ss += vs[j] * vs[j]; sz += vz[j] * vz[j]; }
        sa = wave_sum(sa); ss = wave_sum(ss); sz = wave_sum(sz);
        const float ra = rsqrtf(sa * (1.0f / 1024.0f) + EPSN), rs = rsqrtf(ss * (1.0f / 512.0f) + EPSN), rz = rsqrtf(sz * (1.0f / 512.0f) + EPSN);
        u16* yp = c.YIN + (size_t)row * DM;
        {   const float g[8] = {gv[0][0], gv[0][1], gv[0][2], gv[0][3], gv[1][0], gv[1][1], gv[1][2], gv[1][3]}; u32x4 o;
            o.x = pk2(va[0] * ra * g[0], va[1] * ra * g[1]); o.y = pk2(va[2] * ra * g[2], va[3] * ra * g[3]); o.z = pk2(va[4] * ra * g[4], va[5] * ra * g[5]); o.w = pk2(va[6] * ra * g[6], va[7] * ra * g[7]);
            *(u32x4*)(yp + 8 * lane) = o; }
        {   const float g[8] = {gv[2][0], gv[2][1], gv[2][2], gv[2][3], gv[3][0], gv[3][1], gv[3][2], gv[3][3]}; u32x4 o;
            o.x = pk2(va[8] * ra * g[0], va[9] * ra * g[1]); o.y = pk2(va[10] * ra * g[2], va[11] * ra * g[3]); o.z = pk2(va[12] * ra * g[4], va[13] * ra * g[5]); o.w = pk2(va[14] * ra * g[6], va[15] * ra * g[7]);
            *(u32x4*)(yp + 512 + 8 * lane) = o; }
        {   const float g[8] = {gv[4][0], gv[4][1], gv[4][2], gv[4][3], gv[5][0], gv[5][1], gv[5][2], gv[5][3]}; u32x4 o;
            o.x = pk2(vs[0] * rs * g[0], vs[1] * rs * g[1]); o.y = pk2(vs[2] * rs * g[2], vs[3] * rs * g[3]); o.z = pk2(vs[4] * rs * g[4], vs[5] * rs * g[5]); o.w = pk2(vs[6] * rs * g[6], vs[7] * rs * g[7]);
            *(u32x4*)(yp + 1024 + 8 * lane) = o; }
        {   const float g[8] = {gv[6][0], gv[6][1], gv[6][2], gv[6][3], gv[7][0], gv[7][1], gv[7][2], gv[7][3]}; u32x4 o;
            o.x = pk2(vz[0] * rz * g[0], vz[1] * rz * g[1]); o.y = pk2(vz[2] * rz * g[2], vz[3] * rz * g[3]); o.z = pk2(vz[4] * rz * g[4], vz[5] * rz * g[5]); o.w = pk2(vz[6] * rz * g[6], vz[7] * rz * g[7]);
            *(u32x4*)(yp + 1536 + 8 * lane) = o; }
    }
}

__device__ __forceinline__ unsigned ord_f(float f) { const unsigned u = __float_as_uint(f); return (u & 0x80000000u) ? ~u : (u | 0x80000000u); }
__device__ __forceinline__ float unord_f(unsigned k) { return __uint_as_float((k & 0x80000000u) ? (k ^ 0x80000000u) : ~k); }
#define INS16(r, x_) do { unsigned _x = (x_); _Pragma("unroll") for (int _j = 0; _j < 16; ++_j) { const unsigned _t = max(r[_j], _x); _x = min(r[_j], _x); r[_j] = _t; } } while (0)

#define CE_DESC(a_, b_) do { const unsigned hi_ = max((a_), (b_)), lo_ = min((a_), (b_)); (a_) = hi_; (b_) = lo_; } while (0)
template <int N> __device__ __forceinline__ void bitonic_sort_desc(unsigned (&v)[N]) {
#pragma unroll
    for (int k = 2; k <= N; k <<= 1)
#pragma unroll
        for (int j = k >> 1; j > 0; j >>= 1)
#pragma unroll
            for (int i = 0; i < N; ++i) { const int l = i ^ j; if (l > i) { if ((i & k) == 0) CE_DESC(v[i], v[l]); else CE_DESC(v[l], v[i]); } }
}
__device__ __forceinline__ void merge_top16(unsigned (&a)[16], const unsigned (&b)[16]) {
#pragma unroll
    for (int i = 0; i < 16; ++i) a[i] = max(a[i], b[15 - i]);
#pragma unroll
    for (int j = 8; j > 0; j >>= 1)
#pragma unroll
        for (int i = 0; i < 16; ++i) { const int l = i ^ j; if (l > i) CE_DESC(a[i], a[l]); }
}
__device__ __forceinline__ void top16_of_64(unsigned (&g0)[16], unsigned (&g1)[16], unsigned (&g2)[16], unsigned (&g3)[16]) {
    bitonic_sort_desc<16>(g0); bitonic_sort_desc<16>(g1); bitonic_sort_desc<16>(g2); bitonic_sort_desc<16>(g3);
    merge_top16(g0, g1); merge_top16(g2, g3); merge_top16(g0, g2);
}
constexpr int TKW_STRIDE = 132, TKW_BYTES = 32 * TKW_STRIDE * 4;
static_assert(8 * TKW_BYTES <= LDS_BARW, "topk LDS");

__device__ __forceinline__ void topk_wave_item(const Ctx& c, int l, int tile32, int head) {
    const int lane = c.lane, n = lane & 15, lg = lane >> 4, tk = lane & 31, hf = lane >> 5;
    const int tok0 = tile32 * 32;
    LAS unsigned* SC = (LAS unsigned*)(c.lds + c.wave * TKW_BYTES);
    unsigned top[2][16];
#pragma unroll
    for (int list = 0; list < 2; ++list) {
        bf16x8 af[2][4];
#pragma unroll
        for (int mt = 0; mt < 2; ++mt)
#pragma unroll
            for (int kk = 0; kk < 4; ++kk) af[mt][kk] = *(const bf16x8*)(c.PQ + (size_t)(tok0 + 16 * mt + n) * DM + head * 256 + list * 128 + 32 * kk + 8 * lg);
        const u16* kb = (const u16*)(c.wl(l) + WL_K12) + ((size_t)(list * 8 + head) * 128) * 128;
        lds_fence();
        bf16x8 bk[4];
#pragma unroll
        for (int kk = 0; kk < 4; ++kk) bk[kk] = *(const bf16x8*)(kb + (size_t)n * 128 + 32 * kk + 8 * lg);
#pragma unroll
        for (int nt = 0; nt < 8; ++nt) {
            bf16x8 bn[4];
            if (nt < 7) {
#pragma unroll
                for (int kk = 0; kk < 4; ++kk) bn[kk] = *(const bf16x8*)(kb + (size_t)(16 * (nt + 1) + n) * 128 + 32 * kk + 8 * lg);
            }
            __builtin_amdgcn_sched_barrier(0);
#pragma unroll
            for (int mt = 0; mt < 2; ++mt) {
                f32x4 acc = {0.f, 0.f, 0.f, 0.f};
#pragma unroll
                for (int kk = 0; kk < 4; ++kk) acc = __builtin_amdgcn_mfma_f32_16x16x32_bf16(af[mt][kk], bk[kk], acc, 0, 0, 0);
                const unsigned ki = (unsigned)(16 * nt + n);
#pragma unroll
                for (int rr = 0; rr < 4; ++rr) SC[(16 * mt + 4 * lg + rr) * TKW_STRIDE + ki] = (ord_f(acc[rr]) & ~0x7Fu) | (127u - ki);
            }
            __builtin_amdgcn_sched_barrier(0);
            if (nt < 7) {
#pragma unroll
                for (int kk = 0; kk < 4; ++kk) bk[kk] = bn[kk];
            }
        }
        lds_fence();
        unsigned r[16], g1[16], g2[16], g3[16];
        const LAS u32x4* sp = (const LAS u32x4*)(SC + tk * TKW_STRIDE + 64 * hf);
#pragma unroll
        for (int i = 0; i < 4; ++i) { const u32x4 a = sp[i], b = sp[4 + i], c2 = sp[8 + i], d = sp[12 + i];
            r[4 * i] = a.x; r[4 * i + 1] = a.y; r[4 * i + 2] = a.z; r[4 * i + 3] = a.w; g1[4 * i] = b.x; g1[4 * i + 1] = b.y; g1[4 * i + 2] = b.z; g1[4 * i + 3] = b.w;
            g2[4 * i] = c2.x; g2[4 * i + 1] = c2.y; g2[4 * i + 2] = c2.z; g2[4 * i + 3] = c2.w; g3[4 * i] = d.x; g3[4 * i + 1] = d.y; g3[4 * i + 2] = d.z; g3[4 * i + 3] = d.w; }
        top16_of_64(r, g1, g2, g3);
        unsigned o[16];
#pragma unroll
        for (int j = 0; j < 16; ++j) o[j] = (unsigned)__shfl_xor((int)r[j], 32);
        merge_top16(r, o);
#pragma unroll
        for (int j = 0; j < 16; ++j) top[list][j] = r[j];
    }
    float v1[16], v2[16];
#pragma unroll
    for (int j = 0; j < 16; ++j) { v1[j] = unord_f(top[0][j] & ~0x7Fu); v2[j] = unord_f(top[1][j] & ~0x7Fu); }
    unsigned r[16], q1[16], q2[16], q3[16];
    {
        unsigned cand[64]; int nc = 0;
#pragma unroll
        for (int a = 0; a < 16; ++a)
#pragma unroll
            for (int b = 0; b < 16; ++b)
                if ((a + 1) * (b + 1) <= 16) { cand[nc] = (ord_f(v1[a] + v2[b]) & ~0xFFu) | (unsigned)(255 - (a * 16 + b)); ++nc; }
#pragma unroll
        for (int i = 50; i < 64; ++i) cand[i] = 0u;
#pragma unroll
        for (int i = 0; i < 16; ++i) { r[i] = cand[i]; q1[i] = cand[16 + i]; q2[i] = cand[32 + i]; q3[i] = cand[48 + i]; }
    }
    top16_of_64(r, q1, q2, q3);
    if (hf == 0) {
#pragma unroll
        for (int j = 0; j < 16; ++j) { SC[tk * TKW_STRIDE + j] = top[0][j]; SC[tk * TKW_STRIDE + 16 + j] = top[1][j]; }
    }
    lds_fence();
    float s[16], sum = 0.f;
    const float mx = unord_f(r[0] & ~0xFFu);
#pragma unroll
    for (int k = 0; k < 16; ++k) { s[k] = __expf(unord_f(r[k] & ~0xFFu) - mx); sum += s[k]; }
    const float inv = 1.0f / sum;
    unsigned ev[16];
#pragma unroll
    for (int k = 0; k < 16; ++k) {
        const int flat = 255 - (int)(r[k] & 0xFFu), a = flat >> 4, b = flat & 15;
        const int i1 = 127 - (int)(SC[tk * TKW_STRIDE + a] & 0x7Fu), i2 = 127 - (int)(SC[tk * TKW_STRIDE + 16 + b] & 0x7Fu);
        ev[k] = (unsigned)(i1 * 128 + i2);
    }
    if (hf == 0) {
        const size_t o = (size_t)(tok0 + tk) * 128 + head * 16;
        u32x4* ep = (u32x4*)(c.ET + o);
        ep[0] = (u32x4){ev[0] | (ev[1] << 16), ev[2] | (ev[3] << 16), ev[4] | (ev[5] << 16), ev[6] | (ev[7] << 16)};
        ep[1] = (u32x4){ev[8] | (ev[9] << 16), ev[10] | (ev[11] << 16), ev[12] | (ev[13] << 16), ev[14] | (ev[15] << 16)};
        f32x4* gp = (f32x4*)(c.GT + o);
        gp[0] = (f32x4){s[0] * inv, s[1] * inv, s[2] * inv, s[3] * inv}; gp[1] = (f32x4){s[4] * inv, s[5] * inv, s[6] * inv, s[7] * inv};
        gp[2] = (f32x4){s[8] * inv, s[9] * inv, s[10] * inv, s[11] * inv}; gp[3] = (f32x4){s[12] * inv, s[13] * inv, s[14] * inv, s[15] * inv};
    }
    lds_fence();
}

#define CFENCE() asm volatile("" ::: "memory")
typedef float f2 __attribute__((ext_vector_type(2)));
__device__ __forceinline__ float dpp_xor1(float v) { return __builtin_bit_cast(float, __builtin_amdgcn_update_dpp(0, __builtin_bit_cast(int, v), 0xB1, 0xF, 0xF, true)); }
__device__ __forceinline__ float dpp_xor2(float v) { return __builtin_bit_cast(float, __builtin_amdgcn_update_dpp(0, __builtin_bit_cast(int, v), 0x4E, 0xF, 0xF, true)); }

typedef __bf16 bf2v __attribute__((ext_vector_type(2)));
#define FP4_DOT(a_, w_, h_, o_) do { a_ += (h_)[(o_) + 0] * __builtin_amdgcn_cvt_scalef32_pk_f32_fp4((w_), 1.0f, 0); a_ += (h_)[(o_) + 1] * __builtin_amdgcn_cvt_scalef32_pk_f32_fp4((w_), 1.0f, 1); \
    a_ += (h_)[(o_) + 2] * __builtin_amdgcn_cvt_scalef32_pk_f32_fp4((w_), 1.0f, 2); a_ += (h_)[(o_) + 3] * __builtin_amdgcn_cvt_scalef32_pk_f32_fp4((w_), 1.0f, 3); } while (0)
#define PEER_E(ew_, i_) (((i_) & 1) ? ((ew_)[(i_) >> 1] >> 16) : ((ew_)[(i_) >> 1] & 0xFFFFu))

#define I4_DOT(a_, w_, h_, o_) do { a_ = __builtin_amdgcn_sdot4((int)((w_) & 0x0F0F0F0Fu), (int)(h_)[(o_)], a_, false); a_ = __builtin_amdgcn_sdot4((int)(((w_) >> 4) & 0x0F0F0F0Fu), (int)(h_)[(o_) + 1], a_, false); } while (0)
__device__ __forceinline__ void phase_peer_u(const Ctx& c, int l, int nrows) {
    const int lane = c.lane, g = lane >> 3, j = lane & 7;
    const int tstep = c.xn * 8;
    for (int s = c.xi; s < PEER_NSL; s += c.nx) {
        const unsigned char* ub = c.wl(l) + WL_U + PEER_SLB * s + 16 * j;
        const unsigned char* hs = c.H8 + 256 * s + 32 * j;
        u16* part = c.PART + (size_t)s * PAIRS_MAX;
        int t = c.xr * 8 + c.wave;
        if (t >= nrows) continue;
        u32x4 ea, eb, segN[16], hN[2]; float scN;
        { const u32x4* ep = (const u32x4*)(c.ET + (size_t)t * 128 + 16 * g); ea = ep[0]; eb = ep[1]; }
        { const unsigned ew[8] = {ea.x, ea.y, ea.z, ea.w, eb.x, eb.y, eb.z, eb.w};
#pragma unroll
          for (int i = 0; i < 16; ++i) segN[i] = *(const u32x4*)(ub + (size_t)PEER_E(ew, i) * PEER_ROWB);
          const u32x4* hp = (const u32x4*)(hs + (size_t)t * DM); hN[0] = hp[0]; hN[1] = hp[1]; scN = c.HSC[t]; }
        { const u32x4* ep = (const u32x4*)(c.ET + (size_t)min(t + tstep, nrows - 1) * 128 + 16 * g); ea = ep[0]; eb = ep[1]; }
#pragma unroll 1
        for (; t < nrows; t += tstep) {
            u32x4 seg[16];
#pragma unroll
            for (int i = 0; i < 16; ++i) seg[i] = segN[i];
            const unsigned hv[8] = {hN[0].x, hN[0].y, hN[0].z, hN[0].w, hN[1].x, hN[1].y, hN[1].z, hN[1].w};
            const float hsc = scN;
            {
                const int tn = min(t + tstep, nrows - 1);
                const unsigned ew[8] = {ea.x, ea.y, ea.z, ea.w, eb.x, eb.y, eb.z, eb.w};
#pragma unroll
                for (int i = 0; i < 16; ++i) segN[i] = *(const u32x4*)(ub + (size_t)PEER_E(ew, i) * PEER_ROWB);
                const u32x4* hp = (const u32x4*)(hs + (size_t)tn * DM); hN[0] = hp[0]; hN[1] = hp[1]; scN = c.HSC[tn];
                const u32x4* ep = (const u32x4*)(c.ET + (size_t)min(t + 2 * tstep, nrows - 1) * 128 + 16 * g); ea = ep[0]; eb = ep[1];
            }
            int hsum = 0;
#pragma unroll
            for (int q = 0; q < 8; ++q) hsum = __builtin_amdgcn_sdot4((int)hv[q], 0x01010101, hsum, false);
            const float fs = hsc;
            float acc[16];
#pragma unroll
            for (int i = 0; i < 16; ++i) {
                int a = 0, b = 0;
                I4_DOT(a, seg[i].x, hv, 0); I4_DOT(b, seg[i].y, hv, 2); I4_DOT(a, seg[i].z, hv, 4); I4_DOT(b, seg[i].w, hv, 6);
                acc[i] = (float)(a + b - 8 * hsum) * fs;
            }
            float r8[8], r4[4], r2[2];
            { const bool hi = (j & 4) != 0;
#pragma unroll
              for (int m = 0; m < 8; ++m) { const float keep = hi ? acc[8 + m] : acc[m], send = hi ? acc[m] : acc[8 + m]; r8[m] = keep + __shfl_xor(send, 4); } }
            { const bool hi = (j & 2) != 0;
#pragma unroll
              for (int m = 0; m < 4; ++m) { const float keep = hi ? r8[4 + m] : r8[m], send = hi ? r8[m] : r8[4 + m]; r4[m] = keep + dpp_xor2(send); } }
            { const bool hi = (j & 1) != 0;
#pragma unroll
              for (int m = 0; m < 2; ++m) { const float keep = hi ? r4[2 + m] : r4[m], send = hi ? r4[m] : r4[2 + m]; r2[m] = keep + dpp_xor1(send); } }
            *(unsigned*)(part + (size_t)t * 128 + 2 * lane) = pk2(r2[0], r2[1]);
        }
    }
}

__device__ __forceinline__ void phase_peer_reduce(const Ctx& c, int nrows) {
    const size_t n8 = (size_t)nrows * 128 / 8;
    for (size_t i = (size_t)c.bid * 512 + c.tid; i < n8; i += (size_t)c.G * 512) {
        float s[8];
#pragma unroll
        for (int q = 0; q < 8; ++q) s[q] = 0.f;
#pragma unroll
        for (int sl = 0; sl < PEER_NSL; ++sl) {
            const u32x4 v = *(const u32x4*)(c.PART + (size_t)sl * PAIRS_MAX + 8 * i);
            s[0] += bflo(v.x); s[1] += bfhi(v.x); s[2] += bflo(v.y); s[3] += bfhi(v.y); s[4] += bflo(v.z); s[5] += bfhi(v.z); s[6] += bflo(v.w); s[7] += bfhi(v.w);
        }
        const f32x4 g0 = *(const f32x4*)(c.GT + 8 * i), g1 = *(const f32x4*)(c.GT + 8 * i + 4);
        const float is = 1.0f / USCALE;
        u32x4 o;
        o.x = pk2(g0[0] * gelu_f(s[0] * is), g0[1] * gelu_f(s[1] * is)); o.y = pk2(g0[2] * gelu_f(s[2] * is), g0[3] * gelu_f(s[3] * is));
        o.z = pk2(g1[0] * gelu_f(s[4] * is), g1[1] * gelu_f(s[5] * is)); o.w = pk2(g1[2] * gelu_f(s[6] * is), g1[3] * gelu_f(s[7] * is));
        *(u32x4*)(c.WT + 8 * i) = o;
    }
}

#define FP4_AXPY(o_, w2_, w_, b_) do { (o_)[(b_) + 0] += (w2_) * __builtin_amdgcn_cvt_scalef32_pk_f32_fp4((w_), 1.0f, 0); (o_)[(b_) + 1] += (w2_) * __builtin_amdgcn_cvt_scalef32_pk_f32_fp4((w_), 1.0f, 1); \
    (o_)[(b_) + 2] += (w2_) * __builtin_amdgcn_cvt_scalef32_pk_f32_fp4((w_), 1.0f, 2); (o_)[(b_) + 3] += (w2_) * __builtin_amdgcn_cvt_scalef32_pk_f32_fp4((w_), 1.0f, 3); } while (0)
__device__ __forceinline__ f2 shfl2(f2 v, int m) { return (f2){__shfl_xor(v.x, m), __shfl_xor(v.y, m)}; }
__device__ __forceinline__ void phase_peer_v(const Ctx& c, int l, int nrows, u16* xdst) {
    const int lane = c.lane, g = lane >> 3, j = lane & 7;
    const int tstep = c.xn * 8;
    for (int s = c.xi; s < PEER_NSL; s += c.nx) {
        const unsigned char* vb = c.wl(l) + WL_V + PEER_SLB * s + 16 * j;
        int t = c.xr * 8 + c.wave;
        if (t >= nrows) continue;
        u32x4 ea, eb, segN[16], wN[2];
        { const u32x4* ep = (const u32x4*)(c.ET + (size_t)t * 128 + 16 * g); ea = ep[0]; eb = ep[1]; }
        { const unsigned ew[8] = {ea.x, ea.y, ea.z, ea.w, eb.x, eb.y, eb.z, eb.w};
#pragma unroll
          for (int i = 0; i < 16; ++i) segN[i] = *(const u32x4*)(vb + (size_t)PEER_E(ew, i) * PEER_ROWB);
          const u32x4* wp = (const u32x4*)(c.WT + (size_t)t * 128 + 16 * g); wN[0] = wp[0]; wN[1] = wp[1]; }
        { const u32x4* ep = (const u32x4*)(c.ET + (size_t)min(t + tstep, nrows - 1) * 128 + 16 * g); ea = ep[0]; eb = ep[1]; }
#pragma unroll 1
        for (; t < nrows; t += tstep) {
            u32x4 seg[16];
#pragma unroll
            for (int i = 0; i < 16; ++i) seg[i] = segN[i];
            const unsigned ww[8] = {wN[0].x, wN[0].y, wN[0].z, wN[0].w, wN[1].x, wN[1].y, wN[1].z, wN[1].w};
            const int col = 256 * s + 32 * j + 4 * g;
            const f32x4 q = *(const f32x4*)(c.MOD + ((size_t)(l * 5 + row_bidx(t)) * 6 + 5) * DM + col); const u32x2 xw = *(const u32x2*)(c.X + (size_t)t * DM + col);
            {
                const int tn = min(t + tstep, nrows - 1);
                const unsigned ew[8] = {ea.x, ea.y, ea.z, ea.w, eb.x, eb.y, eb.z, eb.w};
#pragma unroll
                for (int i = 0; i < 16; ++i) segN[i] = *(const u32x4*)(vb + (size_t)PEER_E(ew, i) * PEER_ROWB);
                const u32x4* wp = (const u32x4*)(c.WT + (size_t)tn * 128 + 16 * g); wN[0] = wp[0]; wN[1] = wp[1];
                const u32x4* ep = (const u32x4*)(c.ET + (size_t)min(t + 2 * tstep, nrows - 1) * 128 + 16 * g); ea = ep[0]; eb = ep[1];
            }
            f2 o[16];
#pragma unroll
            for (int q = 0; q < 16; ++q) o[q] = (f2){0.f, 0.f};
#pragma unroll
            for (int i = 0; i < 16; ++i) {
                const float w = (i & 1) ? bfhi(ww[i >> 1]) : bflo(ww[i >> 1]);
                const f2 w2 = {w, w};
                FP4_AXPY(o, w2, seg[i].x, 0); FP4_AXPY(o, w2, seg[i].y, 4); FP4_AXPY(o, w2, seg[i].z, 8); FP4_AXPY(o, w2, seg[i].w, 12);
            }
            f2 r8[8], r4[4], r2[2];
#pragma unroll
            for (int m = 0; m < 8; ++m) {
                const u32x2 sx = __builtin_amdgcn_permlane32_swap(__float_as_uint(o[m].x), __float_as_uint(o[8 + m].x), false, false);
                const u32x2 sy = __builtin_amdgcn_permlane32_swap(__float_as_uint(o[m].y), __float_as_uint(o[8 + m].y), false, false);
                r8[m] = (f2){__uint_as_float(sx.x) + __uint_as_float(sx.y), __uint_as_float(sy.x) + __uint_as_float(sy.y)};
            }
#pragma unroll
            for (int m = 0; m < 4; ++m) {
                const u32x2 sx = __builtin_amdgcn_permlane16_swap(__float_as_uint(r8[m].x), __float_as_uint(r8[4 + m].x), false, false);
                const u32x2 sy = __builtin_amdgcn_permlane16_swap(__float_as_uint(r8[m].y), __float_as_uint(r8[4 + m].y), false, false);
                r4[m] = (f2){__uint_as_float(sx.x) + __uint_as_float(sx.y), __uint_as_float(sy.x) + __uint_as_float(sy.y)};
            }
            { const bool hi = (g & 1) != 0;
#pragma unroll
              for (int m = 0; m < 2; ++m) { const f2 keep = hi ? r4[2 + m] : r4[m], send = hi ? r4[m] : r4[2 + m];
                  r2[m] = keep + shfl2(send, 8); } }
            const float is = 1.0f / VSCALE;
            *(u32x2*)(xdst + (size_t)t * DM + col) = (u32x2){pk2(bflo(xw.x) + q[0] * r2[0].x * is, bfhi(xw.x) + q[1] * r2[0].y * is), pk2(bflo(xw.y) + q[2] * r2[1].x * is, bfhi(xw.y) + q[3] * r2[1].y * is)};
        }
    }
}

__device__ __forceinline__ void phase_final(const Ctx& c) {
    const float* gain = c.in[I_FNORM];
    int row = c.bid * 8 + c.wave;
    if (row >= NLAT) return;
    float4 g[8];
#pragma unroll
    for (int i = 0; i < 8; ++i) g[i] = *(const float4*)(gain + 4 * (c.lane + 64 * i));
    u32x2 xn[8];
    { const u32x2* xp = (const u32x2*)(c.X + (size_t)row * DM);
#pragma unroll
      for (int i = 0; i < 8; ++i) xn[i] = xp[c.lane + 64 * i]; }
    for (; row < NLAT; row += c.G * 8) {
        float4 v[8]; float ss = 0.f;
#pragma unroll
        for (int i = 0; i < 8; ++i) { const u32x2 xw = xn[i]; v[i] = make_float4(bflo(xw.x), bfhi(xw.x), bflo(xw.y), bfhi(xw.y)); ss += v[i].x * v[i].x + v[i].y * v[i].y + v[i].z * v[i].z + v[i].w * v[i].w; }
        { const u32x2* xp = (const u32x2*)(c.X + (size_t)min(row + c.G * 8, NLAT - 1) * DM);
#pragma unroll
          for (int i = 0; i < 8; ++i) xn[i] = xp[c.lane + 64 * i]; }
        ss = wave_sum(ss);
        const float rstd = rsqrtf(ss * (1.0f / DM) + EPSN);
        float4* op = (float4*)(c.out + (size_t)row * DM);
#pragma unroll
        for (int i = 0; i < 8; ++i)
            op[c.lane + 64 * i] = make_float4(v[i].x * rstd * g[i].x, v[i].y * rstd * g[i].y, v[i].z * rstd * g[i].z, v[i].w * rstd * g[i].w);
    }
}

constexpr int PH_PRO = 0, PH_MODFIN = 1, PH_NORM0 = 2, PH_L0 = 3, PH_PER_LAYER = 13, N_PHASES = PH_L0 + DEPTH * PH_PER_LAYER;

__global__ void __launch_bounds__(512, 2) fwd_kernel(Args args) {
    extern __shared__ __attribute__((aligned(16))) unsigned char lds_raw[];
    Ctx c;
#pragma unroll
    for (int i = 0; i < N_IN; ++i) c.in[i] = args.in[i];
    c.out = args.out; c.ws = args.ws; c.lds = (LAS unsigned char*)lds_raw;
    c.tid = threadIdx.x; c.lane = c.tid & 63; c.wave = __builtin_amdgcn_readfirstlane(c.tid >> 6); c.G = gridDim.x; c.bid = blockIdx.x;
    unsigned char* ws = args.ws;
    c.MOD = (float*)(ws + WS_MOD); c.MODP = (float*)(ws + WS_MODP); c.X = (u16*)(ws + WS_X); c.H = (u16*)(ws + WS_H); c.PROJ = (u16*)(ws + WS_PROJ); c.TR = (u16*)(ws + WS_TR);
    c.ATT = (u16*)(ws + WS_ATT); c.SGU = (u16*)(ws + WS_SGU); c.S5Y = (u16*)(ws + WS_S5Y); c.S5O = (u16*)(ws + WS_S5O); c.YIN = (u16*)(ws + WS_YIN); c.PQ = (u16*)(ws + WS_PQ);
    c.ET = (u16*)(ws + WS_ET); c.GT = (float*)(ws + WS_GT); c.PART = (u16*)(ws + WS_PART); c.WT = (u16*)(ws + WS_WT); c.H8 = ws + WS_H8; c.HSC = (float*)(ws + WS_HSC);
    c.xi = c.bid % 8; c.nx = 8; c.xr = c.bid / 8; c.xn = (c.G + 7) / 8; c.SLOC = (f32x2v*)(ws + WS_SLOC);

    const int lo = args.ph_lo, hi = args.ph_hi;
    XcdBarrier bar; bar.bar = (unsigned*)(ws + WS_BAR); bar.x = 0; bar.st = (volatile LAS unsigned*)(c.lds + LDS_BARW);
    if (hi - lo > 1) {
        if (c.tid == 0) { bar.st[0] = 0u; bar.st[1] = 0u; }
        __syncthreads();
        bar = xcd_barrier_post((unsigned*)(ws + WS_BAR), (volatile LAS unsigned*)(c.lds + LDS_BARW));
    }
#ifndef PHASE_MASK
#define PHASE_MASK 0xFFFFFF
#endif
#define EN(i) ((PHASE_MASK >> (i)) & 1)
#ifndef PROBE_MASK
#define PROBE_MASK 0
#endif
#define NREP(i) (((PROBE_MASK >> (i)) & 1) ? 2 : 1)
#ifndef USE_CENSUS
#define USE_CENSUS 1
#endif
#define IN_PH(k) (lo <= (k) && (k) < hi)
#define SEAM(k) do { if (IN_PH((k) + 1)) { xcd_barrier(bar); if (NREP(22) == 2) xcd_barrier(bar); } } while (0)

    if (EN(0) && IN_PH(PH_PRO)) { for (int rep = 0; rep < NREP(0); ++rep) phase_prologue(c); SEAM(PH_PRO); }
    if (USE_CENSUS && hi - lo > 1 && lo == 0) {
        volatile LAS unsigned* st = (volatile LAS unsigned*)(c.lds + LDS_BARW);
        if (c.tid == 0) {
            unsigned below = 0, pop = 0, mine = 1;
#pragma unroll
            for (unsigned jx = 0; jx < 16; ++jx) { const unsigned cn = xb_ld((unsigned*)(ws + WS_BAR) + XB_XCNT(jx)); pop += cn ? 1u : 0u; below += (cn && jx < bar.x) ? 1u : 0u; mine = (jx == bar.x) ? cn : mine; }
            st[4] = below; st[5] = pop ? pop : 1u; st[6] = mine ? mine : 1u;
        }
        __syncthreads();
        c.xi = (int)st[4]; c.nx = (int)st[5]; c.xn = (int)st[6]; c.xr = (int)st[2];
        if (c.xr >= c.xn) c.xr = c.xn - 1;
    }
    if (EN(1) && IN_PH(PH_MODFIN)) { phase_modfin(c); SEAM(PH_MODFIN); }
    if (EN(2) && IN_PH(PH_NORM0)) { phase_normmod(c, 0, 0, MROWS); SEAM(PH_NORM0); }

#pragma unroll 1
    for (int l = 0; l < DEPTH; ++l) {
        const int base = PH_L0 + l * PH_PER_LAYER;
        const bool last = (l == DEPTH - 1);
        const int mrows = last ? NLAT : MROWS;
        unsigned char* W = c.wl(l);
        if (EN(3) && IN_PH(base + 0)) { c.fresh();
            for (int rep = 0; rep < NREP(3); ++rep) {
            { pg8::Gemm g{c.H, (const u16*)(W + WL_MAIN), MROWS, NMAIN, DM, (const u16*)(W + WL_TR), c.H}; pg8::DualOrder S; S.init(MROWS, NMAIN, NTR, MROWS, c.G, c.bid);
              EpiProj E{c.PROJ, c.TR};
              pg8::gemm_phase<EpiProj, pg8::DualOrder>(c.lds, g, S, E, nullptr); }
            }
            SEAM(base + 0);
        }
        if (EN(4) && IN_PH(base + 1)) { c.fresh();
            const int gw = c.bid * 8 + c.wave, nw = c.G * 8;
            for (int rep = 0; rep < NREP(13); ++rep) if (EN(13)) phase_attention(c, l, last);
            for (int rep = 0; rep < NREP(15); ++rep)
            if (EN(15)) for (int it = c.bid; it < (last ? 128 : 136); it += c.G) sgu_item(c, l, it);
            __syncthreads();
            for (int rep = 0; rep < NREP(16); ++rep)
            if (EN(16)) phase_s5_pass1(c, l);
            SEAM(base + 1);
        }
        if (EN(5) && IN_PH(base + 2)) { c.fresh();
            for (int rep = 0; rep < NREP(5); ++rep) phase_s5_pass3(c, l, last);
            SEAM(base + 2);
        }
        if (EN(6) && IN_PH(base + 3)) { c.fresh();
            for (int rep = 0; rep < NREP(6); ++rep) {
            pg8::Gemm g{c.S5Y, (const u16*)(W + WL_GLU), mrows, 512, 512, nullptr, nullptr}; pg8::StaticOrder S; S.init(mrows, 512, c.G, c.bid);
            EpiGlu E{c.S5Y, c.S5O, c.in[I_GLUB] + (size_t)l * 512};
            pg8::gemm_phase<EpiGlu, pg8::StaticOrder>(c.lds, g, S, E, nullptr);
            }
            if (!last && c.G == 256) peer_convert_u(c, l + 1, (MROWS / 256) * 2, c.G - (MROWS / 256) * 2);
            SEAM(base + 3);
        }
        if (EN(7) && IN_PH(base + 4)) { c.fresh(); for (int rep = 0; rep < NREP(7); ++rep) phase_merge(c, l, mrows); SEAM(base + 4); }
        constexpr int NCU = 32;
        const bool split = !last && c.G > 2 * NCU;
        if (EN(8) && IN_PH(base + 5)) { c.fresh();
            const int m5 = split ? NLAT : mrows;
            pg8::Gemm g{c.YIN, (const u16*)(W + WL_OUT), m5, DM, DM, nullptr, nullptr}; pg8::StaticOrder S; S.init(m5, DM, c.G, c.bid);
            EpiResid E{c.X, c.MOD + (size_t)l * 5 * 6 * DM, 0};
            pg8::gemm_phase<EpiResid, pg8::StaticOrder>(c.lds, g, S, E, nullptr);
            SEAM(base + 5);
        }
        if (EN(9) && IN_PH(base + 6)) { c.fresh();
            if (!split) phase_normmod(c, l, 1, mrows);
            else if (c.bid < NCU) {
                pg8::Gemm g{c.YIN + (size_t)NLAT * DM, (const u16*)(W + WL_OUT), NCTX, DM, DM, nullptr, nullptr}; pg8::StaticOrder S; S.init(NCTX, DM, NCU, c.bid);
                EpiResid E{c.X + (size_t)NLAT * DM, c.MOD + (size_t)l * 5 * 6 * DM, NLAT};
                pg8::gemm_phase<EpiResid, pg8::StaticOrder>(c.lds, g, S, E, nullptr);
            } else phase_normmod(c, l, 1, NLAT, 0, NCU, c.G - NCU);
            SEAM(base + 6);
        }
        if (EN(10) && IN_PH(base + 7)) { c.fresh();
            const int m7 = split ? NLAT : mrows;
            pg8::Gemm g{c.H, (const u16*)(W + WL_Q), m7, DM, DM, nullptr, nullptr}; pg8::StaticOrder S; S.init(m7, DM, c.G, c.bid);
            pg8::EpiBf16<0> E{c.PQ, DM, nullptr, 0, 0};
            pg8::gemm_phase<pg8::EpiBf16<0>, pg8::StaticOrder>(c.lds, g, S, E, nullptr);
            if (split) phase_normmod(c, l, 1, NCTX, NLAT);
            SEAM(base + 7);
        }
        if (EN(11) && IN_PH(base + 8)) { c.fresh();
            if (!split) { for (int it = c.bid * 8 + c.wave; it < (mrows / 32) * 8; it += c.G * 8) topk_wave_item(c, l, it >> 3, it & 7); }
            else if (c.bid < NCU) {
                pg8::Gemm g{c.H + (size_t)NLAT * DM, (const u16*)(W + WL_Q), NCTX, DM, DM, nullptr, nullptr}; pg8::StaticOrder S; S.init(NCTX, DM, NCU, c.bid);
                pg8::EpiBf16<0> E{c.PQ + (size_t)NLAT * DM, DM, nullptr, 0, 0};
                pg8::gemm_phase<pg8::EpiBf16<0>, pg8::StaticOrder>(c.lds, g, S, E, nullptr);
                pg8::Unit u; S.next(0, u);
                asm volatile("s_waitcnt vmcnt(0)" ::: "memory"); __syncthreads();
                topk_wave_item(c, l, (NLAT + 256 * u.pm) / 32 + c.wave, u.pn);
            } else { for (int it = (c.bid - NCU) * 8 + c.wave; it < (NLAT / 32) * 8; it += (c.G - NCU) * 8) topk_wave_item(c, l, it >> 3, it & 7);
                if (c.G == 256) peer_convert_v(c, l + 1, 96, c.G - 96); }
            SEAM(base + 8);
        }
        if (EN(12) && IN_PH(base + 9)) { c.fresh(); for (int rep = 0; rep < NREP(17); ++rep) phase_peer_u(c, l, mrows); SEAM(base + 9); }
        if (EN(12) && IN_PH(base + 10)) { c.fresh(); for (int rep = 0; rep < NREP(18); ++rep) phase_peer_reduce(c, mrows); SEAM(base + 10); }
        if (EN(12) && IN_PH(base + 11)) { c.fresh(); phase_peer_v(c, l, mrows, c.X); SEAM(base + 11); }
        if (EN(12) && IN_PH(base + 12)) { c.fresh();
            for (int rep = 0; rep < NREP(20); ++rep)
            if (!last) phase_normmod(c, l + 1, 0, MROWS); else phase_final(c);
            SEAM(base + 12);
        }
    }
}

#ifndef N_LAUNCH_MODE
#define N_LAUNCH_MODE 1
#endif
extern "C" void kernel_launch(void* const* d_in, const int* in_sizes, int n_in, void* d_out, int out_size, void* d_ws, size_t ws_size, hipStream_t stream) {
    static int grid = 0;
    if (grid == 0) {
        if (n_in != N_IN || ws_size < WS_END) { fprintf(stderr, "kernel_launch: unexpected n_in %d or ws %zu < %zu\n", n_in, ws_size, (size_t)WS_END); grid = -1; return; }
        int dev = 0, cus = 0, per_cu = 0;
        hipGetDevice(&dev); hipDeviceGetAttribute(&cus, hipDeviceAttributeMultiprocessorCount, dev);
        if (hipFuncSetAttribute((const void*)fwd_kernel, hipFuncAttributeMaxDynamicSharedMemorySize, LDS_BYTES) != hipSuccess) { fprintf(stderr, "kernel_launch: hipFuncSetAttribute failed\n"); grid = -1; return; }
        if (hipOccupancyMaxActiveBlocksPerMultiprocessor(&per_cu, (const void*)fwd_kernel, 512, LDS_BYTES) != hipSuccess || per_cu < 1) fprintf(stderr, "kernel_launch: occupancy query says %d\n", per_cu);
        (void)hipGetLastError();
        grid = cus > 0 ? cus : 256;
    }
    if (grid < 0) return;
    hipMemsetAsync((char*)d_ws + WS_BAR, 0, 16384, stream);
    Args a{};
    for (int i = 0; i < N_IN; ++i) a.in[i] = (const float*)d_in[i];
    a.out = (float*)d_out; a.ws = (unsigned char*)d_ws;
#if N_LAUNCH_MODE == 1
    a.ph_lo = 0; a.ph_hi = N_PHASES;
    hipLaunchKernelGGL(fwd_kernel, dim3(grid), dim3(512), LDS_BYTES, stream, a);
#else
    for (int p = 0; p < N_PHASES; ++p) { a.ph_lo = p; a.ph_hi = p + 1; hipLaunchKernelGGL(fwd_kernel, dim3(grid), dim3(512), LDS_BYTES, stream, a); }
#endif
}
```

```cpp
#include <hip/hip_runtime.h>
#include <cstdio>
namespace pg8 {
#define PG8_LAS __attribute__((address_space(3)))
typedef unsigned short bf16_t;
typedef short bf16x8 __attribute__((ext_vector_type(8)));
typedef float f32x4 __attribute__((ext_vector_type(4)));
typedef unsigned u32x4 __attribute__((ext_vector_type(4)));
constexpr int BM = 256, BK = 64, HALF = 128, HTB = HALF * BK * 2  , STAGE_BYTES = 8 * HTB, NXCD = 8, WGM = 8;

__host__ __device__ __forceinline__ int lds_byte(int r, int c) { const int st = (r >> 4) * 2 + (c >> 5), rr = r & 15, cc = c & 31, ob = rr * 64 + cc * 2; return st * 1024 + (ob ^ (((ob >> 9) & 1) << 5)); }
__host__ __device__ __forceinline__ void stage_rc(int b, int& R, int& C) { const int st = b / 1024, sb = b % 1024, swz = sb ^ (((sb >> 9) & 1) << 5); R = (st >> 1) * 16 + swz / 64; C = (st & 1) * 32 + (swz % 64) / 2; }
__host__ __device__ __forceinline__ int perm32(int rho) { const int n = rho >> 4, i = rho & 15; return 8 * (i >> 2) + 4 * n + (i & 3); }

struct Unit { int pm, pn, w; };
struct Gemm { const bf16_t* A; const bf16_t* Bt; int M, N, K; const bf16_t* A2; const bf16_t* Bt2; };

struct StaticOrder {
    int nM, nN, nwg, G, c;
    __host__ __device__ void init(int M, int N, int G_, int c_) { nM = M / BM; nN = N / BM; nwg = nM * nN; G = G_; c = c_; }
    __host__ __device__ bool next(int i, Unit& u) const {
        const long L = (long)i * G + c; if (L >= nwg) return false;
        int wgid = (int)L; { const int q = nwg / NXCD, r = nwg % NXCD, xcd = wgid % NXCD, off = wgid / NXCD; wgid = (xcd < r ? xcd * (q + 1) : r * (q + 1) + (xcd - r) * q) + off; }
        const int nig = WGM * nN, gid = wgid / nig, fm = gid * WGM, gsz = (nM - fm) < WGM ? (nM - fm) : WGM;
        u.pm = fm + ((wgid % nig) % gsz); u.pn = (wgid % nig) / gsz; u.w = 0; return true;
    }
    __device__ __forceinline__ void a_ready(const Unit&) const {}
    __device__ __forceinline__ void done(const Unit&) const {}
};
struct DualOrder {
    StaticOrder s0, s1; int G, c;
    __host__ __device__ void init(int M0, int N0, int M1, int N1, int G_, int c_) { s0.init(M0, N0, 1, 0); s1.init(M1, N1, 1, 0); G = G_; c = c_; }
    __host__ __device__ bool next(int i, Unit& u) const {
        const long L = (long)i * G + c;
        if (L < s0.nwg) { s0.next((int)L, u); u.w = 0; return true; }
        if (L < s0.nwg + s1.nwg) { s1.next((int)(L - s0.nwg), u); u.w = 1; return true; }
        return false;
    }
    __device__ __forceinline__ void a_ready(const Unit&) const {}
    __device__ __forceinline__ void done(const Unit&) const {}
};
__device__ __forceinline__ unsigned cvt_pk_bf16(float lo, float hi) { unsigned r; asm volatile("v_cvt_pk_bf16_f32 %0, %1, %2" : "=v"(r) : "v"(lo), "v"(hi)); return r; }
typedef float f32x2 __attribute__((ext_vector_type(2)));
__device__ __forceinline__ f32x2 gelu_pk(f32x2 v) {
    const f32x2 av = __builtin_elementwise_abs(v), d = av * 0.2316418882f + 1.0f;
    f32x2 t; t.x = __builtin_amdgcn_rcpf(d.x); t.y = __builtin_amdgcn_rcpf(d.y);
    f32x2 q = t * 0.5307027145f + (-0.7265760135f); q = q * t + 0.7107068705f; q = q * t + (-0.142248368f); q = q * t + 0.127414796f; q = q * t;
    const f32x2 s = (v * v) * (-0.72134752044f);
    f32x2 e; e.x = __builtin_amdgcn_exp2f(s.x); e.y = __builtin_amdgcn_exp2f(s.y);
    const f32x2 m = v * (q * e), r = v - m;
    f32x2 o; o.x = v.x < 0.f ? m.x : r.x; o.y = v.y < 0.f ? m.y : r.y; return o;
}
template <int ACT  > struct EpiBf16 {
    static constexpr bool PERM = true, AFTER_DRAIN = false;
    bf16_t* O; int ldc; const float* bias; int split_cols; size_t split_stride;
    __device__ __forceinline__ void operator()(const f32x4 (&acc)[2][2][4][2], const Unit& u, int wr, int wc, int fr, int fq) const {
        const int row0 = u.pm * BM + wr * 64 + fr; int colt = u.pn * BM; bf16_t* base = O;
        if (split_cols) { const int t = colt / split_cols; base += (size_t)t * split_stride; colt -= t * split_cols; }
        const int col0 = colt + wc * 32 + 8 * fq, bcol0 = u.pn * BM + wc * 32 + 8 * fq;
        f32x4 bv[2][2];
#pragma unroll
        for (int bj = 0; bj < 2; ++bj)
#pragma unroll
            for (int n = 0; n < 2; ++n) bv[bj][n] = bias ? *(const f32x4*)(bias + bcol0 + bj * HALF + 4 * n) : (f32x4){0.f, 0.f, 0.f, 0.f};
#pragma unroll
        for (int ai = 0; ai < 2; ++ai)
#pragma unroll
            for (int m = 0; m < 4; ++m) { bf16_t* rowp = base + (size_t)(row0 + ai * HALF + m * 16) * ldc + col0;
#pragma unroll
                for (int bj = 0; bj < 2; ++bj) { f32x4 v0 = acc[ai][bj][m][0] + bv[bj][0], v1 = acc[ai][bj][m][1] + bv[bj][1];
                    if (ACT == 1) { f32x2 a = gelu_pk((f32x2){v0[0], v0[1]}), b = gelu_pk((f32x2){v0[2], v0[3]}), c = gelu_pk((f32x2){v1[0], v1[1]}), d = gelu_pk((f32x2){v1[2], v1[3]});
                        v0 = (f32x4){a.x, a.y, b.x, b.y}; v1 = (f32x4){c.x, c.y, d.x, d.y}; }
                    if (ACT == 2) {
#pragma unroll
                        for (int j = 0; j < 4; ++j) { v0[j] = 0.5f * v0[j] * (1.0f + erff(v0[j] * 0.70710678f)); v1[j] = 0.5f * v1[j] * (1.0f + erff(v1[j] * 0.70710678f)); } }
                    u32x4 w; w.x = cvt_pk_bf16(v0[0], v0[1]); w.y = cvt_pk_bf16(v0[2], v0[3]); w.z = cvt_pk_bf16(v1[0], v1[1]); w.w = cvt_pk_bf16(v1[2], v1[3]);
                    *(u32x4*)(rowp + bj * HALF) = w; } }
    }
};
template <class Epi, class Sched, bool STAMP = false>
__device__ __forceinline__ void gemm_phase(PG8_LAS unsigned char* lds, const Gemm g, const Sched& S, const Epi& E, unsigned long long* stamps) {
    int tid = threadIdx.x; asm volatile("" : "+v"(tid)); const int wid = __builtin_amdgcn_readfirstlane(tid >> 6), lane = tid & 63, wr = wid >> 2, wc = wid & 3, fr = lane & 15, fq = lane >> 4;
    const int K = g.K, nt = K / BK;
    int ts_lo = 0, ts_hi = 0, nts = 0; const unsigned long long rt_entry = STAMP ? (unsigned long long)wall_clock64() : 0ull;
#define PG8_STAMP() do { if (STAMP && wid == 0 && nts < 64) { const unsigned long long _c = (unsigned long long)clock64(); \
        ts_lo = (lane == nts) ? (int)(unsigned)_c : ts_lo; ts_hi = (lane == nts) ? (int)(unsigned)(_c >> 32) : ts_hi; ++nts; } } while (0)
    PG8_STAMP();
    unsigned voffA[2], voffB[2];
#pragma unroll
    for (int i = 0; i < 2; ++i) { int R, C; stage_rc(tid * 16 + i * 8192, R, C); const int Rb = Epi::PERM ? ((R & ~31) + perm32(R & 31)) : R;
        voffA[i] = (unsigned)(R * K + C) * 2u; voffB[i] = (unsigned)(Rb * K + C) * 2u; }
    const size_t kstep = (size_t)(BK * 2);
    const size_t hstep = (size_t)HALF * K * 2;
    const size_t tstep = 2 * hstep;
    const unsigned ldsw = (unsigned)wid * 1024u;
    const int aoff = lds_byte(wr * 64 + fr, fq * 8), boff = lds_byte(wc * 32 + fr, fq * 8);
#define PG8_SA(b, h) (((b) * 2 + (h)) * HTB)
#define PG8_SB(b, h) ((4 + (b) * 2 + (h)) * HTB)
#define PG8_STAGE(bufoff, gbase, voff) do { _Pragma("unroll") for (int _i = 0; _i < 2; ++_i) \
        __builtin_amdgcn_global_load_lds((const unsigned*)((const char*)(gbase) + (voff)[_i]), (PG8_LAS unsigned*)(lds + (bufoff) + ldsw + _i * 8192), 16, 0, 0); } while (0)
#define PG8_LDA(dst, b, h) do { _Pragma("unroll") for (int m = 0; m < 4; ++m) _Pragma("unroll") for (int k = 0; k < 2; ++k) dst[m][k] = *(const PG8_LAS bf16x8*)(lds + PG8_SA(b, h) + aoff + m * 2048 + k * 1024); } while (0)
#define PG8_LDB(dst, b, h) do { _Pragma("unroll") for (int n = 0; n < 2; ++n) _Pragma("unroll") for (int k = 0; k < 2; ++k) dst[n][k] = *(const PG8_LAS bf16x8*)(lds + PG8_SB(b, h) + boff + n * 2048 + k * 1024); } while (0)
#define PG8_MMA(ai, bj, At, Bt) do { __builtin_amdgcn_s_setprio(1); _Pragma("unroll") for (int m = 0; m < 4; ++m) _Pragma("unroll") for (int n = 0; n < 2; ++n) _Pragma("unroll") for (int k = 0; k < 2; ++k) \
        acc[ai][bj][m][n] = __builtin_amdgcn_mfma_f32_16x16x32_bf16(Bt[n][k], At[m][k], acc[ai][bj][m][n], 0, 0, 0); __builtin_amdgcn_s_setprio(0); } while (0)
#define PG8_WAIT_V(n) asm volatile("s_waitcnt vmcnt(" #n ")" ::: "memory")
#define PG8_WAIT_L(n) asm volatile("s_waitcnt lgkmcnt(" #n ")" ::: "memory")
#define PG8_BAR __builtin_amdgcn_s_barrier()
#define PG8_SCHED __builtin_amdgcn_sched_barrier(0)
    Unit cur, nxt; int ui = 0;
    if (!S.next(0, cur)) return;
    f32x4 acc[2][2][4][2];
#pragma unroll
    for (int a = 0; a < 2; ++a)
#pragma unroll
        for (int b = 0; b < 2; ++b)
#pragma unroll
            for (int m = 0; m < 4; ++m)
#pragma unroll
                for (int n = 0; n < 2; ++n) acc[a][b][m][n] = (f32x4){0.f, 0.f, 0.f, 0.f};
    bf16x8 At[4][2], B0[2][2], B1[2][2];
    const char* cA = (const char*)(cur.w ? g.A2 : g.A) + (size_t)cur.pm * tstep; const char* cB = (const char*)(cur.w ? g.Bt2 : g.Bt) + (size_t)cur.pn * tstep;
    S.a_ready(cur);
    PG8_STAGE(PG8_SB(0, 0), cB, voffB); PG8_STAGE(PG8_SA(0, 0), cA, voffA); PG8_STAGE(PG8_SB(0, 1), cB + hstep, voffB); PG8_STAGE(PG8_SA(0, 1), cA + hstep, voffA);
    if (wr == 1) PG8_BAR;
    PG8_WAIT_V(4); PG8_BAR;
    PG8_STAGE(PG8_SB(1, 0), cB + kstep, voffB); PG8_STAGE(PG8_SA(1, 0), cA + kstep, voffA); PG8_STAGE(PG8_SB(1, 1), cB + hstep + kstep, voffB);
    PG8_WAIT_V(6); PG8_BAR;
    PG8_STAMP();
    for (;;) {
        const bool has_next = S.next(ui + 1, nxt);
        const char* nA = has_next ? (const char*)(nxt.w ? g.A2 : g.A) + (size_t)nxt.pm * tstep : cA; const char* nB = has_next ? (const char*)(nxt.w ? g.Bt2 : g.Bt) + (size_t)nxt.pn * tstep : cB;
        for (int t = 0; t < nt; t += 2) {
            const bool last = (t == nt - 2);
            const char* a1 = cA + (size_t)(t + 1) * kstep;
            const char* a2 = last ? nA : cA + (size_t)(t + 2) * kstep; const char* b2 = last ? nB : cB + (size_t)(t + 2) * kstep;
            const char* a3 = a2 + kstep; const char* b3 = b2 + kstep;
            if (last && has_next) S.a_ready(nxt);
            PG8_LDB(B0, 0, 0); PG8_SCHED; PG8_LDA(At, 0, 0); PG8_STAGE(PG8_SA(1, 1), a1 + hstep, voffA);
            PG8_WAIT_L(8); PG8_BAR; PG8_WAIT_L(0); PG8_MMA(0, 0, At, B0); PG8_BAR; PG8_SCHED;
            PG8_LDB(B1, 0, 1); PG8_STAGE(PG8_SB(0, 0), b2, voffB);
            PG8_BAR; PG8_WAIT_L(0); PG8_MMA(0, 1, At, B1); PG8_BAR;
            PG8_LDA(At, 0, 1); PG8_STAGE(PG8_SA(0, 0), a2, voffA);
            PG8_BAR; PG8_WAIT_L(0); PG8_MMA(1, 0, At, B0); PG8_BAR; PG8_SCHED;
            PG8_STAGE(PG8_SB(0, 1), b2 + hstep, voffB);
            PG8_WAIT_V(6); PG8_BAR; PG8_MMA(1, 1, At, B1); PG8_BAR;
            PG8_LDB(B0, 1, 0); PG8_SCHED; PG8_LDA(At, 1, 0); PG8_STAGE(PG8_SA(0, 1), a2 + hstep, voffA);
            PG8_WAIT_L(8); PG8_BAR; PG8_WAIT_L(0); PG8_MMA(0, 0, At, B0); PG8_BAR; PG8_SCHED;
            PG8_LDB(B1, 1, 1); PG8_STAGE(PG8_SB(1, 0), b3, voffB);
            PG8_BAR; PG8_WAIT_L(0); PG8_MMA(0, 1, At, B1); PG8_BAR;
            PG8_LDA(At, 1, 1); PG8_STAGE(PG8_SA(1, 0), a3, voffA);
            PG8_BAR; PG8_WAIT_L(0); PG8_MMA(1, 0, At, B0); PG8_BAR; PG8_SCHED;
            PG8_STAGE(PG8_SB(1, 1), b3 + hstep, voffB);
            PG8_WAIT_V(6); PG8_BAR; PG8_MMA(1, 1, At, B1); PG8_BAR;
        }
        PG8_STAMP();
        if constexpr (!Epi::AFTER_DRAIN) { E(acc, cur, wr, wc, fr, fq); S.done(cur); }
        PG8_STAMP();
        if (!has_next) break;
#pragma unroll
        for (int a = 0; a < 2; ++a)
#pragma unroll
            for (int b = 0; b < 2; ++b)
#pragma unroll
                for (int m = 0; m < 4; ++m)
#pragma unroll
                    for (int n = 0; n < 2; ++n) acc[a][b][m][n] = (f32x4){0.f, 0.f, 0.f, 0.f};
        cur = nxt; cA = nA; cB = nB; ++ui;
    }
    PG8_WAIT_V(0);
    if (wr == 0) PG8_BAR;
    PG8_BAR;
    if constexpr (Epi::AFTER_DRAIN) { E.fused(acc, cur, wr, wc, fr, fq, lds, wid, lane); S.done(cur); }
    PG8_STAMP();
    if (STAMP && wid == 0) { stamps[lane] = lane < nts ? (((unsigned long long)(unsigned)ts_hi << 32) | (unsigned)ts_lo) : 0ull;
        if (lane == 62) stamps[62] = rt_entry; if (lane == 63) stamps[63] = (unsigned long long)wall_clock64(); }
#undef PG8_STAMP
#undef PG8_SA
#undef PG8_SB
#undef PG8_STAGE
#undef PG8_LDA
#undef PG8_LDB
#undef PG8_MMA
#undef PG8_WAIT_V
#undef PG8_WAIT_L
#undef PG8_BAR
#undef PG8_SCHED
}
}

#define XB_TMO      128
#define XB_XCNT(j)  (256  + 64 * (j))
#define XB_XSUB(j)  (1280 + 64 * (j))
#define XB_XGEN(j)  (2304 + 64 * (j))
#define XB_TOP      3328
#define XB_TOPGEN   3392
#define XCD_BAR_WORDS 3456
#define XB_SPIN_CAP (1u << 22)
#define LAS __attribute__((address_space(3)))

__device__ __forceinline__ unsigned xb_ld(unsigned* p)              { return __hip_atomic_load(p, __ATOMIC_RELAXED, __HIP_MEMORY_SCOPE_AGENT); }
__device__ __forceinline__ unsigned xb_add(unsigned* p, unsigned v) { return __hip_atomic_fetch_add(p, v, __ATOMIC_RELAXED, __HIP_MEMORY_SCOPE_AGENT); }
__device__ __forceinline__ unsigned xb_xcc_id() { return (unsigned)__builtin_amdgcn_s_getreg((3 << 11) | 20) & 0xFu; }
#define XB_SPIN(cond, bar) do { unsigned _sp = 0; while (cond) { __builtin_amdgcn_s_sleep(1); \
    if ((++_sp & 255u) == 0u) { if (xb_ld(&(bar)[XB_TMO])) break; if (_sp > XB_SPIN_CAP) { atomicAdd(&(bar)[XB_TMO], 1u); break; } } } } while (0)

struct XcdBarrier { unsigned* bar; unsigned x; volatile LAS unsigned* st; };

__device__ __forceinline__ XcdBarrier xcd_barrier_post(unsigned* bar, volatile LAS unsigned* st) {
    XcdBarrier b; b.bar = bar; b.x = xb_xcc_id(); b.st = st;
    if (threadIdx.x == 0) st[2] = xb_add(&bar[XB_XCNT(b.x)], 1u);
    return b;
}
__device__ __forceinline__ void xcd_barrier_complete(unsigned* bar, unsigned x, unsigned& nloc, unsigned& nx) {
    const unsigned G = gridDim.x * gridDim.y * gridDim.z;
    unsigned sum, cnt, mine, sp = 0u;
    for (;;) {
        sum = 0u; cnt = 0u; mine = 0u;
#pragma unroll
        for (unsigned j = 0; j < 16; ++j) { const unsigned c = xb_ld(&bar[XB_XCNT(j)]); sum += c; cnt += (c > 0u) ? 1u : 0u; mine = (j == x) ? c : mine; }
        if (sum == G) break;
        __builtin_amdgcn_s_sleep(1);
        if ((++sp & 255u) == 0u) { if (xb_ld(&bar[XB_TMO])) break; if (sp > XB_SPIN_CAP) { atomicAdd(&bar[XB_TMO], 1u); break; } }
    }
    nloc = mine > 0u ? mine : 1u; nx = cnt > 0u ? cnt : 1u;
}
__device__ __forceinline__ void xcd_barrier(const XcdBarrier& b) {
    asm volatile("s_waitcnt vmcnt(0)" ::: "memory");
    __syncthreads();
    if (threadIdx.x == 0) {
        unsigned* bar = b.bar;
        __builtin_amdgcn_s_waitcnt(0);
        unsigned nloc = b.st[0], nx = b.st[1];
        if (nloc == 0u) { xcd_barrier_complete(bar, b.x, nloc, nx); b.st[0] = nloc; b.st[1] = nx; }
        const unsigned old = xb_add(&bar[XB_XSUB(b.x)], 1u);
        const unsigned gen = old / nloc;
        if (old + 1u == (gen + 1u) * nloc) {
            __builtin_amdgcn_fence(__ATOMIC_RELEASE, "agent");
            asm volatile("s_waitcnt vmcnt(0)" ::: "memory");
            const unsigned og = xb_add(&bar[XB_TOP], 1u);
            const unsigned tg = og / nx;
            if (og + 1u == (tg + 1u) * nx) xb_add(&bar[XB_TOPGEN], 1u);
            else XB_SPIN(xb_ld(&bar[XB_TOPGEN]) == tg, bar);
            __builtin_amdgcn_fence(__ATOMIC_ACQUIRE, "agent");
            xb_add(&bar[XB_XGEN(b.x)], 1u);
            asm volatile("s_waitcnt vmcnt(0)" ::: "memory");
        } else {
            XB_SPIN(xb_ld(&bar[XB_XGEN(b.x)]) == gen, bar);
            __builtin_amdgcn_fence(__ATOMIC_ACQUIRE, "agent");
            asm volatile("s_waitcnt vmcnt(0)" ::: "memory");
        }
    }
    __syncthreads();
}

typedef unsigned short u16;
using pg8::bf16x8; using pg8::f32x4; using pg8::u32x4;
typedef float f32x2v __attribute__((ext_vector_type(2)));
typedef unsigned u32x2 __attribute__((ext_vector_type(2)));

constexpr int DM = 2048, NB = 4, SEQL = 4096, CTXL = 256, NLAT = NB * SEQL, NCTX = NB * CTXL, MROWS = NLAT + NCTX;
constexpr int DEPTH = 4, NMAIN = 3072, NTR = 1536;
constexpr int PJ_Q = 0, PJ_K = 1024, PJ_SU = 2048, PJ_SIN = 2560;
constexpr int TR_V = 0, TR_SV = 1024;
constexpr int NCHK = 68;
constexpr float EPSN = 1e-6f;

constexpr size_t al256(size_t x) { return (x + 255) & ~(size_t)255; }
constexpr size_t WS_BAR   = 0;
constexpr size_t WS_MOD   = 16384;
constexpr size_t WS_MODP  = al256(WS_MOD + (size_t)DEPTH * 5 * 6 * DM * 4);
constexpr size_t WS_X     = al256(WS_MODP + (size_t)64 * DEPTH * 5 * 6 * DM * 4);
constexpr size_t WS_H     = al256(WS_X + (size_t)MROWS * DM * 4);
constexpr size_t WS_PROJ  = al256(WS_H + (size_t)MROWS * DM * 2);
constexpr size_t WS_TR    = al256(WS_PROJ + (size_t)MROWS * NMAIN * 2);
constexpr size_t WS_ATT   = al256(WS_TR + (size_t)NTR * MROWS * 2);
constexpr size_t WS_SGU   = al256(WS_ATT + (size_t)MROWS * 1024 * 2);
constexpr size_t WS_S5Y   = al256(WS_SGU + (size_t)MROWS * 512 * 2);
constexpr size_t WS_S5O   = al256(WS_S5Y + (size_t)MROWS * 512 * 2);
constexpr size_t WS_YIN   = al256(WS_S5O + (size_t)MROWS * 512 * 2);
constexpr size_t WS_PQ    = al256(WS_YIN + (size_t)MROWS * DM * 2);
constexpr size_t PAIRS_MAX = (size_t)MROWS * 128;
constexpr size_t WS_ET    = al256(WS_PQ + (size_t)MROWS * DM * 2);
constexpr size_t WS_GT    = al256(WS_ET + PAIRS_MAX * 2);
constexpr size_t WS_PART  = al256(WS_GT + PAIRS_MAX * 4);
constexpr size_t WS_WT    = al256(WS_PART + 8 * PAIRS_MAX * 2);
constexpr size_t WS_H8    = al256(WS_WT + PAIRS_MAX * 2);
constexpr size_t WS_HSC   = al256(WS_H8 + (size_t)MROWS * DM);
constexpr size_t WS_SLOC  = al256(WS_HSC + (size_t)MROWS * 4);
constexpr size_t WS_WTS   = al256(WS_SLOC + (size_t)NB * 32 * 2 * NCHK * 64 * 8);
constexpr size_t WL_MAIN = 0;
constexpr size_t WL_TR   = WL_MAIN + (size_t)NMAIN * DM * 2;
constexpr size_t WL_OUT  = WL_TR + (size_t)NTR * DM * 2;
constexpr size_t WL_Q    = WL_OUT + (size_t)DM * DM * 2;
constexpr size_t WL_GLU  = WL_Q + (size_t)DM * DM * 2;
constexpr size_t WL_K12  = WL_GLU + (size_t)512 * 512 * 2;
constexpr size_t WL_U    = WL_K12 + (size_t)2 * 8 * 128 * 128 * 2;
constexpr size_t WL_V    = WL_U + (size_t)16384 * DM / 2;
constexpr size_t WL_SGUW = WL_V + (size_t)16384 * DM / 2;
constexpr size_t WL_SIZE = al256(WL_SGUW + (size_t)4 * 128 * 128 * 2);
constexpr float VSCALE = 5.5f, USCALE = 135.0f;
constexpr int PEER_NSL = 8, PEER_ROWB = 128;
constexpr size_t PEER_SLB = (size_t)16384 * 128;
constexpr size_t WS_END  = WS_WTS + DEPTH * WL_SIZE;

constexpr int LDS_BYTES = 147456;
constexpr int LDS_BARW  = LDS_BYTES - 32;

enum { I_X = 0, I_C, I_CTX, I_CCTX, I_ADAW, I_ADAB, I_NMIX, I_NFFN, I_WIN, I_WOUT, I_ONORM, I_RPB, I_SGUW, I_SGUB, I_SGUN, I_ARE, I_AIM, I_LOGDT, I_BRE, I_BIM, I_CRE, I_CIM, I_S5D, I_GLUW, I_GLUB,
       I_WQ, I_K1, I_K2, I_PU, I_PV, I_FNORM, N_IN };

struct Args { const float* in[N_IN]; float* out; unsigned char* ws; int ph_lo, ph_hi; };

struct Ctx {
    const float* in[N_IN]; float* out; unsigned char* ws; LAS unsigned char* lds;
    int tid, lane, wave, G, bid;
    float* MOD; float* MODP; u16* X; u16* H; u16* PROJ; u16* TR; u16* ATT; u16* SGU; u16* S5Y; u16* S5O; u16* YIN; u16* PQ; u16* ET; float* GT; u16* PART; u16* WT; unsigned char* H8; float* HSC; f32x2v* SLOC;
    int xi, nx, xr, xn;
    __device__ __forceinline__ unsigned char* wl(int l) const { return ws + WS_WTS + (size_t)l * WL_SIZE; }
    __device__ __forceinline__ void fresh() { int t = threadIdx.x; asm volatile("" : "+v"(t)); tid = t; lane = t & 63; wave = __builtin_amdgcn_readfirstlane(t >> 6); }
};

__device__ __forceinline__ float bf2f(u16 v) { return __uint_as_float(((unsigned)v) << 16); }
__device__ __forceinline__ float bflo(unsigned v) { return __uint_as_float(v << 16); }
__device__ __forceinline__ float bfhi(unsigned v) { return __uint_as_float(v & 0xffff0000u); }
__device__ __forceinline__ u16 f2bf(float f) { unsigned u = __float_as_uint(f); u += 0x7FFFu + ((u >> 16) & 1u); return (u16)(u >> 16); }
__device__ __forceinline__ unsigned pk2(float lo, float hi) { return pg8::cvt_pk_bf16(lo, hi); }
__device__ __forceinline__ float gelu_f(float v) {
    const float av = fabsf(v), t = __builtin_amdgcn_rcpf(av * 0.2316418882f + 1.0f);
    float q = t * 0.5307027145f + (-0.7265760135f); q = q * t + 0.7107068705f; q = q * t + (-0.142248368f); q = q * t + 0.127414796f; q = q * t;
    const float e = __builtin_amdgcn_exp2f((v * v) * (-0.72134752044f));
    const float m = v * (q * e);
    return v < 0.f ? m : v - m;
}
__device__ __forceinline__ float wave_sum(float v) {
    v += __shfl_xor(v, 32); v += __shfl_xor(v, 16); v += __shfl_xor(v, 8); v += __shfl_xor(v, 4); v += __shfl_xor(v, 2); v += __shfl_xor(v, 1); return v;
}
__device__ __forceinline__ int row_bidx(int row) { return row < NLAT ? (row >> 12) : 4; }
__device__ __forceinline__ void lds_fence() { asm volatile("s_waitcnt lgkmcnt(0)" ::: "memory"); }

__device__ __forceinline__ void tr_tile(const Ctx& c, const float* src, int ld, int k0, int n0, u16* dst, int drow0) {
    LAS float* T = (LAS float*)c.lds;
    const int t = c.tid, cq = t & 63, r0 = t >> 6;
    f32x4 v[8];
#pragma unroll
    for (int i = 0; i < 8; ++i) v[i] = *(const f32x4*)(src + (size_t)(k0 + r0 + 8 * i) * ld + n0 + 4 * cq);
#pragma unroll
    for (int i = 0; i < 8; ++i) *(LAS f32x4*)(T + (r0 + 8 * i) * 260 + 4 * cq) = v[i];
    __syncthreads();
#pragma unroll
    for (int i = 0; i < 4; ++i) {
        const int idx = t + 512 * i, n = idx >> 3, kc = idx & 7;
        float e[8];
#pragma unroll
        for (int q = 0; q < 8; ++q) e[q] = T[(8 * kc + q) * 260 + n];
        u32x4 o; o.x = pk2(e[0], e[1]); o.y = pk2(e[2], e[3]); o.z = pk2(e[4], e[5]); o.w = pk2(e[6], e[7]);
        *(u32x4*)(dst + (size_t)(drow0 + n) * DM + k0 + 8 * kc) = o;
    }
    __syncthreads();
}

__device__ __forceinline__ unsigned pack_i4(const float4& a, const float4& b) {
    const float ev[8] = {a.x, a.y, a.z, a.w, b.x, b.y, b.z, b.w};
    unsigned nb[8];
#pragma unroll
    for (int k2 = 0; k2 < 8; ++k2) { const int qv = (int)rintf(ev[k2] * USCALE); nb[k2] = (unsigned)(min(max(qv, -8), 7) + 8); }
    return nb[0] | (nb[4] << 4) | (nb[1] << 8) | (nb[5] << 12) | (nb[2] << 16) | (nb[6] << 20) | (nb[3] << 24) | (nb[7] << 28);
}
__device__ __forceinline__ unsigned pack_fp4(const float4& a, const float4& b) {
    unsigned w = 0u;
    w = __builtin_amdgcn_cvt_scalef32_pk_fp4_f32(w, a.x * VSCALE, a.y * VSCALE, 1.0f, 0); w = __builtin_amdgcn_cvt_scalef32_pk_fp4_f32(w, a.z * VSCALE, a.w * VSCALE, 1.0f, 1);
    w = __builtin_amdgcn_cvt_scalef32_pk_fp4_f32(w, b.x * VSCALE, b.y * VSCALE, 1.0f, 2); w = __builtin_amdgcn_cvt_scalef32_pk_fp4_f32(w, b.z * VSCALE, b.w * VSCALE, 1.0f, 3);
    return w;
}
template <bool IS_U>
__device__ __forceinline__ void peer_convert(const Ctx& c, int l, int b0, int nb, size_t i_lo = 0, size_t i_hi = (size_t)16384 * DM / 32) {
    if (c.bid < b0 || c.bid >= b0 + nb) return;
    const size_t n32 = i_hi, stride = (size_t)nb * 512;
    const float4* src = (const float4*)((IS_U ? c.in[I_PU] : c.in[I_PV]) + (size_t)l * 16384 * DM);
    u32x4* dst = (u32x4*)(c.wl(l) + (IS_U ? WL_U : WL_V));
    for (size_t i = i_lo + (size_t)(c.bid - b0) * 512 + c.tid; i < n32; i += 2 * stride) {
        const size_t i2 = i + stride; const bool two = i2 < n32; const size_t j2 = two ? i2 : i;
        float4 a[8], b[8];
#pragma unroll
        for (int q = 0; q < 8; ++q) { a[q] = src[8 * i + q]; b[q] = src[8 * j2 + q]; }
        u32x4 o, p;
        if (IS_U) { o = (u32x4){pack_i4(a[0], a[1]), pack_i4(a[2], a[3]), pack_i4(a[4], a[5]), pack_i4(a[6], a[7])}; p = (u32x4){pack_i4(b[0], b[1]), pack_i4(b[2], b[3]), pack_i4(b[4], b[5]), pack_i4(b[6], b[7])}; }
        else      { o = (u32x4){pack_fp4(a[0], a[1]), pack_fp4(a[2], a[3]), pack_fp4(a[4], a[5]), pack_fp4(a[6], a[7])}; p = (u32x4){pack_fp4(b[0], b[1]), pack_fp4(b[2], b[3]), pack_fp4(b[4], b[5]), pack_fp4(b[6], b[7])}; }
        dst[((i & 63) >> 3) * 131072 + (i >> 6) * 8 + (i & 7)] = o; if (two) dst[((i2 & 63) >> 3) * 131072 + (i2 >> 6) * 8 + (i2 & 7)] = p;
    }
}
__device__ __forceinline__ void peer_convert_u(const Ctx& c, int l, int b0, int nb, size_t i_lo = 0, size_t i_hi = (size_t)16384 * DM / 32) { peer_convert<true>(c, l, b0, nb, i_lo, i_hi); }
__device__ __forceinline__ void peer_convert_v(const Ctx& c, int l, int b0, int nb) { peer_convert<false>(c, l, b0, nb); }

__device__ __forceinline__ void phase_prologue(const Ctx& c) {
    const int G = c.G, bid = c.bid, tid = c.tid;
    {
        const size_t n8 = (size_t)MROWS * DM / 8, nl8 = (size_t)NLAT * DM / 8;
        const float4* sx = (const float4*)c.in[I_X]; const float4* sc = (const float4*)c.in[I_CTX]; u32x4* dx = (u32x4*)c.X;
        for (size_t i = (size_t)bid * 512 + tid; i < n8; i += (size_t)G * 512) {
            const float4* s = i < nl8 ? sx + 2 * i : sc + 2 * (i - nl8);
            const float4 a = s[0], b = s[1];
            dx[i] = (u32x4){pk2(a.x, a.y), pk2(a.z, a.w), pk2(b.x, b.y), pk2(b.z, b.w)};
        }
    }
    for (int l = 0; l < DEPTH; ++l) {
        unsigned char* W = c.wl(l);
        const float* win = c.in[I_WIN] + (size_t)l * DM * 4608;
        for (int it = bid; it < 32 * 18; it += G) {
            const int kt = it & 31, nt = it >> 5, n0 = nt * 256;
            u16* dst; int drow;
            if (n0 < 2048) { dst = (u16*)(W + WL_MAIN); drow = n0; }
            else if (n0 < 3072) { dst = (u16*)(W + WL_TR); drow = n0 - 2048; }
            else if (n0 < 3584) { dst = (u16*)(W + WL_MAIN); drow = 2048 + (n0 - 3072); }
            else if (n0 < 4096) { dst = (u16*)(W + WL_TR); drow = 1024 + (n0 - 3584); }
            else { dst = (u16*)(W + WL_MAIN); drow = 2560 + (n0 - 4096); }
            tr_tile(c, win, 4608, kt * 64, n0, dst, drow);
        }
        const float* wout = c.in[I_WOUT] + (size_t)l * DM * DM;
        for (int it = bid; it < 32 * 8; it += G) tr_tile(c, wout, DM, (it & 31) * 64, (it >> 5) * 256, (u16*)(W + WL_OUT), (it >> 5) * 256);
        const float* wq = c.in[I_WQ] + (size_t)l * DM * DM;
        for (int it = bid; it < 32 * 8; it += G) tr_tile(c, wq, DM, (it & 31) * 64, (it >> 5) * 256, (u16*)(W + WL_Q), (it >> 5) * 256);
        {
            const float* gw = c.in[I_GLUW] + (size_t)l * 512 * 512; u16* dst = (u16*)(W + WL_GLU);
            LAS float* T = (LAS float*)c.lds;
            for (int it = bid; it < 8 * 8; it += G) {
                const int k0 = (it & 7) * 64, n0 = (it >> 3) * 64, t = tid;
#pragma unroll
                for (int i = 0; i < 8; ++i) { const int r = (t >> 6) + 8 * i; T[r * 65 + (t & 63)] = gw[(size_t)(k0 + r) * 512 + n0 + (t & 63)]; }
                __syncthreads();
#pragma unroll
                for (int i = 0; i < 4; ++i) { const int n = (t >> 5) + 16 * i, kp = t & 31;
                    *(unsigned*)(dst + (size_t)(n0 + n) * 512 + k0 + 2 * kp) = pk2(T[(2 * kp) * 65 + n], T[(2 * kp + 1) * 65 + n]); }
                __syncthreads();
            }
        }
        {
            const float* sw = c.in[I_SGUW] + (size_t)l * 4 * 128 * 128; u16* dst = (u16*)(W + WL_SGUW);
            for (int i = bid * 512 + tid; i < 4 * 128 * 128 / 2; i += G * 512) *(unsigned*)(dst + 2 * i) = pk2(sw[2 * i], sw[2 * i + 1]);
        }
        {
            u16* dst = (u16*)(W + WL_K12);
            const float* k1 = c.in[I_K1] + (size_t)l * 8 * 128 * 128; const float* k2 = c.in[I_K2] + (size_t)l * 8 * 128 * 128;
            for (int i = bid * 512 + tid; i < 2 * 131072 / 2; i += G * 512) {
                const int e = 2 * i; const float* s = e < 131072 ? k1 + e : k2 + (e - 131072);
                *(unsigned*)(dst + e) = pk2(s[0], s[1]);
            }
        }
    }
    { const int nl = (G == 256) ? 1 : DEPTH;
      for (int l = 0; l < nl; ++l) { peer_convert_u(c, l, 0, G); peer_convert_v(c, l, 0, G); } }
    {
        LAS float* S = (LAS float*)c.lds;
        for (int it = bid; it < DEPTH * 24 * 16; it += G) {
            const int kc = it & 15, nb = (it >> 4) % 24, l = it / (16 * 24);
            __syncthreads();
            for (int i = tid; i < 640; i += 512) { const int r = i >> 7, kk = i & 127; const float v = r < 4 ? c.in[I_C][r * DM + kc * 128 + kk] : c.in[I_CCTX][kc * 128 + kk]; S[i] = v / (1.0f + __expf(-v)); }
            __syncthreads();
            const int cq = tid & 127, kq = tid >> 7, n = nb * 512 + 4 * cq;
            const float* w = c.in[I_ADAW] + ((size_t)l * DM + kc * 128 + kq * 32) * 12288 + n;
            float4 a[5];
#pragma unroll
            for (int r = 0; r < 5; ++r) a[r] = make_float4(0.f, 0.f, 0.f, 0.f);
#pragma unroll 16
            for (int kk = 0; kk < 32; ++kk) {
                const float4 wv = *(const float4*)(w + (size_t)kk * 12288);
#pragma unroll
                for (int r = 0; r < 5; ++r) { const float sv = S[r * 128 + kq * 32 + kk]; a[r].x += sv * wv.x; a[r].y += sv * wv.y; a[r].z += sv * wv.z; a[r].w += sv * wv.w; }
            }
            float* o = c.MODP + ((size_t)((kc * 4 + kq) * DEPTH + l) * 5) * 12288 + n;
#pragma unroll
            for (int r = 0; r < 5; ++r) *(float4*)(o + (size_t)r * 12288) = a[r];
        }
        __syncthreads();
    }
}

__device__ __forceinline__ void phase_modfin(const Ctx& c) {
    const int total = DEPTH * 5 * 12288;
    for (int i = c.bid * 512 + c.tid; i < total; i += c.G * 512) {
        const int n = i % 12288, l = i / (5 * 12288);
        float s = c.in[I_ADAB][l * 12288 + n];
#pragma unroll
        for (int kc = 0; kc < 64; ++kc) s += c.MODP[(size_t)kc * total + i];
        const int mi = n >> 11, col = n & 2047;
        if (mi == 1) s = c.in[I_NMIX][l * DM + col] * (1.0f + s);
        if (mi == 4) s = c.in[I_NFFN][l * DM + col] * (1.0f + s);
        c.MOD[i] = s;
    }
}

__device__ __forceinline__ void phase_normmod(const Ctx& c, int l, int which, int nrows, int row0 = 0, int b0 = 0, int nb = 0) {
    if (nb == 0) nb = c.G;
    if (c.bid < b0 || c.bid >= b0 + nb) return;
    int row = row0 + (c.bid - b0) * 8 + c.wave;
    if (row >= row0 + nrows) return;
    u32x2 xn[8];
    { const u32x2* xp = (const u32x2*)(c.X + (size_t)row * DM);
#pragma unroll
      for (int i = 0; i < 8; ++i) xn[i] = xp[c.lane + 64 * i]; }
    for (; row < row0 + nrows; row += nb * 8) {
        const int bi = row_bidx(row);
        const float* sh = c.MOD + ((size_t)(l * 5 + bi) * 6 + (which ? 3 : 0)) * DM; const float* sc = sh + DM;
        float4 v[8]; float ss = 0.f;
#pragma unroll
        for (int i = 0; i < 8; ++i) { const u32x2 xw = xn[i]; v[i] = make_float4(bflo(xw.x), bfhi(xw.x), bflo(xw.y), bfhi(xw.y)); ss += v[i].x * v[i].x + v[i].y * v[i].y + v[i].z * v[i].z + v[i].w * v[i].w; }
        float4 s1v[8], s0v[8];
#pragma unroll
        for (int i = 0; i < 8; ++i) { const int e = 4 * (c.lane + 64 * i); s1v[i] = *(const float4*)(sc + e); s0v[i] = *(const float4*)(sh + e); }
        asm volatile("" ::: "memory");
        { const u32x2* xp = (const u32x2*)(c.X + (size_t)min(row + nb * 8, row0 + nrows - 1) * DM);
#pragma unroll
          for (int i = 0; i < 8; ++i) xn[i] = xp[c.lane + 64 * i]; }
        asm volatile("" ::: "memory");
        ss = wave_sum(ss);
        const float rstd = rsqrtf(ss * (1.0f / DM) + EPSN);
        uint2* hp = (uint2*)(c.H + (size_t)row * DM);
        float amax = 0.f;
#pragma unroll
        for (int i = 0; i < 8; ++i) {
            const float4 s1 = s1v[i], s0 = s0v[i];
            const float y0 = v[i].x * rstd * s1.x + s0.x, y1 = v[i].y * rstd * s1.y + s0.y;
            const float y2 = v[i].z * rstd * s1.z + s0.z, y3 = v[i].w * rstd * s1.w + s0.w;
            uint2 o; o.x = pk2(y0, y1); o.y = pk2(y2, y3); hp[c.lane + 64 * i] = o;
            if (which) { v[i] = make_float4(y0, y1, y2, y3); amax = fmaxf(fmaxf(amax, fmaxf(fabsf(y0), fabsf(y1))), fmaxf(fabsf(y2), fabsf(y3))); }
        }
        if (which) {
            amax = fmaxf(amax, __shfl_xor(amax, 32)); amax = fmaxf(amax, __shfl_xor(amax, 16)); amax = fmaxf(amax, __shfl_xor(amax, 8));
            amax = fmaxf(amax, __shfl_xor(amax, 4)); amax = fmaxf(amax, __shfl_xor(amax, 2)); amax = fmaxf(amax, __shfl_xor(amax, 1));
            const float qs = amax > 0.f ? 127.0f / amax : 0.f;
            unsigned* qp = (unsigned*)(c.H8 + (size_t)row * DM);
#pragma unroll
            for (int i = 0; i < 8; ++i) {
                const int q0 = (int)rintf(v[i].x * qs), q1 = (int)rintf(v[i].y * qs), q2 = (int)rintf(v[i].z * qs), q3 = (int)rintf(v[i].w * qs);
                qp[c.lane + 64 * i] = (unsigned)(q0 & 0xFF) | ((unsigned)(q1 & 0xFF) << 8) | ((unsigned)(q2 & 0xFF) << 16) | ((unsigned)(q3 & 0xFF) << 24);
            }
            if (c.lane == 0) c.HSC[row] = amax * (1.0f / 127.0f);
        }
    }
}

struct EpiProj {
    static constexpr bool PERM = true, AFTER_DRAIN = false;
    u16* P; u16* T;
    __device__ __forceinline__ void operator()(const f32x4 (&acc)[2][2][4][2], const pg8::Unit& u, int wr, int wc, int fr, int fq) const {
        u16* base = u.w ? T : P; const int ldc = u.w ? MROWS : NMAIN;
        const int row0 = u.pm * 256 + wr * 64 + fr, col0 = u.pn * 256 + wc * 32 + 8 * fq;
#pragma unroll
        for (int ai = 0; ai < 2; ++ai)
#pragma unroll
            for (int m = 0; m < 4; ++m) { u16* rowp = base + (size_t)(row0 + ai * 128 + m * 16) * ldc + col0;
#pragma unroll
                for (int bj = 0; bj < 2; ++bj) { const f32x4 v0 = acc[ai][bj][m][0], v1 = acc[ai][bj][m][1];
                    u32x4 w; w.x = pk2(v0[0], v0[1]); w.y = pk2(v0[2], v0[3]); w.z = pk2(v1[0], v1[1]); w.w = pk2(v1[2], v1[3]);
                    *(u32x4*)(rowp + bj * 128) = w; } }
    }
};
struct EpiResid {
    static constexpr bool PERM = false, AFTER_DRAIN = false;
    u16* X; const float* modl; int row_off;
    __device__ __forceinline__ void operator()(const f32x4 (&acc)[2][2][4][2], const pg8::Unit& u, int wr, int wc, int fr, int fq) const {
        const int row0 = u.pm * 256 + wr * 64 + fr, col0 = u.pn * 256 + wc * 32 + 4 * fq;
        const int bi = row_bidx(u.pm * 256 + row_off);
        const float* gp = modl + ((size_t)bi * 6 + 2) * DM + col0;
        f32x4 gv[2][2];
#pragma unroll
        for (int bj = 0; bj < 2; ++bj)
#pragma unroll
            for (int n = 0; n < 2; ++n) gv[bj][n] = *(const f32x4*)(gp + bj * 128 + n * 16);
#pragma unroll
        for (int ai = 0; ai < 2; ++ai) {
            u32x2 xv[4][2][2];
#pragma unroll
            for (int m = 0; m < 4; ++m)
#pragma unroll
                for (int bj = 0; bj < 2; ++bj)
#pragma unroll
                    for (int n = 0; n < 2; ++n) xv[m][bj][n] = *(const u32x2*)(X + (size_t)(row0 + ai * 128 + m * 16) * DM + col0 + bj * 128 + n * 16);
            __builtin_amdgcn_sched_barrier(0);
#pragma unroll
            for (int m = 0; m < 4; ++m) { u16* rowp = X + (size_t)(row0 + ai * 128 + m * 16) * DM + col0;
#pragma unroll
                for (int bj = 0; bj < 2; ++bj)
#pragma unroll
                    for (int n = 0; n < 2; ++n) { u32x2* p = (u32x2*)(rowp + bj * 128 + n * 16); const u32x2 xw = xv[m][bj][n]; const f32x4 r = (f32x4){bflo(xw.x), bfhi(xw.x), bflo(xw.y), bfhi(xw.y)} + gv[bj][n] * acc[ai][bj][m][n];
                        *p = (u32x2){pk2(r[0], r[1]), pk2(r[2], r[3])}; } }
            __builtin_amdgcn_sched_barrier(0);
        }
    }
};
struct EpiGlu {
    static constexpr bool PERM = true, AFTER_DRAIN = false;
    const u16* Y; u16* O; const float* bias;
    __device__ __forceinline__ void operator()(const f32x4 (&acc)[2][2][4][2], const pg8::Unit& u, int wr, int wc, int fr, int fq) const {
        const int row0 = u.pm * 256 + wr * 64 + fr, col0 = u.pn * 256 + wc * 32 + 8 * fq;
        f32x4 bv[2][2];
#pragma unroll
        for (int bj = 0; bj < 2; ++bj)
#pragma unroll
            for (int n = 0; n < 2; ++n) bv[bj][n] = *(const f32x4*)(bias + col0 + bj * 128 + 4 * n);
#pragma unroll
        for (int ai = 0; ai < 2; ++ai) {
            u32x4 yq[4][2];
#pragma unroll
            for (int m = 0; m < 4; ++m)
#pragma unroll
                for (int bj = 0; bj < 2; ++bj) yq[m][bj] = *(const u32x4*)(Y + (size_t)(row0 + ai * 128 + m * 16) * 512 + col0 + bj * 128);
            __builtin_amdgcn_sched_barrier(0);
#pragma unroll
            for (int m = 0; m < 4; ++m) { const size_t off = (size_t)(row0 + ai * 128 + m * 16) * 512 + col0;
#pragma unroll
                for (int bj = 0; bj < 2; ++bj) {
                    const u32x4 yv = yq[m][bj];
                    const f32x4 v0 = acc[ai][bj][m][0] + bv[bj][0], v1 = acc[ai][bj][m][1] + bv[bj][1];
                    float y[8] = {bflo(yv.x), bfhi(yv.x), bflo(yv.y), bfhi(yv.y), bflo(yv.z), bfhi(yv.z), bflo(yv.w), bfhi(yv.w)};
                    float z[8] = {v0[0], v0[1], v0[2], v0[3], v1[0], v1[1], v1[2], v1[3]};
#pragma unroll
                    for (int j = 0; j < 8; ++j) y[j] = y[j] / (1.0f + __expf(-z[j]));
                    u32x4 w; w.x = pk2(y[0], y[1]); w.y = pk2(y[2], y[3]); w.z = pk2(y[4], y[5]); w.w = pk2(y[6], y[7]);
                    *(u32x4*)(O + off + bj * 128) = w; } }
            __builtin_amdgcn_sched_barrier(0);
        }
    }
};

constexpr int AT_KC_STRIDE = 272, AT_VC_STRIDE = 528;
constexpr int AT_KC_OFF = 0, AT_VC_OFF = 256 * AT_KC_STRIDE, AT_BT_OFF = AT_VC_OFF + 128 * AT_VC_STRIDE, AT_END = AT_BT_OFF + 15 * 64 * 4;
static_assert(AT_END <= LDS_BARW, "attention LDS");
__device__ __forceinline__ void attn_block_load(const Ctx& c, int l, int b, int head) {
    const int tid = c.tid;
    __syncthreads();
    u32x4 tk[8], tv[8];
#pragma unroll
    for (int i = 0; i < 8; ++i) { const int e = tid + 512 * i, key = e >> 4, ch = e & 15; tk[i] = *(const u32x4*)(c.PROJ + (size_t)(NLAT + b * CTXL + key) * NMAIN + PJ_K + head * 128 + ch * 8); }
#pragma unroll
    for (int i = 0; i < 8; ++i) { const int e = tid + 512 * i, d = e >> 5, ch = e & 31; tv[i] = *(const u32x4*)(c.TR + (size_t)(TR_V + head * 128 + d) * MROWS + NLAT + b * CTXL + ch * 8); }
#pragma unroll
    for (int i = 0; i < 8; ++i) { const int e = tid + 512 * i, key = e >> 4, ch = e & 15; *(LAS u32x4*)(c.lds + AT_KC_OFF + key * AT_KC_STRIDE + ch * 16) = tk[i]; }
#pragma unroll
    for (int i = 0; i < 8; ++i) { const int e = tid + 512 * i, d = e >> 5, ch = e & 31; *(LAS u32x4*)(c.lds + AT_VC_OFF + d * AT_VC_STRIDE + ch * 16) = tv[i]; }
    LAS float* BT = (LAS float*)(c.lds + AT_BT_OFF);
    const float* src = c.in[I_RPB] + (size_t)(l * 8 + head) * 465;
    for (int i = tid; i < 15 * 64; i += 512) { const int col = (i & 63) - 16, row = i >> 6; BT[i] = (col >= 0 && col < 31) ? src[row * 31 + col] : 0.f; }
    __syncthreads();
}
template <bool WINDOW>
__device__ __forceinline__ void attn_segment(const Ctx& c, int b, int r, int head, int qt, int r_start, int cbase, const bf16x8 (&qf)[4], f32x4 (&O)[8], float& mrun, float& lrun) {
    const int lane = c.lane, n = lane & 15, lg = lane >> 4;
    f32x4 S[8][2];
    if (WINDOW) {
        const u16* kp0 = c.PROJ + (size_t)(b * SEQL + r_start * 64 + cbase + 8 * (n >> 2) + (n & 3)) * NMAIN + PJ_K + head * 128 + 8 * lg;
#pragma unroll
        for (int gi = 0; gi < 8; ++gi) {
            bf16x8 kf[2][4];
#pragma unroll
            for (int t = 0; t < 2; ++t)
#pragma unroll
                for (int kk = 0; kk < 4; ++kk) kf[t][kk] = *(const bf16x8*)(kp0 + (size_t)(gi * 64 + 4 * t) * NMAIN + 32 * kk);
            __builtin_amdgcn_sched_barrier(0);
#pragma unroll
            for (int t = 0; t < 2; ++t) {
                f32x4 acc = {0.f, 0.f, 0.f, 0.f};
#pragma unroll
                for (int kk = 0; kk < 4; ++kk) acc = __builtin_amdgcn_mfma_f32_16x16x32_bf16(kf[t][kk], qf[kk], acc, 0, 0, 0);
                S[gi][t] = acc;
            }
            __builtin_amdgcn_sched_barrier(0);
        }
    } else {
#pragma unroll
        for (int gi = 0; gi < 8; ++gi) {
#pragma unroll
            for (int t = 0; t < 2; ++t) {
                const int ko = 8 * (n >> 2) + 4 * t + (n & 3);
                f32x4 acc = {0.f, 0.f, 0.f, 0.f};
                const LAS unsigned char* kp = c.lds + AT_KC_OFF + (32 * gi + ko) * AT_KC_STRIDE + 16 * lg;
#pragma unroll
                for (int kk = 0; kk < 4; ++kk) { const bf16x8 a = *(const LAS bf16x8*)(kp + 64 * kk); acc = __builtin_amdgcn_mfma_f32_16x16x32_bf16(a, qf[kk], acc, 0, 0, 0); }
                S[gi][t] = acc;
            }
        }
    }
    const float scale = 0.08838834764831845f;
    float mx = -3.0e38f;
    const int qc = 16 * qt + n, cs = min(max(qc - 8, 0), 48);
    const LAS float* BT = (const LAS float*)(c.lds + AT_BT_OFF);
    const int btbase = WINDOW ? (r_start - r + 7) * 64 + (cbase + 8 * lg - qc + 15 + 16) : 0;
#pragma unroll
    for (int gi = 0; gi < 8; ++gi)
#pragma unroll
        for (int t = 0; t < 2; ++t)
#pragma unroll
            for (int rr = 0; rr < 4; ++rr) {
                float s = S[gi][t][rr] * scale;
                if (WINDOW) {
                    const int kc = cbase + 8 * lg + 4 * t + rr;
                    const bool valid = (kc >= cs) && (kc < cs + 16);
                    const float bias = BT[btbase + gi * 64 + 4 * t + rr];
                    s = valid ? s + bias : -INFINITY;
                }
                S[gi][t][rr] = s; mx = fmaxf(mx, s);
            }
    mx = fmaxf(mx, __shfl_xor(mx, 16)); mx = fmaxf(mx, __shfl_xor(mx, 32));
    const float mnew = fmaxf(mrun, mx), resc = exp2f((mrun - mnew) * 1.4426950408889634f);
    float sum = 0.f;
#pragma unroll
    for (int gi = 0; gi < 8; ++gi)
#pragma unroll
        for (int t = 0; t < 2; ++t)
#pragma unroll
            for (int rr = 0; rr < 4; ++rr) { const float p = exp2f((S[gi][t][rr] - mnew) * 1.4426950408889634f); S[gi][t][rr] = p; sum += p; }
    sum += __shfl_xor(sum, 16); sum += __shfl_xor(sum, 32);
    lrun = lrun * resc + sum; mrun = mnew;
#pragma unroll
    for (int dt = 0; dt < 8; ++dt) O[dt] *= resc;
    if (WINDOW) {
        const u16* vp0 = c.TR + (size_t)(TR_V + head * 128 + n) * MROWS + (b * SEQL + r_start * 64 + cbase) + 8 * lg;
#pragma unroll
        for (int gi = 0; gi < 8; ++gi) {
            u32x4 pw; pw.x = pk2(S[gi][0][0], S[gi][0][1]); pw.y = pk2(S[gi][0][2], S[gi][0][3]); pw.z = pk2(S[gi][1][0], S[gi][1][1]); pw.w = pk2(S[gi][1][2], S[gi][1][3]);
            const bf16x8 pb = __builtin_bit_cast(bf16x8, pw);
            bf16x8 vf[8];
#pragma unroll
            for (int dt = 0; dt < 8; ++dt) vf[dt] = *(const bf16x8*)(vp0 + (size_t)(16 * dt) * MROWS + gi * 64);
            __builtin_amdgcn_sched_barrier(0);
#pragma unroll
            for (int dt = 0; dt < 8; ++dt) O[dt] = __builtin_amdgcn_mfma_f32_16x16x32_bf16(vf[dt], pb, O[dt], 0, 0, 0);
            __builtin_amdgcn_sched_barrier(0);
        }
    } else {
#pragma unroll
        for (int gi = 0; gi < 8; ++gi) {
            u32x4 pw; pw.x = pk2(S[gi][0][0], S[gi][0][1]); pw.y = pk2(S[gi][0][2], S[gi][0][3]); pw.z = pk2(S[gi][1][0], S[gi][1][1]); pw.w = pk2(S[gi][1][2], S[gi][1][3]);
            const bf16x8 pb = __builtin_bit_cast(bf16x8, pw);
            const LAS unsigned char* vp = c.lds + AT_VC_OFF + n * AT_VC_STRIDE + (32 * gi + 8 * lg) * 2;
#pragma unroll
            for (int dt = 0; dt < 8; ++dt) { const bf16x8 va = *(const LAS bf16x8*)(vp + 16 * dt * AT_VC_STRIDE); O[dt] = __builtin_amdgcn_mfma_f32_16x16x32_bf16(va, pb, O[dt], 0, 0, 0); }
        }
    }
}
template <bool LOCAL>
__device__ __forceinline__ void attn_item(const Ctx& c, int b, int r, int head, int qt) {
    const int lane = c.lane, n = lane & 15, lg = lane >> 4;
    const int qrow0 = LOCAL ? (b * SEQL + r * 64 + 16 * qt) : (NLAT + b * CTXL + 16 * qt);
    const int r_start = LOCAL ? min(max(r - 4, 0), 56) : 0;
    const int cbase = LOCAL ? (qt == 0 ? 0 : (qt == 1 ? 8 : (qt == 2 ? 24 : 32))) : 0;
    bf16x8 qf[4];
    { const u16* qp = c.PROJ + (size_t)(qrow0 + n) * NMAIN + PJ_Q + head * 128 + 8 * lg;
#pragma unroll
      for (int kk = 0; kk < 4; ++kk) qf[kk] = *(const bf16x8*)(qp + 32 * kk); }
    f32x4 O[8];
#pragma unroll
    for (int dt = 0; dt < 8; ++dt) O[dt] = (f32x4){0.f, 0.f, 0.f, 0.f};
    float mrun = -3.0e38f, lrun = 0.f;
    attn_segment<false>(c, b, r, head, qt, r_start, cbase, qf, O, mrun, lrun);
    if (LOCAL) attn_segment<true>(c, b, r, head, qt, r_start, cbase, qf, O, mrun, lrun);
    const float inv = 1.0f / lrun;
    u16* op = c.ATT + (size_t)(qrow0 + n) * 1024 + head * 128 + 4 * lg;
#pragma unroll
    for (int dt = 0; dt < 8; ++dt) { uint2 o; o.x = pk2(O[dt][0] * inv, O[dt][1] * inv); o.y = pk2(O[dt][2] * inv, O[dt][3] * inv); *(uint2*)(op + 16 * dt) = o; }
}
__device__ __forceinline__ void phase_attention(const Ctx& c, int l, bool last) {
    for (int bh = c.bid; bh < 256; bh += c.G) {
        const int b = bh >> 6, head = (bh >> 3) & 7, sub = bh & 7;
        attn_block_load(c, l, b, head);
#pragma unroll 1
        for (int i = 0; i < 4; ++i) { const int item = c.wave + 8 * i; attn_item<true>(c, b, sub * 8 + (item >> 2), head, item & 3); }
        if (!last && c.wave < 2) attn_item<false>(c, b, 0, head, sub * 2 + c.wave);
    }
    __syncthreads();
}

__device__ __forceinline__ void sgu_item(const Ctx& c, int l, int chunk) {
    const int tid = c.tid, lane = c.lane, n = lane & 15, lg = lane >> 4;
    const int tok0 = chunk < 128 ? chunk * 128 : NLAT + (chunk - 128) * 128;
    LAS float* part = (LAS float*)c.lds;
    LAS float* rstd = part + 32 * 128;
    __syncthreads();
    {
        const int sg = tid & 15, cg = tid >> 4;
        float a[8];
#pragma unroll
        for (int j = 0; j < 8; ++j) a[j] = 0.f;
        u32x4 vv[16];
#pragma unroll
        for (int cc = 0; cc < 16; ++cc) vv[cc] = *(const u32x4*)(c.TR + (size_t)(TR_SV + cg * 16 + cc) * MROWS + tok0 + 8 * sg);
        __builtin_amdgcn_sched_barrier(0);
#pragma unroll
        for (int cc = 0; cc < 16; ++cc) {
            const u32x4 v = vv[cc];
            const float x[8] = {bflo(v.x), bfhi(v.x), bflo(v.y), bfhi(v.y), bflo(v.z), bfhi(v.z), bflo(v.w), bfhi(v.w)};
#pragma unroll
            for (int j = 0; j < 8; ++j) { const float g = gelu_f(x[j]); a[j] += g * g; }
        }
#pragma unroll
        for (int j = 0; j < 8; ++j) part[cg * 128 + 8 * sg + j] = a[j];
    }
    __syncthreads();
    if (tid < 128) { float s = 0.f; for (int cg = 0; cg < 32; ++cg) s += part[cg * 128 + tid]; rstd[tid] = rsqrtf(s * (1.0f / 512.0f) + EPSN); }
    __syncthreads();
    const int hs = c.wave >> 1, th = c.wave & 1;
    const u16* wsp = (const u16*)(c.wl(l) + WL_SGUW) + ((size_t)hs * 128) * 128;
    const float* gn = c.in[I_SGUN] + (size_t)l * 512 + hs * 128;
    const float* bsp = c.in[I_SGUB] + (size_t)(l * 4 + hs) * 128;
#pragma unroll 1
    for (int ch = 0; ch < 2; ++ch) {
        f32x4 acc[4][4];
#pragma unroll
        for (int mt = 0; mt < 4; ++mt)
#pragma unroll
            for (int ct = 0; ct < 4; ++ct) acc[mt][ct] = (f32x4){0.f, 0.f, 0.f, 0.f};
        float gcv[4];
#pragma unroll
        for (int ct = 0; ct < 4; ++ct) gcv[ct] = gn[64 * ch + 16 * ct + n];
        bf16x8 afN[4]; u32x4 vN[4];
#pragma unroll
        for (int mt = 0; mt < 4; ++mt) afN[mt] = *(const bf16x8*)(wsp + (size_t)(64 * th + 16 * mt + n) * 128 + 8 * lg);
#pragma unroll
        for (int ct = 0; ct < 4; ++ct) vN[ct] = *(const u32x4*)(c.TR + (size_t)(TR_SV + hs * 128 + 64 * ch + 16 * ct + n) * MROWS + tok0 + 8 * lg);
#pragma unroll 1
        for (int kk = 0; kk < 4; ++kk) {
            bf16x8 af[4]; u32x4 vq[4];
#pragma unroll
            for (int q = 0; q < 4; ++q) { af[q] = afN[q]; vq[q] = vN[q]; }
            { const int kn = kk < 3 ? kk + 1 : 3;
#pragma unroll
              for (int mt = 0; mt < 4; ++mt) afN[mt] = *(const bf16x8*)(wsp + (size_t)(64 * th + 16 * mt + n) * 128 + 32 * kn + 8 * lg);
#pragma unroll
              for (int ct = 0; ct < 4; ++ct) vN[ct] = *(const u32x4*)(c.TR + (size_t)(TR_SV + hs * 128 + 64 * ch + 16 * ct + n) * MROWS + tok0 + 32 * kn + 8 * lg); }
            __builtin_amdgcn_sched_barrier(0);
            const f32x4 r0 = *(const LAS f32x4*)(rstd + 32 * kk + 8 * lg), r1 = *(const LAS f32x4*)(rstd + 32 * kk + 8 * lg + 4);
#pragma unroll
            for (int ct = 0; ct < 4; ++ct) {
                const u32x4 v = vq[ct];
                const float gc = gcv[ct];
                const float x0 = gelu_f(bflo(v.x)) * r0[0] * gc, x1 = gelu_f(bfhi(v.x)) * r0[1] * gc, x2 = gelu_f(bflo(v.y)) * r0[2] * gc, x3 = gelu_f(bfhi(v.y)) * r0[3] * gc;
                const float x4 = gelu_f(bflo(v.z)) * r1[0] * gc, x5 = gelu_f(bfhi(v.z)) * r1[1] * gc, x6 = gelu_f(bflo(v.w)) * r1[2] * gc, x7 = gelu_f(bfhi(v.w)) * r1[3] * gc;
                u32x4 pw; pw.x = pk2(x0, x1); pw.y = pk2(x2, x3); pw.z = pk2(x4, x5); pw.w = pk2(x6, x7);
                const bf16x8 bfr = __builtin_bit_cast(bf16x8, pw);
#pragma unroll
                for (int mt = 0; mt < 4; ++mt) acc[mt][ct] = __builtin_amdgcn_mfma_f32_16x16x32_bf16(bfr, af[mt], acc[mt][ct], 0, 0, 0);
            }
        }
        float bsv[4]; u32x2 swv[4][4];
#pragma unroll
        for (int mt = 0; mt < 4; ++mt) {
            bsv[mt] = bsp[64 * th + 16 * mt + n];
#pragma unroll
            for (int ct = 0; ct < 4; ++ct) swv[mt][ct] = *(const u32x2*)(c.PROJ + (size_t)(tok0 + 64 * th + 16 * mt + n) * NMAIN + PJ_SU + hs * 128 + 64 * ch + 16 * ct + 4 * lg);
        }
        __builtin_amdgcn_sched_barrier(0);
#pragma unroll
        for (int mt = 0; mt < 4; ++mt) {
            const int t = 64 * th + 16 * mt + n; const float bs = bsv[mt];
            const size_t row = (size_t)(tok0 + t);
#pragma unroll
            for (int ct = 0; ct < 4; ++ct) {
                const int col = hs * 128 + 64 * ch + 16 * ct + 4 * lg;
                const u32x2 sw = swv[mt][ct];
                const f32x4 a = acc[mt][ct];
                *(u32x2*)(c.SGU + row * 512 + col) = (u32x2){pk2(gelu_f(bflo(sw.x)) * (a[0] + bs), gelu_f(bfhi(sw.x)) * (a[1] + bs)), pk2(gelu_f(bflo(sw.y)) * (a[2] + bs), gelu_f(bfhi(sw.y)) * (a[3] + bs))};
            }
        }
    }
}

__device__ __forceinline__ int s5_row(int dir, int b, int q) {
    if (dir == 0) return q < CTXL ? NLAT + b * CTXL + q : b * SEQL + (q - CTXL);
    return q < CTXL ? NLAT + b * CTXL + (CTXL - 1 - q) : b * SEQL + (SEQL - 1 - (q - CTXL));
}
__device__ __forceinline__ void s5_disc(const Ctx& c, int l, int dir, int grp, int p, float& lr, float& li, float (&bbr)[16], float (&bbi)[16]) {
    const size_t gp = ((size_t)(l * 2 + dir) * 32 + grp) * 64 + p;
    const float are = fminf(c.in[I_ARE][gp], -1e-4f), aim = c.in[I_AIM][gp];
    const float dt = expf(c.in[I_LOGDT][(size_t)(l * 2 + dir) * 32 + grp]);
    const float mag = expf(are * dt); float sn, cs; sincosf(aim * dt, &sn, &cs);
    lr = mag * cs; li = mag * sn;
    const float den = 1.0f / (are * are + aim * aim), nr = lr - 1.0f;
    const float cr = (nr * are + li * aim) * den, ci = (li * are - nr * aim) * den;
    const float* br = c.in[I_BRE] + gp * 16; const float* bi = c.in[I_BIM] + gp * 16;
#pragma unroll
    for (int q4 = 0; q4 < 4; ++q4) {
        const float4 a = *(const float4*)(br + 4 * q4), b = *(const float4*)(bi + 4 * q4);
        bbr[4 * q4 + 0] = cr * a.x - ci * b.x; bbi[4 * q4 + 0] = cr * b.x + ci * a.x;
        bbr[4 * q4 + 1] = cr * a.y - ci * b.y; bbi[4 * q4 + 1] = cr * b.y + ci * a.y;
        bbr[4 * q4 + 2] = cr * a.z - ci * b.z; bbi[4 * q4 + 2] = cr * b.z + ci * a.z;
        bbr[4 * q4 + 3] = cr * a.w - ci * b.w; bbi[4 * q4 + 3] = cr * b.w + ci * a.w;
    }
}
__device__ __forceinline__ void s5_load_u(const Ctx& c, LAS float* U, int row, int grp) {
    const u32x4* sp = (const u32x4*)(c.PROJ + (size_t)row * NMAIN + PJ_SIN + 16 * grp);
    const u32x4 a = sp[0], b = sp[1];
    LAS u32x4* up = (LAS u32x4*)(U + c.lane * 8);
    up[0] = a; up[1] = b;
    lds_fence();
}
__device__ __forceinline__ float s5_u(LAS const float* U, int tok, int ch) { const unsigned w = ((const LAS unsigned*)U)[tok * 8 + (ch >> 1)]; return (ch & 1) ? bfhi(w) : bflo(w); }
typedef float f2s __attribute__((ext_vector_type(2)));
typedef __bf16 bf2s __attribute__((ext_vector_type(2)));
__device__ __forceinline__ float dot2s(unsigned a, unsigned b, float c) { return __builtin_amdgcn_fdot2_f32_bf16(__builtin_bit_cast(bf2s, a), __builtin_bit_cast(bf2s, b), c, false); }
__device__ __forceinline__ void s5_drive4(LAS const float* U, int tok0, int dt, const unsigned (&pr)[8], const unsigned (&pi)[8], f2s (&d)[4]) {
    u32x4 u[4][2];
#pragma unroll
    for (int k = 0; k < 4; ++k) { const LAS u32x4* up = (const LAS u32x4*)(U + (tok0 + dt * k) * 8); u[k][0] = up[0]; u[k][1] = up[1]; }
    asm volatile("" ::: "memory");
#pragma unroll
    for (int k = 0; k < 4; ++k) {
        const unsigned w[8] = {u[k][0].x, u[k][0].y, u[k][0].z, u[k][0].w, u[k][1].x, u[k][1].y, u[k][1].z, u[k][1].w};
        float r0 = 0.f, r1 = 0.f, i0 = 0.f, i1 = 0.f;
#pragma unroll
        for (int q = 0; q < 4; ++q) { r0 = dot2s(pr[q], w[q], r0); r1 = dot2s(pr[4 + q], w[4 + q], r1); i0 = dot2s(pi[q], w[q], i0); i1 = dot2s(pi[4 + q], w[4 + q], i1); }
        d[k] = (f2s){r0 + r1, i0 + i1};
    }
}
constexpr int S5P1_X = 7;
__device__ __forceinline__ void phase_s5_pass1(const Ctx& c, int l) {
    const int gw = c.bid * 8 + c.wave, nw = c.G * 8;
    LAS float* U = (LAS float*)(c.lds + c.wave * 4096);
    const int nslot = nw >> 6;
    if (nslot < 1 || (gw >> 6) >= nslot) return;
    const int gd = gw & 63, grp = gd >> 1, dir = gd & 1, slot = gw >> 6;
    float lr, li, bbr[16], bbi[16];
    s5_disc(c, l, dir, grp, c.lane, lr, li, bbr, bbi);
    unsigned pr[8], pi[8];
#pragma unroll
    for (int k = 0; k < 8; ++k) { pr[k] = pk2(bbr[2 * k], bbr[2 * k + 1]); pi[k] = pk2(bbi[2 * k], bbi[2 * k + 1]); }
    int i0, i1;
    if (nslot == 32) { constexpr int X = S5P1_X, REM = 272 - 17 * X, Q = REM / 15, R = REM % 15;
        if (slot < 17) { i0 = X * slot; i1 = i0 + X; } else { const int f = slot - 17; i0 = 17 * X + f * Q + min(f, R); i1 = i0 + Q + (f < R ? 1 : 0); } }
    else { const int per = (NB * NCHK + nslot - 1) / nslot; i0 = min(slot * per, NB * NCHK); i1 = min(i0 + per, NB * NCHK); }
    if (i0 >= i1) return;
    u32x4 na, nb;
    { const u32x4* sp = (const u32x4*)(c.PROJ + (size_t)s5_row(dir, i0 / NCHK, 64 * (i0 % NCHK) + c.lane) * NMAIN + PJ_SIN + 16 * grp); na = sp[0]; nb = sp[1]; }
#pragma unroll 1
    for (int bn = i0; bn < i1; ++bn) {
        const u32x4 a = na, b = nb;
        { const int bq = min(bn + 1, NB * NCHK - 1);
          const u32x4* sp = (const u32x4*)(c.PROJ + (size_t)s5_row(dir, bq / NCHK, 64 * (bq % NCHK) + c.lane) * NMAIN + PJ_SIN + 16 * grp); na = sp[0]; nb = sp[1]; }
        lds_fence();
        { LAS u32x4* up = (LAS u32x4*)(U + c.lane * 8); up[0] = a; up[1] = b; }
        lds_fence();
        float hr = 0.f, hi = 0.f;
#pragma unroll 1
        for (int j = 0; j < 64; j += 4) {
            f2s d[4]; s5_drive4(U, j, 1, pr, pi, d);
#pragma unroll
            for (int k = 0; k < 4; ++k) { const float nr = lr * hr - li * hi + d[k].x, ni = lr * hi + li * hr + d[k].y; hr = nr; hi = ni; }
        }
        c.SLOC[((size_t)(((bn / NCHK) * 32 + grp) * 2 + dir) * NCHK + (bn % NCHK)) * 64 + c.lane] = (f32x2v){hr, hi};
    }
}
constexpr int S5_HS = 272;
template <int DIR, int HALF>
__device__ __forceinline__ void s5_half(LAS const float* U, LAS unsigned char* Hb, float lr, float li, const unsigned (&pr)[8], const unsigned (&pi)[8], float& hr, float& hi,
                                        const bf16x8 (&cf)[4], f32x4 (&acc)[4], int lane, int n, int lg) {
#pragma unroll 1
    for (int jj = 0; jj < 32; jj += 4) {
        const int j = 32 * HALF + jj, tok0 = DIR ? 63 - j : j;
        f2s d[4]; s5_drive4(U, tok0, DIR ? -1 : 1, pr, pi, d);
#pragma unroll
        for (int k = 0; k < 4; ++k) {
            const float nr = lr * hr - li * hi + d[k].x, ni = lr * hi + li * hr + d[k].y; hr = nr; hi = ni;
            const int tok = DIR ? tok0 - k : tok0 + k;
            *(LAS unsigned*)(Hb + (tok & 31) * S5_HS + 4 * lane) = pk2(hr, hi);
        }
    }
    lds_fence();
    constexpr int MTB = DIR ? (2 - 2 * HALF) : (2 * HALF);
#pragma unroll
    for (int mi = 0; mi < 2; ++mi)
#pragma unroll
        for (int kk = 0; kk < 4; ++kk) {
            const bf16x8 a = *(const LAS bf16x8*)(Hb + (16 * mi + n) * S5_HS + (32 * kk + 8 * lg) * 2);
            acc[MTB + mi] = __builtin_amdgcn_mfma_f32_16x16x32_bf16(a, cf[kk], acc[MTB + mi], 0, 0, 0);
        }
    lds_fence();
}
template <int DIR>
__device__ __forceinline__ void s5_pass3_dir(const Ctx& c, int l, bool last, int grp, int slot, int nslot, LAS float* U, LAS unsigned char* Hb, float* scratch) {
    const int lane = c.lane, n = lane & 15, lg = lane >> 4;
    float lr, li, bbr[16], bbi[16];
    s5_disc(c, l, DIR, grp, lane, lr, li, bbr, bbi);
    unsigned pr[8], pi[8];
#pragma unroll
    for (int k = 0; k < 8; ++k) { pr[k] = pk2(bbr[2 * k], bbr[2 * k + 1]); pi[k] = pk2(bbi[2 * k], bbi[2 * k + 1]); }
    bf16x8 cf[4];
    {
        const size_t cb = (((size_t)(l * 2 + DIR) * 32 + grp) * 16 + n) * 64;
#pragma unroll
        for (int kk = 0; kk < 4; ++kk) {
            const float4 re = *(const float4*)(c.in[I_CRE] + cb + 16 * kk + 4 * lg), im = *(const float4*)(c.in[I_CIM] + cb + 16 * kk + 4 * lg);
            u32x4 pw; pw.x = pk2(re.x, -im.x); pw.y = pk2(re.y, -im.y); pw.z = pk2(re.z, -im.z); pw.w = pk2(re.w, -im.w);
            cf[kk] = __builtin_bit_cast(bf16x8, pw);
        }
    }
    float tr = lr, ti = li;
#pragma unroll
    for (int s = 0; s < 6; ++s) { const float a = tr * tr - ti * ti, bq = 2.0f * tr * ti; tr = a; ti = bq; }
    const float dv = c.in[I_S5D][(size_t)l * 512 + 16 * grp + n];
    const int nitems = last ? NB * 64 : NB * NCHK;
#pragma unroll 1
    for (int idx = slot; idx < nitems; idx += nslot) {
        const int b = last ? (idx >> 6) : idx / NCHK, tc = last ? (idx & 63) : idx % NCHK;
        const int rowbase = tc < 64 ? b * SEQL + 64 * tc : NLAT + b * CTXL + 64 * (tc - 64);
        lds_fence();
        s5_load_u(c, U, rowbase + lane, grp);
        const int nchunk = tc < 64 ? (DIR == 0 ? 4 + tc : 4 + 63 - tc) : (DIR == 0 ? tc - 64 : 3 - (tc - 64));
        float hr = 0.f, hi = 0.f;
        {
            const f32x2v* sp = c.SLOC + ((size_t)((b * 32 + grp) * 2 + DIR) * NCHK) * 64 + lane;
#pragma unroll 1
            for (int m0 = 0; m0 < nchunk; m0 += 8) {
                f32x2v sv[8];
#pragma unroll
                for (int q = 0; q < 8; ++q) sv[q] = sp[(size_t)min(m0 + q, nchunk - 1) * 64];
#pragma unroll
                for (int q = 0; q < 8; ++q) if (m0 + q < nchunk) { const float nr = hr * tr - hi * ti + sv[q].x, ni = hr * ti + hi * tr + sv[q].y; hr = nr; hi = ni; }
            }
        }
        f32x4 acc[4];
#pragma unroll
        for (int i = 0; i < 4; ++i) acc[i] = (f32x4){0.f, 0.f, 0.f, 0.f};
        s5_half<DIR, 0>(U, Hb, lr, li, pr, pi, hr, hi, cf, acc, lane, n, lg);
        s5_half<DIR, 1>(U, Hb, lr, li, pr, pi, hr, hi, cf, acc, lane, n, lg);
        f32x4* sc = (f32x4*)(scratch + ((size_t)(grp * NB * NCHK + idx) * 64 + lane) * 16);
        if (DIR == 0) {
#pragma unroll
            for (int i = 0; i < 4; ++i) sc[i] = acc[i];
        } else {
#pragma unroll
            for (int mt = 0; mt < 4; ++mt) {
                const f32x4 p0 = sc[mt];
#pragma unroll
                for (int rr = 0; rr < 4; ++rr) {
                    const int tok = 16 * mt + 4 * lg + rr;
                    const float y = acc[mt][rr] + p0[rr] + dv * s5_u(U, tok, n);
                    c.S5Y[(size_t)(rowbase + tok) * 512 + 16 * grp + n] = f2bf(gelu_f(y));
                }
            }
        }
    }
}
__device__ __forceinline__ void phase_s5_pass3(const Ctx& c, int l, bool last) {
    const int gw = c.bid * 8 + c.wave, nw = c.G * 8;
    LAS float* U = (LAS float*)(c.lds + c.wave * 4096); LAS unsigned char* Hb = c.lds + 32768 + c.wave * (32 * S5_HS);
    const int nslot = nw >> 5;
    if (nslot < 1 || (gw >> 5) >= nslot) return;
    const int grp = gw & 31, slot = gw >> 5;
    float* scratch = (float*)c.PART;
    s5_pass3_dir<0>(c, l, last, grp, slot, nslot, U, Hb, scratch);
    asm volatile("s_waitcnt vmcnt(0)" ::: "memory");
    s5_pass3_dir<1>(c, l, last, grp, slot, nslot, U, Hb, scratch);
}

__device__ __forceinline__ void phase_merge(const Ctx& c, int l, int nrows) {
    const float* gn = c.in[I_ONORM] + (size_t)l * DM;
    const int lane = c.lane;
    int row = c.bid * 8 + c.wave;
    if (row >= nrows) return;
    u32x4 na0 = *(const u32x4*)(c.ATT + (size_t)row * 1024 + 8 * lane), na1 = *(const u32x4*)(c.ATT + (size_t)row * 1024 + 512 + 8 * lane);
    u32x4 ns0 = *(const u32x4*)(c.SGU + (size_t)row * 512 + 8 * lane), nz0 = *(const u32x4*)(c.S5O + (size_t)row * 512 + 8 * lane);
    f32x4 gv[8];
#pragma unroll
    for (int q = 0; q < 4; ++q) { gv[2 * q] = *(const f32x4*)(gn + 512 * q + 8 * lane); gv[2 * q + 1] = *(const f32x4*)(gn + 512 * q + 8 * lane + 4); }
    for (; row < nrows; row += c.G * 8) {
        const u32x4 a0 = na0, a1 = na1, s0 = ns0, z0 = nz0;
        { const size_t rn = (size_t)min(row + c.G * 8, nrows - 1);
          na0 = *(const u32x4*)(c.ATT + rn * 1024 + 8 * lane); na1 = *(const u32x4*)(c.ATT + rn * 1024 + 512 + 8 * lane);
          ns0 = *(const u32x4*)(c.SGU + rn * 512 + 8 * lane); nz0 = *(const u32x4*)(c.S5O + rn * 512 + 8 * lane); }
        float va[16] = {bflo(a0.x), bfhi(a0.x), bflo(a0.y), bfhi(a0.y), bflo(a0.z), bfhi(a0.z), bflo(a0.w), bfhi(a0.w), bflo(a1.x), bfhi(a1.x), bflo(a1.y), bfhi(a1.y), bflo(a1.z), bfhi(a1.z), bflo(a1.w), bfhi(a1.w)};
        float vs[8] = {bflo(s0.x), bfhi(s0.x), bflo(s0.y), bfhi(s0.y), bflo(s0.z), bfhi(s0.z), bflo(s0.w), bfhi(s0.w)};
        float vz[8] = {bflo(z0.x), bfhi(z0.x), bflo(z0.y), bfhi(z0.y), bflo(z0.z), bfhi(z0.z), bflo(z0.w), bfhi(z0.w)};
        float sa = 0.f, ss = 0.f, sz = 0.f;
#pragma unroll
        for (int j = 0; j < 16; ++j) sa += va[j] * va[j];
#pragma unroll
        for (int j = 0; j < 8; ++j) { ss += vs[j] * vs[j]; sz += vz[j] * vz[j]; }
        sa = wave_sum(sa); ss = wave_sum(ss); sz = wave_sum(sz);
        const float ra = rsqrtf(sa * (1.0f / 1024.0f) + EPSN), rs = rsqrtf(ss * (1.0f / 512.0f) + EPSN), rz = rsqrtf(sz * (1.0f / 512.0f) + EPSN);
        u16* yp = c.YIN + (size_t)row * DM;
        {   const float g[8] = {gv[0][0], gv[0][1], gv[0][2], gv[0][3], gv[1][0], gv[1][1], gv[1][2], gv[1][3]}; u32x4 o;
            o.x = pk2(va[0] * ra * g[0], va[1] * ra * g[1]); o.y = pk2(va[2] * ra * g[2], va[3] * ra * g[3]); o.z = pk2(va[4] * ra * g[4], va[5] * ra * g[5]); o.w = pk2(va[6] * ra * g[6], va[7] * ra * g[7]);
            *(u32x4*)(yp + 8 * lane) = o; }
        {   const float g[8] = {gv[2][0], gv[2][1], gv[2][2], gv[2][3], gv[3][0], gv[3][1], gv[3][2], gv[3][3]}; u32x4 o;
            o.x = pk2(va[8] * ra * g[0], va[9] * ra * g[1]); o.y = pk2(va[10] * ra * g[2], va[11] * ra * g[3]); o.z = pk2(va[12] * ra * g[4], va[13] * ra * g[5]); o.w = pk2(va[14] * ra * g[6], va[15] * ra * g[7]);
            *(u32x4*)(yp + 512 + 8 * lane) = o; }
        {   const float g[8] = {gv[4][0], gv[4][1], gv[4][2], gv[4][3], gv[5][0], gv[5][1], gv[5][2], gv[5][3]}; u32x4 o;
            o.x = pk2(vs[0] * rs * g[0], vs[1] * rs * g[1]); o.y = pk2(vs[2] * rs * g[2], vs[3] * rs * g[3]); o.z = pk2(vs[4] * rs * g[4], vs[5] * rs * g[5]); o.w = pk2(vs[6] * rs * g[6], vs[7] * rs * g[7]);
            *(u32x4*)(yp + 1024 + 8 * lane) = o; }
        {   const float g[8] = {gv[6][0], gv[6][1], gv[6][2], gv[6][3], gv[7][0], gv[7][1], gv[7][2], gv[7][3]}; u32x4 o;
            o.x = pk2(vz[0] * rz * g[0], vz[1] * rz * g[1]); o.y = pk2(vz[2] * rz * g[2], vz[3] * rz * g[3]); o.z = pk2(vz[4] * rz * g[4], vz[5] * rz * g[5]); o.w = pk2(vz[6] * rz * g[6], vz[7] * rz * g[7]);
            *(u32x4*)(yp + 1536 + 8 * lane) = o; }
    }
}

__device__ __forceinline__ unsigned ord_f(float f) { const unsigned u = __float_as_uint(f); return (u & 0x80000000u) ? ~u : (u | 0x80000000u); }
__device__ __forceinline__ float unord_f(unsigned k) { return __uint_as_float((k & 0x80000000u) ? (k ^ 0x80000000u) : ~k); }
#define INS16(r, x_) do { unsigned _x = (x_); _Pragma("unroll") for (int _j = 0; _j < 16; ++_j) { const unsigned _t = max(r[_j], _x); _x = min(r[_j], _x); r[_j] = _t; } } while (0)

#define CE_DESC(a_, b_) do { const unsigned hi_ = max((a_), (b_)), lo_ = min((a_), (b_)); (a_) = hi_; (b_) = lo_; } while (0)
template <int N> __device__ __forceinline__ void bitonic_sort_desc(unsigned (&v)[N]) {
#pragma unroll
    for (int k = 2; k <= N; k <<= 1)
#pragma unroll
        for (int j = k >> 1; j > 0; j >>= 1)
#pragma unroll
            for (int i = 0; i < N; ++i) { const int l = i ^ j; if (l > i) { if ((i & k) == 0) CE_DESC(v[i], v[l]); else CE_DESC(v[l], v[i]); } }
}
__device__ __forceinline__ void merge_top16(unsigned (&a)[16], const unsigned (&b)[16]) {
#pragma unroll
    for (int i = 0; i < 16; ++i) a[i] = max(a[i], b[15 - i]);
#pragma unroll
    for (int j = 8; j > 0; j >>= 1)
#pragma unroll
        for (int i = 0; i < 16; ++i) { const int l = i ^ j; if (l > i) CE_DESC(a[i], a[l]); }
}
__device__ __forceinline__ void top16_of_64(unsigned (&g0)[16], unsigned (&g1)[16], unsigned (&g2)[16], unsigned (&g3)[16]) {
    bitonic_sort_desc<16>(g0); bitonic_sort_desc<16>(g1); bitonic_sort_desc<16>(g2); bitonic_sort_desc<16>(g3);
    merge_top16(g0, g1); merge_top16(g2, g3); merge_top16(g0, g2);
}
constexpr int TKW_STRIDE = 132, TKW_BYTES = 32 * TKW_STRIDE * 4;
static_assert(8 * TKW_BYTES <= LDS_BARW, "topk LDS");

__device__ __forceinline__ void topk_wave_item(const Ctx& c, int l, int tile32, int head) {
    const int lane = c.lane, n = lane & 15, lg = lane >> 4, tk = lane & 31, hf = lane >> 5;
    const int tok0 = tile32 * 32;
    LAS unsigned* SC = (LAS unsigned*)(c.lds + c.wave * TKW_BYTES);
    unsigned top[2][16];
#pragma unroll
    for (int list = 0; list < 2; ++list) {
        bf16x8 af[2][4];
#pragma unroll
        for (int mt = 0; mt < 2; ++mt)
#pragma unroll
            for (int kk = 0; kk < 4; ++kk) af[mt][kk] = *(const bf16x8*)(c.PQ + (size_t)(tok0 + 16 * mt + n) * DM + head * 256 + list * 128 + 32 * kk + 8 * lg);
        const u16* kb = (const u16*)(c.wl(l) + WL_K12) + ((size_t)(list * 8 + head) * 128) * 128;
        lds_fence();
        bf16x8 bk[4];
#pragma unroll
        for (int kk = 0; kk < 4; ++kk) bk[kk] = *(const bf16x8*)(kb + (size_t)n * 128 + 32 * kk + 8 * lg);
#pragma unroll
        for (int nt = 0; nt < 8; ++nt) {
            bf16x8 bn[4];
            if (nt < 7) {
#pragma unroll
                for (int kk = 0; kk < 4; ++kk) bn[kk] = *(const bf16x8*)(kb + (size_t)(16 * (nt + 1) + n) * 128 + 32 * kk + 8 * lg);
            }
            __builtin_amdgcn_sched_barrier(0);
#pragma unroll
            for (int mt = 0; mt < 2; ++mt) {
                f32x4 acc = {0.f, 0.f, 0.f, 0.f};
#pragma unroll
                for (int kk = 0; kk < 4; ++kk) acc = __builtin_amdgcn_mfma_f32_16x16x32_bf16(af[mt][kk], bk[kk], acc, 0, 0, 0);
                const unsigned ki = (unsigned)(16 * nt + n);
#pragma unroll
                for (int rr = 0; rr < 4; ++rr) SC[(16 * mt + 4 * lg + rr) * TKW_STRIDE + ki] = (ord_f(acc[rr]) & ~0x7Fu) | (127u - ki);
            }
            __builtin_amdgcn_sched_barrier(0);
            if (nt < 7) {
#pragma unroll
                for (int kk = 0; kk < 4; ++kk) bk[kk] = bn[kk];
            }
        }
        lds_fence();
        unsigned r[16], g1[16], g2[16], g3[16];
        const LAS u32x4* sp = (const LAS u32x4*)(SC + tk * TKW_STRIDE + 64 * hf);
#pragma unroll
        for (int i = 0; i < 4; ++i) { const u32x4 a = sp[i], b = sp[4 + i], c2 = sp[8 + i], d = sp[12 + i];
            r[4 * i] = a.x; r[4 * i + 1] = a.y; r[4 * i + 2] = a.z; r[4 * i + 3] = a.w; g1[4 * i] = b.x; g1[4 * i + 1] = b.y; g1[4 * i + 2] = b.z; g1[4 * i + 3] = b.w;
            g2[4 * i] = c2.x; g2[4 * i + 1] = c2.y; g2[4 * i + 2] = c2.z; g2[4 * i + 3] = c2.w; g3[4 * i] = d.x; g3[4 * i + 1] = d.y; g3[4 * i + 2] = d.z; g3[4 * i + 3] = d.w; }
        top16_of_64(r, g1, g2, g3);
        unsigned o[16];
#pragma unroll
        for (int j = 0; j < 16; ++j) o[j] = (unsigned)__shfl_xor((int)r[j], 32);
        merge_top16(r, o);
#pragma unroll
        for (int j = 0; j < 16; ++j) top[list][j] = r[j];
    }
    float v1[16], v2[16];
#pragma unroll
    for (int j = 0; j < 16; ++j) { v1[j] = unord_f(top[0][j] & ~0x7Fu); v2[j] = unord_f(top[1][j] & ~0x7Fu); }
    unsigned r[16], q1[16], q2[16], q3[16];
    {
        unsigned cand[64]; int nc = 0;
#pragma unroll
        for (int a = 0; a < 16; ++a)
#pragma unroll
            for (int b = 0; b < 16; ++b)
                if ((a + 1) * (b + 1) <= 16) { cand[nc] = (ord_f(v1[a] + v2[b]) & ~0xFFu) | (unsigned)(255 - (a * 16 + b)); ++nc; }
#pragma unroll
        for (int i = 50; i < 64; ++i) cand[i] = 0u;
#pragma unroll
        for (int i = 0; i < 16; ++i) { r[i] = cand[i]; q1[i] = cand[16 + i]; q2[i] = cand[32 + i]; q3[i] = cand[48 + i]; }
    }
    top16_of_64(r, q1, q2, q3);
    if (hf == 0) {
#pragma unroll
        for (int j = 0; j < 16; ++j) { SC[tk * TKW_STRIDE + j] = top[0][j]; SC[tk * TKW_STRIDE + 16 + j] = top[1][j]; }
    }
    lds_fence();
    float s[16], sum = 0.f;
    const float mx = unord_f(r[0] & ~0xFFu);
#pragma unroll
    for (int k = 0; k < 16; ++k) { s[k] = __expf(unord_f(r[k] & ~0xFFu) - mx); sum += s[k]; }
    const float inv = 1.0f / sum;
    unsigned ev[16];
#pragma unroll
    for (int k = 0; k < 16; ++k) {
        const int flat = 255 - (int)(r[k] & 0xFFu), a = flat >> 4, b = flat & 15;
        const int i1 = 127 - (int)(SC[tk * TKW_STRIDE + a] & 0x7Fu), i2 = 127 - (int)(SC[tk * TKW_STRIDE + 16 + b] & 0x7Fu);
        ev[k] = (unsigned)(i1 * 128 + i2);
    }
    if (hf == 0) {
        const size_t o = (size_t)(tok0 + tk) * 128 + head * 16;
        u32x4* ep = (u32x4*)(c.ET + o);
        ep[0] = (u32x4){ev[0] | (ev[1] << 16), ev[2] | (ev[3] << 16), ev[4] | (ev[5] << 16), ev[6] | (ev[7] << 16)};
        ep[1] = (u32x4){ev[8] | (ev[9] << 16), ev[10] | (ev[11] << 16), ev[12] | (ev[13] << 16), ev[14] | (ev[15] << 16)};
        f32x4* gp = (f32x4*)(c.GT + o);
        gp[0] = (f32x4){s[0] * inv, s[1] * inv, s[2] * inv, s[3] * inv}; gp[1] = (f32x4){s[4] * inv, s[5] * inv, s[6] * inv, s[7] * inv};
        gp[2] = (f32x4){s[8] * inv, s[9] * inv, s[10] * inv, s[11] * inv}; gp[3] = (f32x4){s[12] * inv, s[13] * inv, s[14] * inv, s[15] * inv};
    }
    lds_fence();
}

#define CFENCE() asm volatile("" ::: "memory")
typedef float f2 __attribute__((ext_vector_type(2)));
__device__ __forceinline__ float dpp_xor1(float v) { return __builtin_bit_cast(float, __builtin_amdgcn_update_dpp(0, __builtin_bit_cast(int, v), 0xB1, 0xF, 0xF, true)); }
__device__ __forceinline__ float dpp_xor2(float v) { return __builtin_bit_cast(float, __builtin_amdgcn_update_dpp(0, __builtin_bit_cast(int, v), 0x4E, 0xF, 0xF, true)); }

typedef __bf16 bf2v __attribute__((ext_vector_type(2)));
#define FP4_DOT(a_, w_, h_, o_) do { a_ += (h_)[(o_) + 0] * __builtin_amdgcn_cvt_scalef32_pk_f32_fp4((w_), 1.0f, 0); a_ += (h_)[(o_) + 1] * __builtin_amdgcn_cvt_scalef32_pk_f32_fp4((w_), 1.0f, 1); \
    a_ += (h_)[(o_) + 2] * __builtin_amdgcn_cvt_scalef32_pk_f32_fp4((w_), 1.0f, 2); a_ += (h_)[(o_) + 3] * __builtin_amdgcn_cvt_scalef32_pk_f32_fp4((w_), 1.0f, 3); } while (0)
#define PEER_E(ew_, i_) (((i_) & 1) ? ((ew_)[(i_) >> 1] >> 16) : ((ew_)[(i_) >> 1] & 0xFFFFu))

#define I4_DOT(a_, w_, h_, o_) do { a_ = __builtin_amdgcn_sdot4((int)((w_) & 0x0F0F0F0Fu), (int)(h_)[(o_)], a_, false); a_ = __builtin_amdgcn_sdot4((int)(((w_) >> 4) & 0x0F0F0F0Fu), (int)(h_)[(o_) + 1], a_, false); } while (0)
__device__ __forceinline__ void phase_peer_u(const Ctx& c, int l, int nrows) {
    const int lane = c.lane, g = lane >> 3, j = lane & 7;
    const int tstep = c.xn * 8;
    for (int s = c.xi; s < PEER_NSL; s += c.nx) {
        const unsigned char* ub = c.wl(l) + WL_U + PEER_SLB * s + 16 * j;
        const unsigned char* hs = c.H8 + 256 * s + 32 * j;
        u16* part = c.PART + (size_t)s * PAIRS_MAX;
        int t = c.xr * 8 + c.wave;
        if (t >= nrows) continue;
        u32x4 ea, eb, segN[16], hN[2]; float scN;
        { const u32x4* ep = (const u32x4*)(c.ET + (size_t)t * 128 + 16 * g); ea = ep[0]; eb = ep[1]; }
        { const unsigned ew[8] = {ea.x, ea.y, ea.z, ea.w, eb.x, eb.y, eb.z, eb.w};
#pragma unroll
          for (int i = 0; i < 16; ++i) segN[i] = *(const u32x4*)(ub + (size_t)PEER_E(ew, i) * PEER_ROWB);
          const u32x4* hp = (const u32x4*)(hs + (size_t)t * DM); hN[0] = hp[0]; hN[1] = hp[1]; scN = c.HSC[t]; }
        { const u32x4* ep = (const u32x4*)(c.ET + (size_t)min(t + tstep, nrows - 1) * 128 + 16 * g); ea = ep[0]; eb = ep[1]; }
#pragma unroll 1
        for (; t < nrows; t += tstep) {
            u32x4 seg[16];
#pragma unroll
            for (int i = 0; i < 16; ++i) seg[i] = segN[i];
            const unsigned hv[8] = {hN[0].x, hN[0].y, hN[0].z, hN[0].w, hN[1].x, hN[1].y, hN[1].z, hN[1].w};
            const float hsc = scN;
            {
                const int tn = min(t + tstep, nrows - 1);
                const unsigned ew[8] = {ea.x, ea.y, ea.z, ea.w, eb.x, eb.y, eb.z, eb.w};
#pragma unroll
                for (int i = 0; i < 16; ++i) segN[i] = *(const u32x4*)(ub + (size_t)PEER_E(ew, i) * PEER_ROWB);
                const u32x4* hp = (const u32x4*)(hs + (size_t)tn * DM); hN[0] = hp[0]; hN[1] = hp[1]; scN = c.HSC[tn];
                const u32x4* ep = (const u32x4*)(c.ET + (size_t)min(t + 2 * tstep, nrows - 1) * 128 + 16 * g); ea = ep[0]; eb = ep[1];
            }
            int hsum = 0;
#pragma unroll
            for (int q = 0; q < 8; ++q) hsum = __builtin_amdgcn_sdot4((int)hv[q], 0x01010101, hsum, false);
            const float fs = hsc;
            float acc[16];
#pragma unroll
            for (int i = 0; i < 16; ++i) {
                int a = 0, b = 0;
                I4_DOT(a, seg[i].x, hv, 0); I4_DOT(b, seg[i].y, hv, 2); I4_DOT(a, seg[i].z, hv, 4); I4_DOT(b, seg[i].w, hv, 6);
                acc[i] = (float)(a + b - 8 * hsum) * fs;
            }
            float r8[8], r4[4], r2[2];
            { const bool hi = (j & 4) != 0;
#pragma unroll
              for (int m = 0; m < 8; ++m) { const float keep = hi ? acc[8 + m] : acc[m], send = hi ? acc[m] : acc[8 + m]; r8[m] = keep + __shfl_xor(send, 4); } }
            { const bool hi = (j & 2) != 0;
#pragma unroll
              for (int m = 0; m < 4; ++m) { const float keep = hi ? r8[4 + m] : r8[m], send = hi ? r8[m] : r8[4 + m]; r4[m] = keep + dpp_xor2(send); } }
            { const bool hi = (j & 1) != 0;
#pragma unroll
              for (int m = 0; m < 2; ++m) { const float keep = hi ? r4[2 + m] : r4[m], send = hi ? r4[m] : r4[2 + m]; r2[m] = keep + dpp_xor1(send); } }
            *(unsigned*)(part + (size_t)t * 128 + 2 * lane) = pk2(r2[0], r2[1]);
        }
    }
}

__device__ __forceinline__ void phase_peer_reduce(const Ctx& c, int nrows) {
    const size_t n8 = (size_t)nrows * 128 / 8;
    for (size_t i = (size_t)c.bid * 512 + c.tid; i < n8; i += (size_t)c.G * 512) {
        float s[8];
#pragma unroll
        for (int q = 0; q < 8; ++q) s[q] = 0.f;
#pragma unroll
        for (int sl = 0; sl < PEER_NSL; ++sl) {
            const u32x4 v = *(const u32x4*)(c.PART + (size_t)sl * PAIRS_MAX + 8 * i);
            s[0] += bflo(v.x); s[1] += bfhi(v.x); s[2] += bflo(v.y); s[3] += bfhi(v.y); s[4] += bflo(v.z); s[5] += bfhi(v.z); s[6] += bflo(v.w); s[7] += bfhi(v.w);
        }
        const f32x4 g0 = *(const f32x4*)(c.GT + 8 * i), g1 = *(const f32x4*)(c.GT + 8 * i + 4);
        const float is = 1.0f / USCALE;
        u32x4 o;
        o.x = pk2(g0[0] * gelu_f(s[0] * is), g0[1] * gelu_f(s[1] * is)); o.y = pk2(g0[2] * gelu_f(s[2] * is), g0[3] * gelu_f(s[3] * is));
        o.z = pk2(g1[0] * gelu_f(s[4] * is), g1[1] * gelu_f(s[5] * is)); o.w = pk2(g1[2] * gelu_f(s[6] * is), g1[3] * gelu_f(s[7] * is));
        *(u32x4*)(c.WT + 8 * i) = o;
    }
}

#define FP4_AXPY(o_, w2_, w_, b_) do { (o_)[(b_) + 0] += (w2_) * __builtin_amdgcn_cvt_scalef32_pk_f32_fp4((w_), 1.0f, 0); (o_)[(b_) + 1] += (w2_) * __builtin_amdgcn_cvt_scalef32_pk_f32_fp4((w_), 1.0f, 1); \
    (o_)[(b_) + 2] += (w2_) * __builtin_amdgcn_cvt_scalef32_pk_f32_fp4((w_), 1.0f, 2); (o_)[(b_) + 3] += (w2_) * __builtin_amdgcn_cvt_scalef32_pk_f32_fp4((w_), 1.0f, 3); } while (0)
__device__ __forceinline__ f2 shfl2(f2 v, int m) { return (f2){__shfl_xor(v.x, m), __shfl_xor(v.y, m)}; }
__device__ __forceinline__ void phase_peer_v(const Ctx& c, int l, int nrows, u16* xdst) {
    const int lane = c.lane, g = lane >> 3, j = lane & 7;
    const int tstep = c.xn * 8;
    for (int s = c.xi; s < PEER_NSL; s += c.nx) {
        const unsigned char* vb = c.wl(l) + WL_V + PEER_SLB * s + 16 * j;
        int t = c.xr * 8 + c.wave;
        if (t >= nrows) continue;
        u32x4 ea, eb, segN[16], wN[2];
        { const u32x4* ep = (const u32x4*)(c.ET + (size_t)t * 128 + 16 * g); ea = ep[0]; eb = ep[1]; }
        { const unsigned ew[8] = {ea.x, ea.y, ea.z, ea.w, eb.x, eb.y, eb.z, eb.w};
#pragma unroll
          for (int i = 0; i < 16; ++i) segN[i] = *(const u32x4*)(vb + (size_t)PEER_E(ew, i) * PEER_ROWB);
          const u32x4* wp = (const u32x4*)(c.WT + (size_t)t * 128 + 16 * g); wN[0] = wp[0]; wN[1] = wp[1]; }
        { const u32x4* ep = (const u32x4*)(c.ET + (size_t)min(t + tstep, nrows - 1) * 128 + 16 * g); ea = ep[0]; eb = ep[1]; }
#pragma unroll 1
        for (; t < nrows; t += tstep) {
            u32x4 seg[16];
#pragma unroll
            for (int i = 0; i < 16; ++i) seg[i] = segN[i];
            const unsigned ww[8] = {wN[0].x, wN[0].y, wN[0].z, wN[0].w, wN[1].x, wN[1].y, wN[1].z, wN[1].w};
            const int col = 256 * s + 32 * j + 4 * g;
            const f32x4 q = *(const f32x4*)(c.MOD + ((size_t)(l * 5 + row_bidx(t)) * 6 + 5) * DM + col); const u32x2 xw = *(const u32x2*)(c.X + (size_t)t * DM + col);
            {
                const int tn = min(t + tstep, nrows - 1);
                const unsigned ew[8] = {ea.x, ea.y, ea.z, ea.w, eb.x, eb.y, eb.z, eb.w};
#pragma unroll
                for (int i = 0; i < 16; ++i) segN[i] = *(const u32x4*)(vb + (size_t)PEER_E(ew, i) * PEER_ROWB);
                const u32x4* wp = (const u32x4*)(c.WT + (size_t)tn * 128 + 16 * g); wN[0] = wp[0]; wN[1] = wp[1];
                const u32x4* ep = (const u32x4*)(c.ET + (size_t)min(t + 2 * tstep, nrows - 1) * 128 + 16 * g); ea = ep[0]; eb = ep[1];
            }
            f2 o[16];
#pragma unroll
            for (int q = 0; q < 16; ++q) o[q] = (f2){0.f, 0.f};
#pragma unroll
            for (int i = 0; i < 16; ++i) {
                const float w = (i & 1) ? bfhi(ww[i >> 1]) : bflo(ww[i >> 1]);
                const f2 w2 = {w, w};
                FP4_AXPY(o, w2, seg[i].x, 0); FP4_AXPY(o, w2, seg[i].y, 4); FP4_AXPY(o, w2, seg[i].z, 8); FP4_AXPY(o, w2, seg[i].w, 12);
            }
            f2 r8[8], r4[4], r2[2];
#pragma unroll
            for (int m = 0; m < 8; ++m) {
                const u32x2 sx = __builtin_amdgcn_permlane32_swap(__float_as_uint(o[m].x), __float_as_uint(o[8 + m].x), false, false);
                const u32x2 sy = __builtin_amdgcn_permlane32_swap(__float_as_uint(o[m].y), __float_as_uint(o[8 + m].y), false, false);
                r8[m] = (f2){__uint_as_float(sx.x) + __uint_as_float(sx.y), __uint_as_float(sy.x) + __uint_as_float(sy.y)};
            }
#pragma unroll
            for (int m = 0; m < 4; ++m) {
                const u32x2 sx = __builtin_amdgcn_permlane16_swap(__float_as_uint(r8[m].x), __float_as_uint(r8[4 + m].x), false, false);
                const u32x2 sy = __builtin_amdgcn_permlane16_swap(__float_as_uint(r8[m].y), __float_as_uint(r8[4 + m].y), false, false);
                r4[m] = (f2){__uint_as_float(sx.x) + __uint_as_float(sx.y), __uint_as_float(sy.x) + __uint_as_float(sy.y)};
            }
            { const bool hi = (g & 1) != 0;
#pragma unroll
              for (int m = 0; m < 2; ++m) { const f2 keep = hi ? r4[2 + m] : r4[m], send = hi ? r4[m] : r4[2 + m];
                  r2[m] = keep + shfl2(send, 8); } }
            const float is = 1.0f / VSCALE;
            *(u32x2*)(xdst + (size_t)t * DM + col) = (u32x2){pk2(bflo(xw.x) + q[0] * r2[0].x * is, bfhi(xw.x) + q[1] * r2[0].y * is), pk2(bflo(xw.y) + q[2] * r2[1].x * is, bfhi(xw.y) + q[3] * r2[1].y * is)};
        }
    }
}

__device__ __forceinline__ void phase_final(const Ctx& c) {
    const float* gain = c.in[I_FNORM];
    int row = c.bid * 8 + c.wave;
    if (row >= NLAT) return;
    float4 g[8];
#pragma unroll
    for (int i = 0; i < 8; ++i) g[i] = *(const float4*)(gain + 4 * (c.lane + 64 * i));
    u32x2 xn[8];
    { const u32x2* xp = (const u32x2*)(c.X + (size_t)row * DM);
#pragma unroll
      for (int i = 0; i < 8; ++i) xn[i] = xp[c.lane + 64 * i]; }
    for (; row < NLAT; row += c.G * 8) {
        float4 v[8]; float ss = 0.f;
#pragma unroll
        for (int i = 0; i < 8; ++i) { const u32x2 xw = xn[i]; v[i] = make_float4(bflo(xw.x), bfhi(xw.x), bflo(xw.y), bfhi(xw.y)); ss += v[i].x * v[i].x + v[i].y * v[i].y + v[i].z * v[i].z + v[i].w * v[i].w; }
        { const u32x2* xp = (const u32x2*)(c.X + (size_t)min(row + c.G * 8, NLAT - 1) * DM);
#pragma unroll
          for (int i = 0; i < 8; ++i) xn[i] = xp[c.lane + 64 * i]; }
        ss = wave_sum(ss);
        const float rstd = rsqrtf(ss * (1.0f / DM) + EPSN);
        float4* op = (float4*)(c.out + (size_t)row * DM);
#pragma unroll
        for (int i = 0; i < 8; ++i)
            op[c.lane + 64 * i] = make_float4(v[i].x * rstd * g[i].x, v[i].y * rstd * g[i].y, v[i].z * rstd * g[i].z, v[i].w * rstd * g[i].w);
    }
}

constexpr int PH_PRO = 0, PH_MODFIN = 1, PH_NORM0 = 2, PH_L0 = 3, PH_PER_LAYER = 13, N_PHASES = PH_L0 + DEPTH * PH_PER_LAYER;

__global__ void __launch_bounds__(512, 2) fwd_kernel(Args args) {
    extern __shared__ __attribute__((aligned(16))) unsigned char lds_raw[];
    Ctx c;
#pragma unroll
    for (int i = 0; i < N_IN; ++i) c.in[i] = args.in[i];
    c.out = args.out; c.ws = args.ws; c.lds = (LAS unsigned char*)lds_raw;
    c.tid = threadIdx.x; c.lane = c.tid & 63; c.wave = __builtin_amdgcn_readfirstlane(c.tid >> 6); c.G = gridDim.x; c.bid = blockIdx.x;
    unsigned char* ws = args.ws;
    c.MOD = (float*)(ws + WS_MOD); c.MODP = (float*)(ws + WS_MODP); c.X = (u16*)(ws + WS_X); c.H = (u16*)(ws + WS_H); c.PROJ = (u16*)(ws + WS_PROJ); c.TR = (u16*)(ws + WS_TR);
    c.ATT = (u16*)(ws + WS_ATT); c.SGU = (u16*)(ws + WS_SGU); c.S5Y = (u16*)(ws + WS_S5Y); c.S5O = (u16*)(ws + WS_S5O); c.YIN = (u16*)(ws + WS_YIN); c.PQ = (u16*)(ws + WS_PQ);
    c.ET = (u16*)(ws + WS_ET); c.GT = (float*)(ws + WS_GT); c.PART = (u16*)(ws + WS_PART); c.WT = (u16*)(ws + WS_WT); c.H8 = ws + WS_H8; c.HSC = (float*)(ws + WS_HSC);
    c.xi = c.bid % 8; c.nx = 8; c.xr = c.bid / 8; c.xn = (c.G + 7) / 8; c.SLOC = (f32x2v*)(ws + WS_SLOC);

    const int lo = args.ph_lo, hi = args.ph_hi;
    XcdBarrier bar; bar.bar = (unsigned*)(ws + WS_BAR); bar.x = 0; bar.st = (volatile LAS unsigned*)(c.lds + LDS_BARW);
    if (hi - lo > 1) {
        if (c.tid == 0) { bar.st[0] = 0u; bar.st[1] = 0u; }
        __syncthreads();
        bar = xcd_barrier_post((unsigned*)(ws + WS_BAR), (volatile LAS unsigned*)(c.lds + LDS_BARW));
    }
#ifndef PHASE_MASK
#define PHASE_MASK 0xFFFFFF
#endif
#define EN(i) ((PHASE_MASK >> (i)) & 1)
#ifndef PROBE_MASK
#define PROBE_MASK 0
#endif
#define NREP(i) (((PROBE_MASK >> (i)) & 1) ? 2 : 1)
#ifndef USE_CENSUS
#define USE_CENSUS 1
#endif
#define IN_PH(k) (lo <= (k) && (k) < hi)
#define SEAM(k) do { if (IN_PH((k) + 1)) { xcd_barrier(bar); if (NREP(22) == 2) xcd_barrier(bar); } } while (0)

    if (EN(0) && IN_PH(PH_PRO)) { for (int rep = 0; rep < NREP(0); ++rep) phase_prologue(c); SEAM(PH_PRO); }
    if (USE_CENSUS && hi - lo > 1 && lo == 0) {
        volatile LAS unsigned* st = (volatile LAS unsigned*)(c.lds + LDS_BARW);
        if (c.tid == 0) {
            unsigned below = 0, pop = 0, mine = 1;
#pragma unroll
            for (unsigned jx = 0; jx < 16; ++jx) { const unsigned cn = xb_ld((unsigned*)(ws + WS_BAR) + XB_XCNT(jx)); pop += cn ? 1u : 0u; below += (cn && jx < bar.x) ? 1u : 0u; mine = (jx == bar.x) ? cn : mine; }
            st[4] = below; st[5] = pop ? pop : 1u; st[6] = mine ? mine : 1u;
        }
        __syncthreads();
        c.xi = (int)st[4]; c.nx = (int)st[5]; c.xn = (int)st[6]; c.xr = (int)st[2];
        if (c.xr >= c.xn) c.xr = c.xn - 1;
    }
    if (EN(1) && IN_PH(PH_MODFIN)) { phase_modfin(c); SEAM(PH_MODFIN); }
    if (EN(2) && IN_PH(PH_NORM0)) { phase_normmod(c, 0, 0, MROWS); SEAM(PH_NORM0); }

#pragma unroll 1
    for (int l = 0; l < DEPTH; ++l) {
        const int base = PH_L0 + l * PH_PER_LAYER;
        const bool last = (l == DEPTH - 1);
        const int mrows = last ? NLAT : MROWS;
        unsigned char* W = c.wl(l);
        if (EN(3) && IN_PH(base + 0)) { c.fresh();
            for (int rep = 0; rep < NREP(3); ++rep) {
            { pg8::Gemm g{c.H, (const u16*)(W + WL_MAIN), MROWS, NMAIN, DM, (const u16*)(W + WL_TR), c.H}; pg8::DualOrder S; S.init(MROWS, NMAIN, NTR, MROWS, c.G, c.bid);
              EpiProj E{c.PROJ, c.TR};
              pg8::gemm_phase<EpiProj, pg8::DualOrder>(c.lds, g, S, E, nullptr); }
            }
            SEAM(base + 0);
        }
        if (EN(4) && IN_PH(base + 1)) { c.fresh();
            const int gw = c.bid * 8 + c.wave, nw = c.G * 8;
            for (int rep = 0; rep < NREP(13); ++rep) if (EN(13)) phase_attention(c, l, last);
            for (int rep = 0; rep < NREP(15); ++rep)
            if (EN(15)) for (int it = c.bid; it < (last ? 128 : 136); it += c.G) sgu_item(c, l, it);
            __syncthreads();
            for (int rep = 0; rep < NREP(16); ++rep)
            if (EN(16)) phase_s5_pass1(c, l);
            SEAM(base + 1);
        }
        if (EN(5) && IN_PH(base + 2)) { c.fresh();
            for (int rep = 0; rep < NREP(5); ++rep) phase_s5_pass3(c, l, last);
            SEAM(base + 2);
        }
        if (EN(6) && IN_PH(base + 3)) { c.fresh();
            for (int rep = 0; rep < NREP(6); ++rep) {
            pg8::Gemm g{c.S5Y, (const u16*)(W + WL_GLU), mrows, 512, 512, nullptr, nullptr}; pg8::StaticOrder S; S.init(mrows, 512, c.G, c.bid);
            EpiGlu E{c.S5Y, c.S5O, c.in[I_GLUB] + (size_t)l * 512};
            pg8::gemm_phase<EpiGlu, pg8::StaticOrder>(c.lds, g, S, E, nullptr);
            }
            if (!last && c.G == 256) {
                constexpr size_t UCUT = (size_t)16384 * DM / 32 * 3 / 5;
                constexpr int NU = (MROWS / 256) * 2;
                const bool idle = c.bid >= NU;
                peer_convert_u(c, l + 1, idle ? NU : 0, idle ? c.G - NU : NU, idle ? (size_t)0 : UCUT, idle ? UCUT : (size_t)16384 * DM / 32);
            }
            SEAM(base + 3);
        }
        if (EN(7) && IN_PH(base + 4)) { c.fresh(); for (int rep = 0; rep < NREP(7); ++rep) phase_merge(c, l, mrows); SEAM(base + 4); }
        constexpr int NCU = 32;
        const bool split = !last && c.G > 2 * NCU;
        if (EN(8) && IN_PH(base + 5)) { c.fresh();
            const int m5 = split ? NLAT : mrows;
            pg8::Gemm g{c.YIN, (const u16*)(W + WL_OUT), m5, DM, DM, nullptr, nullptr}; pg8::StaticOrder S; S.init(m5, DM, c.G, c.bid);
            EpiResid E{c.X, c.MOD + (size_t)l * 5 * 6 * DM, 0};
            pg8::gemm_phase<EpiResid, pg8::StaticOrder>(c.lds, g, S, E, nullptr);
            SEAM(base + 5);
        }
        if (EN(9) && IN_PH(base + 6)) { c.fresh();
            if (!split) phase_normmod(c, l, 1, mrows);
            else if (c.bid < NCU) {
                pg8::Gemm g{c.YIN + (size_t)NLAT * DM, (const u16*)(W + WL_OUT), NCTX, DM, DM, nullptr, nullptr}; pg8::StaticOrder S; S.init(NCTX, DM, NCU, c.bid);
                EpiResid E{c.X + (size_t)NLAT * DM, c.MOD + (size_t)l * 5 * 6 * DM, NLAT};
                pg8::gemm_phase<EpiResid, pg8::StaticOrder>(c.lds, g, S, E, nullptr);
            } else phase_normmod(c, l, 1, NLAT, 0, NCU, c.G - NCU);
            SEAM(base + 6);
        }
        if (EN(10) && IN_PH(base + 7)) { c.fresh();
            const int m7 = split ? NLAT : mrows;
            pg8::Gemm g{c.H, (const u16*)(W + WL_Q), m7, DM, DM, nullptr, nullptr}; pg8::StaticOrder S; S.init(m7, DM, c.G, c.bid);
            pg8::EpiBf16<0> E{c.PQ, DM, nullptr, 0, 0};
            pg8::gemm_phase<pg8::EpiBf16<0>, pg8::StaticOrder>(c.lds, g, S, E, nullptr);
            if (split) phase_normmod(c, l, 1, NCTX, NLAT);
            SEAM(base + 7);
        }
        if (EN(11) && IN_PH(base + 8)) { c.fresh();
            if (!split) { for (int it = c.bid * 8 + c.wave; it < (mrows / 32) * 8; it += c.G * 8) topk_wave_item(c, l, it >> 3, it & 7); }
            else if (c.bid < NCU) {
                pg8::Gemm g{c.H + (size_t)NLAT * DM, (const u16*)(W + WL_Q), NCTX, DM, DM, nullptr, nullptr}; pg8::StaticOrder S; S.init(NCTX, DM, NCU, c.bid);
                pg8::EpiBf16<0> E{c.PQ + (size_t)NLAT * DM, DM, nullptr, 0, 0};
                pg8::gemm_phase<pg8::EpiBf16<0>, pg8::StaticOrder>(c.lds, g, S, E, nullptr);
                pg8::Unit u; S.next(0, u);
                asm volatile("s_waitcnt vmcnt(0)" ::: "memory"); __syncthreads();
                topk_wave_item(c, l, (NLAT + 256 * u.pm) / 32 + c.wave, u.pn);
            } else { for (int it = (c.bid - NCU) * 8 + c.wave; it < (NLAT / 32) * 8; it += (c.G - NCU) * 8) topk_wave_item(c, l, it >> 3, it & 7);
                if (c.G == 256) peer_convert_v(c, l + 1, 96, c.G - 96); }
            SEAM(base + 8);
        }
        if (EN(12) && IN_PH(base + 9)) { c.fresh(); for (int rep = 0; rep < NREP(17); ++rep) phase_peer_u(c, l, mrows); SEAM(base + 9); }
        if (EN(12) && IN_PH(base + 10)) { c.fresh(); for (int rep = 0; rep < NREP(18); ++rep) phase_peer_reduce(c, mrows); SEAM(base + 10); }
        if (EN(12) && IN_PH(base + 11)) { c.fresh(); phase_peer_v(c, l, mrows, c.X); SEAM(base + 11); }
        if (EN(12) && IN_PH(base + 12)) { c.fresh();
            for (int rep = 0; rep < NREP(20); ++rep)
            if (!last) phase_normmod(c, l + 1, 0, MROWS); else phase_final(c);
            SEAM(base + 12);
        }
    }
}

#ifndef N_LAUNCH_MODE
#define N_LAUNCH_MODE 1
#endif
extern "C" void kernel_launch(void* const* d_in, const int* in_sizes, int n_in, void* d_out, int out_size, void* d_ws, size_t ws_size, hipStream_t stream) {
    static int grid = 0;
    if (grid == 0) {
        if (n_in != N_IN || ws_size < WS_END) { fprintf(stderr, "kernel_launch: unexpected n_in %d or ws %zu < %zu\n", n_in, ws_size, (size_t)WS_END); grid = -1; return; }
        int dev = 0, cus = 0, per_cu = 0;
        hipGetDevice(&dev); hipDeviceGetAttribute(&cus, hipDeviceAttributeMultiprocessorCount, dev);
        if (hipFuncSetAttribute((const void*)fwd_kernel, hipFuncAttributeMaxDynamicSharedMemorySize, LDS_BYTES) != hipSuccess) { fprintf(stderr, "kernel_launch: hipFuncSetAttribute failed\n"); grid = -1; return; }
        if (hipOccupancyMaxActiveBlocksPerMultiprocessor(&per_cu, (const void*)fwd_kernel, 512, LDS_BYTES) != hipSuccess || per_cu < 1) fprintf(stderr, "kernel_launch: occupancy query says %d\n", per_cu);
        (void)hipGetLastError();
        grid = cus > 0 ? cus : 256;
    }
    if (grid < 0) return;
    hipMemsetAsync((char*)d_ws + WS_BAR, 0, 16384, stream);
    Args a{};
    for (int i = 0; i < N_IN; ++i) a.in[i] = (const float*)d_in[i];
    a.out = (float*)d_out; a.ws = (unsigned char*)d_ws;
#if N_LAUNCH_MODE == 1
    a.ph_lo = 0; a.ph_hi = N_PHASES;
    hipLaunchKernelGGL(fwd_kernel, dim3(grid), dim3(512), LDS_BYTES, stream, a);
#else
    for (int p = 0; p < N_PHASES; ++p) { a.ph_lo = p; a.ph_hi = p + 1; hipLaunchKernelGGL(fwd_kernel, dim3(grid), dim3(512), LDS_BYTES, stream, a); }
#endif
}
```
